# Optimizing an MI355X kernel written in HIP

```python
import math, functools
import jax, jax.numpy as jnp
from jax import lax
import numpy as np

D_MODEL = 1024
BATCH = 8
SEQ = 8192
DEPTH = 1

CTX_LEN = 256
GRID_W = 64
HG_HEADS = 4
HG_DK = 128
HG_DV = 128
HG_WIDTH = HG_HEADS * HG_DV
HG_COLS = 5 * HG_WIDTH
HG_CHUNK = 64
RW_HEADS = 8
RW_HEAD = 64
RW_WIDTH = RW_HEADS * RW_HEAD
RW_W_LORA = 32
RW_A_LORA = 32
RW_G_LORA = 96
RW_COLS = 3 * RW_WIDTH + 2 * RW_W_LORA + 2 * RW_A_LORA + RW_G_LORA
IN_COLS = HG_COLS + RW_COLS
MIX_WIDTH = HG_WIDTH + RW_WIDTH
D_FF = int(math.ceil(8 * D_MODEL / 3 / 256)) * 256
ADA_EPS = 1e-6
LN_EPS = 1e-5
HG_NORM_EPS = 1e-5
RW_GN_EPS = 64e-5

kernel_name = 'hybrid_hgrn2_rwkv7_flow_block'


def _ln(x, eps=ADA_EPS):
    xf = x.astype(jnp.float32)
    m = jnp.mean(xf, -1, keepdims=True)
    v = jnp.mean(jnp.square(xf - m), -1, keepdims=True)
    return (xf - m) * lax.rsqrt(v + eps)


def _post_ln(x, g, b):
    return (_ln(x, LN_EPS) * g + b).astype(x.dtype)


def _modulate(x, shift, scale):
    return (_ln(x) * (1.0 + scale) + shift).astype(x.dtype)


def _rev(a):
    return jnp.flip(a, axis=1)


def _shift_seq(z):
    h = z.shape[-1] // 2
    p = jnp.pad(z, ((0, 0), (1, 1), (0, 0)))
    return jnp.concatenate([p[:, :-2, :h], p[:, 2:, h:]], axis=-1)


def _qshift_grid(z, rows):
    B, T, C = z.shape
    q = C // 4
    g = jnp.pad(z.reshape(B, rows, GRID_W, C), ((0, 0), (1, 1), (1, 1), (0, 0)))
    left = g[:, 1:-1, :-2, :q]
    right = g[:, 1:-1, 2:, q:2 * q]
    up = g[:, :-2, 1:-1, 2 * q:3 * q]
    down = g[:, 2:, 1:-1, 3 * q:]
    return jnp.concatenate([left, right, up, down], axis=-1).reshape(B, T, C)


def _hgrn2_chunk_scan(q, k, log_f, v, s0):
    B, T, H, DK = q.shape
    DV = v.shape[-1]
    n = T // HG_CHUNK

    def chunks(a):
        return a.reshape(B, n, HG_CHUNK, H, a.shape[-1]).transpose(1, 0, 3, 2, 4)

    mask = jnp.tril(jnp.ones((HG_CHUNK, HG_CHUNK), bool))[:, :, None]

    def step(s, inp):
        qc, kc, gc, vc = inp
        b = jnp.cumsum(gc, axis=2)
        diff = jnp.where(mask, b[:, :, :, None, :] - b[:, :, None, :, :], -jnp.inf)
        scores = jnp.einsum('bhtk,bhtsk->bhts', qc, jnp.exp(diff) * kc[:, :, None, :, :])
        o = (jnp.einsum('bhts,bhsv->bhtv', scores, vc)
             + jnp.einsum('bhtk,bhkv->bhtv', qc * jnp.exp(b), s))
        b_end = b[:, :, -1:, :]
        s = (jnp.exp(b_end[:, :, 0, :])[..., None] * s
             + jnp.einsum('bhsk,bhsv->bhkv', kc * jnp.exp(b_end - b), vc))
        return s, o

    s, o = lax.scan(step, s0, (chunks(q), chunks(k), chunks(log_f), chunks(v)))
    return o.transpose(1, 0, 3, 2, 4).reshape(B, T, H, DV), s


def _rwkv7_scan(r, w, k, v, a, b, s0):
    def step(s, inp):
        rt, wt, kt, vt, at, bt = inp
        sa = jnp.einsum('bhvk,bhk->bhv', s, at)
        s = s * wt[:, :, None, :] + sa[..., None] * bt[:, :, None, :] + vt[..., None] * kt[:, :, None, :]
        return s, jnp.einsum('bhvk,bhk->bhv', s, rt)

    xs = tuple(jnp.swapaxes(z, 0, 1) for z in (r, w, k, v, a, b))
    s, y = lax.scan(step, s0, xs)
    return jnp.swapaxes(y, 0, 1), s


def _token_mix(u, shift_fn, w_in_l, mu_l, lb_l, hg_norm_w_l, w0_l, w2_l, a0_l, a2_l, g2_l,
               kk_l, ka_l, rk_l, lnw_l, lnb_l, states):
    B, T, _ = u.shape
    f32 = jnp.float32
    z = jnp.einsum('btd,dc->btc', u, w_in_l).astype(f32)
    zh = z[..., :HG_COLS]
    zr = z[..., HG_COLS:]
    zr = zr + mu_l * (shift_fn(zr) - zr)
    hs_f, hs_b, rs_f, rs_b = states

    q, f_fwd, f_bwd, i, og = jnp.split(zh, 5, axis=-1)
    hg = lambda a: a.reshape(B, T, HG_HEADS, -1)
    q = hg(jax.nn.silu(q))
    i = hg(i)
    ff = lb_l[0] + (1.0 - lb_l[0]) * jax.nn.sigmoid(f_fwd)
    fb = lb_l[1] + (1.0 - lb_l[1]) * jax.nn.sigmoid(f_bwd)
    o_f, hs_f = _hgrn2_chunk_scan(q, hg(1.0 - ff), hg(jnp.log(ff)), i, hs_f)
    o_b, hs_b = _hgrn2_chunk_scan(_rev(q), _rev(hg(1.0 - fb)), _rev(hg(jnp.log(fb))), _rev(i), hs_b)
    o = o_f + _rev(o_b)
    o = o * lax.rsqrt(jnp.mean(jnp.square(o), -1, keepdims=True) + HG_NORM_EPS) * hg_norm_w_l
    y_hg = (o * jax.nn.silu(hg(og))).reshape(B, T, HG_WIDTH)

    W = RW_WIDTH
    r, k, v = zr[..., :W], zr[..., W:2 * W], zr[..., 2 * W:3 * W]
    o1 = 3 * W
    o2 = o1 + 2 * RW_W_LORA
    o3 = o2 + 2 * RW_A_LORA
    wd = zr[..., o1:o2].reshape(B, T, 2, RW_W_LORA)
    ad = zr[..., o2:o3].reshape(B, T, 2, RW_A_LORA)
    gd = zr[..., o3:]
    w_pre = w0_l + jnp.einsum('btel,elc->btec', jnp.tanh(wd), w2_l)
    decay = jnp.exp(-jnp.exp(-jax.nn.softplus(-w_pre) - 0.5))
    a = jax.nn.sigmoid(a0_l + jnp.einsum('btel,elc->btec', ad, a2_l))
    g = jnp.einsum('btl,lc->btc', jax.nn.sigmoid(gd), g2_l)
    rh = lambda t_: t_.reshape(B, T, RW_HEADS, RW_HEAD)
    kk = rh(k * kk_l)
    kk = kk / jnp.maximum(jnp.sqrt(jnp.sum(jnp.square(kk), -1, keepdims=True)), 1e-12)
    kd = k[:, :, None, :] * (1.0 + (a - 1.0) * ka_l)
    r_h, v_h = rh(r), rh(v)
    k_f, k_b = rh(kd[:, :, 0]), rh(kd[:, :, 1])
    a_f, a_b = rh(a[:, :, 0]), rh(a[:, :, 1])
    y_f, rs_f = _rwkv7_scan(r_h, rh(decay[:, :, 0]), k_f, v_h, -kk, kk * a_f, rs_f)
    y_b, rs_b = _rwkv7_scan(_rev(r_h), _rev(rh(decay[:, :, 1])), _rev(k_b), _rev(v_h),
                            _rev(-kk), _rev(kk * a_b), rs_b)
    yr = y_f + _rev(y_b)
    m = jnp.mean(yr, -1, keepdims=True)
    var = jnp.mean(jnp.square(yr - m), -1, keepdims=True)
    yr = (yr - m) * lax.rsqrt(var + RW_GN_EPS) * lnw_l.reshape(RW_HEADS, RW_HEAD) + lnb_l.reshape(RW_HEADS, RW_HEAD)
    bonus = (jnp.sum(r_h * k_f * rk_l, -1, keepdims=True) + jnp.sum(r_h * k_b * rk_l, -1, keepdims=True)) * v_h
    y_rw = (yr + bonus).reshape(B, T, W) * g

    y = jnp.concatenate([y_hg, y_rw], axis=-1).astype(u.dtype)
    return y, (hs_f, hs_b, rs_f, rs_b)


def _swiglu(u, wg, wu, wd):
    h = jax.nn.silu(jnp.einsum('btd,df->btf', u, wg)) * jnp.einsum('btd,df->btf', u, wu)
    return jnp.einsum('btf,fd->btd', h, wd)


def setup_inputs(seed: int = 0) -> dict:
    key = jax.random.key(seed)
    ks = jax.random.split(key, 32)
    f32 = jnp.float32
    nrm = lambda k, s, sc: jax.random.normal(k, s, f32) * sc
    beta = (8.0 * DEPTH) ** -0.25
    L = DEPTH
    return {
        'x': nrm(ks[0], (BATCH, SEQ, D_MODEL), 1.0),
        'c': nrm(ks[1], (BATCH, D_MODEL), 1.0),
        'ctx': nrm(ks[2], (BATCH, CTX_LEN, D_MODEL), 1.0),
        'c_ctx': nrm(ks[3], (D_MODEL,), 1.0),
        'w_ada': nrm(ks[4], (L, D_MODEL, 6 * D_MODEL), D_MODEL ** -0.5),
        'b_ada': nrm(ks[5], (L, 6 * D_MODEL), 0.02),
        'w_in': nrm(ks[6], (L, D_MODEL, IN_COLS), D_MODEL ** -0.5),
        'hgrn_lb_logits': nrm(ks[7], (L + 1, 2, HG_WIDTH), 0.5),
        'hgrn_norm_w': 1.0 + nrm(ks[8], (L, HG_DV), 0.02),
        'rwkv_mu': jax.random.uniform(ks[9], (L, RW_COLS), f32, 0.0, 1.0),
        'rwkv_w0': jax.random.uniform(ks[10], (L, 2, RW_WIDTH), f32, -4.0, 0.0),
        'rwkv_w2': nrm(ks[11], (L, 2, RW_W_LORA, RW_WIDTH), 0.1),
        'rwkv_a0': nrm(ks[12], (L, 2, RW_WIDTH), 0.3),
        'rwkv_a2': nrm(ks[13], (L, 2, RW_A_LORA, RW_WIDTH), 0.3 * RW_A_LORA ** -0.5),
        'rwkv_g2': nrm(ks[14], (L, RW_G_LORA, RW_WIDTH), RW_G_LORA ** -0.5),
        'rwkv_k_k': 0.85 + nrm(ks[15], (L, RW_WIDTH), 0.05),
        'rwkv_k_a': 1.0 + nrm(ks[16], (L, RW_WIDTH), 0.05),
        'rwkv_r_k': nrm(ks[17], (L, RW_HEADS, RW_HEAD), 0.1),
        'rwkv_lnx_w': 1.0 + nrm(ks[18], (L, RW_WIDTH), 0.02),
        'rwkv_lnx_b': nrm(ks[19], (L, RW_WIDTH), 0.02),
        'w_out': nrm(ks[20], (L, MIX_WIDTH, D_MODEL), beta * MIX_WIDTH ** -0.5),
        'ln1_g': 1.0 + nrm(ks[21], (L, D_MODEL), 0.02),
        'ln1_b': nrm(ks[22], (L, D_MODEL), 0.02),
        'w_ffn_gate': nrm(ks[23], (L, D_MODEL, D_FF), D_MODEL ** -0.5),
        'w_ffn_up': nrm(ks[24], (L, D_MODEL, D_FF), D_MODEL ** -0.5),
        'w_ffn_down': nrm(ks[25], (L, D_FF, D_MODEL), beta * D_FF ** -0.5),
        'ln2_g': 1.0 + nrm(ks[26], (L, D_MODEL), 0.02),
        'ln2_b': nrm(ks[27], (L, D_MODEL), 0.02),
    }


def reference(x, c, ctx, c_ctx, w_ada, b_ada, w_in, hgrn_lb_logits, hgrn_norm_w, rwkv_mu, rwkv_w0,
              rwkv_w2, rwkv_a0, rwkv_a2, rwkv_g2, rwkv_k_k, rwkv_k_a, rwkv_r_k, rwkv_lnx_w, rwkv_lnx_b,
              w_out, ln1_g, ln1_b, w_ffn_gate, w_ffn_up, w_ffn_down, ln2_g, ln2_b):
    B = x.shape[0]
    rows = x.shape[1] // GRID_W
    latent_shift = functools.partial(_qshift_grid, rows=rows)
    alpha = (2.0 * DEPTH) ** 0.25
    lb_all = jnp.cumsum(jax.nn.softmax(hgrn_lb_logits.astype(jnp.float32), axis=0), axis=0)
    zero_states = (jnp.zeros((B, HG_HEADS, HG_DK, HG_DV), jnp.float32),
                   jnp.zeros((B, HG_HEADS, HG_DK, HG_DV), jnp.float32),
                   jnp.zeros((B, RW_HEADS, RW_HEAD, RW_HEAD), jnp.float32),
                   jnp.zeros((B, RW_HEADS, RW_HEAD, RW_HEAD), jnp.float32))
    for l in range(DEPTH):
        mod = jnp.einsum('bd,de->be', jax.nn.silu(c), w_ada[l]) + b_ada[l]
        sh1, sc1, g1, sh2, sc2, g2 = [m[:, None, :] for m in jnp.split(mod, 6, axis=-1)]
        mod_c = jnp.einsum('d,de->e', jax.nn.silu(c_ctx), w_ada[l]) + b_ada[l]
        ch1, cs1, cg1, ch2, cs2, cg2 = jnp.split(mod_c, 6)
        mix_w = (w_in[l], rwkv_mu[l], lb_all[l], hgrn_norm_w[l], rwkv_w0[l], rwkv_w2[l], rwkv_a0[l],
                 rwkv_a2[l], rwkv_g2[l], rwkv_k_k[l], rwkv_k_a[l], rwkv_r_k[l], rwkv_lnx_w[l], rwkv_lnx_b[l])
        y_ctx, ctx_states = _token_mix(_modulate(ctx, ch1, cs1), _shift_seq, *mix_w, zero_states)
        y, _ = _token_mix(_modulate(x, sh1, sc1), latent_shift, *mix_w, ctx_states)
        x = _post_ln(alpha * x + g1 * jnp.einsum('btm,md->btd', y, w_out[l]), ln1_g[l], ln1_b[l])
        ffn = _swiglu(_modulate(x, sh2, sc2), w_ffn_gate[l], w_ffn_up[l], w_ffn_down[l])
        x = _post_ln(alpha * x + g2 * ffn, ln2_g[l], ln2_b[l])
        if l < DEPTH - 1:
            ctx = _post_ln(alpha * ctx + cg1 * jnp.einsum('btm,md->btd', y_ctx, w_out[l]), ln1_g[l], ln1_b[l])
            ffn_c = _swiglu(_modulate(ctx, ch2, cs2), w_ffn_gate[l], w_ffn_up[l], w_ffn_down[l])
            ctx = _post_ln(alpha * ctx + cg2 * ffn_c, ln2_g[l], ln2_b[l])
    return x
```

```cpp
#include <hip/hip_runtime.h>
#include <cstdio>
#include <cstdint>

namespace pg8 {
#define PG8_LAS __attribute__((address_space(3)))
typedef unsigned short bf16_t;
typedef short bf16x8 __attribute__((ext_vector_type(8)));
typedef float f32x4 __attribute__((ext_vector_type(4)));
typedef unsigned u32x4 __attribute__((ext_vector_type(4)));
constexpr int BM = 256, BK = 64, HALF = 128, HTB = HALF * BK * 2, STAGE_BYTES = 8 * HTB, NXCD = 8, WGM = 8;

__host__ __device__ __forceinline__ int lds_byte(int r, int c) { const int st = (r >> 4) * 2 + (c >> 5), rr = r & 15, cc = c & 31, ob = rr * 64 + cc * 2; return st * 1024 + (ob ^ (((ob >> 9) & 1) << 5)); }
__host__ __device__ __forceinline__ void stage_rc(int b, int& R, int& C) { const int st = b / 1024, sb = b % 1024, swz = sb ^ (((sb >> 9) & 1) << 5); R = (st >> 1) * 16 + swz / 64; C = (st & 1) * 32 + (swz % 64) / 2; }
__host__ __device__ __forceinline__ int perm32(int rho) { const int n = rho >> 4, i = rho & 15; return 8 * (i >> 2) + 4 * n + (i & 3); }

struct Unit { int pm, pn; };
struct Gemm { const bf16_t* A; const bf16_t* Bt; int M, N, K, lda, ldb; };

struct StaticOrder {
    int nM, nN, nwg, G, c;
    __host__ __device__ void init(int M, int N, int G_, int c_) { nM = M / BM; nN = N / BM; nwg = nM * nN; G = G_; c = c_; }
    __host__ __device__ bool next(int i, Unit& u) const {
        const long L = (long)i * G + c; if (L >= nwg) return false;
        int wgid = (int)L; { const int q = nwg / NXCD, r = nwg % NXCD, xcd = wgid % NXCD, off = wgid / NXCD; wgid = (xcd < r ? xcd * (q + 1) : r * (q + 1) + (xcd - r) * q) + off; }
        const int nig = WGM * nN, gid = wgid / nig, fm = gid * WGM, gsz = (nM - fm) < WGM ? (nM - fm) : WGM;
        u.pm = fm + ((wgid % nig) % gsz); u.pn = (wgid % nig) / gsz; return true;
    }
    __device__ __forceinline__ void a_ready(const Unit&) const {}
    __device__ __forceinline__ void done(const Unit&) const {}
};
struct PanelOrder {
    int pm, n;
    __device__ __forceinline__ bool next(int i, Unit& u) const { if (i >= n) return false; u.pm = pm; u.pn = i; return true; }
    __device__ __forceinline__ void a_ready(const Unit&) const {}
    __device__ __forceinline__ void done(const Unit&) const {}
};
typedef float f32x2_t __attribute__((ext_vector_type(2))); typedef __bf16 bf16x2_t __attribute__((ext_vector_type(2)));
__device__ __forceinline__ unsigned cvt_pk_bf16(float lo, float hi) { const f32x2_t v = {lo, hi}; const bf16x2_t b = __builtin_convertvector(v, bf16x2_t); return __builtin_bit_cast(unsigned, b); }
__device__ __forceinline__ float sigm(float x) { return __builtin_amdgcn_rcpf(1.0f + __expf(-x)); }
__device__ __forceinline__ unsigned pk_f16(float lo, float hi) { const _Float16 a = (_Float16)lo, b = (_Float16)hi; return (unsigned)__builtin_bit_cast(unsigned short, a) | ((unsigned)__builtin_bit_cast(unsigned short, b) << 16); }

struct EpiZ {
    static constexpr bool PERM = true, AFTER_DRAIN = false;
    bf16_t* Z; int ldz; const float* lb;
    __device__ __forceinline__ void operator()(const f32x4 (&acc)[2][2][4][2], const Unit& u, int wr, int wc, int fr, int fq) const {
        const int row0 = u.pm * BM + wr * 64 + fr, col0 = u.pn * BM + wc * 32 + 8 * fq;
        const int mode = (u.pn < 2 || u.pn == 8 || u.pn == 9) ? 1 : ((u.pn >= 2 && u.pn < 6) ? 2 : 0);
#pragma unroll
        for (int bj = 0; bj < 2; ++bj) {
            f32x4 l0 = (f32x4){0.f, 0.f, 0.f, 0.f}, l1 = l0;
            if (mode == 2) { const float* lp = lb + (col0 + bj * HALF - 512); l0 = *(const f32x4*)lp; l1 = *(const f32x4*)(lp + 4); }
#pragma unroll
            for (int ai = 0; ai < 2; ++ai)
#pragma unroll
                for (int m = 0; m < 4; ++m) {
                    f32x4 v0 = acc[ai][bj][m][0], v1 = acc[ai][bj][m][1]; u32x4 w;
                    if (mode == 1) {
#pragma unroll
                        for (int e = 0; e < 4; ++e) { v0[e] = v0[e] * sigm(v0[e]); v1[e] = v1[e] * sigm(v1[e]); }
                    }
                    if (mode == 2) {
#pragma unroll
                        for (int e = 0; e < 4; ++e) { v0[e] = __logf(l0[e] + (1.0f - l0[e]) * sigm(v0[e])); v1[e] = __logf(l1[e] + (1.0f - l1[e]) * sigm(v1[e])); }
                        w.x = pk_f16(v0[0], v0[1]); w.y = pk_f16(v0[2], v0[3]); w.z = pk_f16(v1[0], v1[1]); w.w = pk_f16(v1[2], v1[3]);
                    } else { w.x = cvt_pk_bf16(v0[0], v0[1]); w.y = cvt_pk_bf16(v0[2], v0[3]); w.z = cvt_pk_bf16(v1[0], v1[1]); w.w = cvt_pk_bf16(v1[2], v1[3]); }
                    *(u32x4*)(Z + (size_t)(row0 + ai * HALF + m * 16) * ldz + col0 + bj * HALF) = w;
                }
        }
    }
};
struct EpiGU {
    static constexpr bool PERM = true, AFTER_DRAIN = false;
    bf16_t* H; int ldh;
    __device__ __forceinline__ void operator()(const f32x4 (&acc)[2][2][4][2], const Unit& u, int wr, int wc, int fr, int fq) const {
        const int row0 = u.pm * BM + wr * 64 + fr, col0 = u.pn * HALF + wc * 32 + 8 * fq;
#pragma unroll
        for (int ai = 0; ai < 2; ++ai)
#pragma unroll
            for (int m = 0; m < 4; ++m) {
                f32x4 g0 = acc[ai][0][m][0], g1 = acc[ai][0][m][1]; const f32x4 u0 = acc[ai][1][m][0], u1 = acc[ai][1][m][1];
#pragma unroll
                for (int e = 0; e < 4; ++e) { g0[e] = g0[e] * sigm(g0[e]) * u0[e]; g1[e] = g1[e] * sigm(g1[e]) * u1[e]; }
                u32x4 w; w.x = cvt_pk_bf16(g0[0], g0[1]); w.y = cvt_pk_bf16(g0[2], g0[3]); w.z = cvt_pk_bf16(g1[0], g1[1]); w.w = cvt_pk_bf16(g1[2], g1[3]);
                *(u32x4*)(H + (size_t)(row0 + ai * HALF + m * 16) * ldh + col0) = w;
            }
    }
};
struct EpiRes {
    static constexpr bool PERM = false, AFTER_DRAIN = false;
    const float* base; float* out; int ldc; const float* gate; float alpha;
    __device__ __forceinline__ void operator()(const f32x4 (&acc)[2][2][4][2], const Unit& u, int wr, int wc, int fr, int fq) const {
        const int row0 = u.pm * BM + wr * 64 + fr, col0 = u.pn * BM + wc * 32 + 4 * fq;
        f32x4 gv[2][2];
#pragma unroll
        for (int bj = 0; bj < 2; ++bj)
#pragma unroll
            for (int n = 0; n < 2; ++n) gv[bj][n] = *(const f32x4*)(gate + col0 + bj * HALF + n * 16);
#pragma unroll
        for (int ai = 0; ai < 2; ++ai)
#pragma unroll
            for (int m = 0; m < 4; ++m) { const size_t off = (size_t)(row0 + ai * HALF + m * 16) * ldc + col0;
#pragma unroll
                for (int bj = 0; bj < 2; ++bj)
#pragma unroll
                    for (int n = 0; n < 2; ++n) { const f32x4 bs = *(const f32x4*)(base + off + bj * HALF + n * 16); *(f32x4*)(out + off + bj * HALF + n * 16) = bs * alpha + gv[bj][n] * acc[ai][bj][m][n]; }
                if (m & 1) asm volatile("" ::: "memory"); }
    }
};

template <class Epi, class Sched, bool ALIGN_EPI = false, bool SP2 = false>
__device__ __forceinline__ void gemm_phase(PG8_LAS unsigned char* lds, const Gemm g, const Sched& S, const Epi& E, const int tid) {
    const int wid = __builtin_amdgcn_readfirstlane(tid >> 6), lane = tid & 63, wr = wid >> 2, wc = wid & 3, fr = lane & 15, fq = lane >> 4;
    const int K = g.K, nt = K / BK;
    unsigned voffA[2], voffB[2];
#pragma unroll
    for (int i = 0; i < 2; ++i) { int R, C; stage_rc(tid * 16 + i * 8192, R, C); const int Rb = Epi::PERM ? ((R & ~31) + perm32(R & 31)) : R;
        voffA[i] = (unsigned)(R * g.lda + C) * 2u; voffB[i] = (unsigned)(Rb * g.ldb + C) * 2u; }
    const size_t kstep = (size_t)(BK * 2);
    const size_t hstepA = (size_t)HALF * g.lda * 2, hstepB = (size_t)HALF * g.ldb * 2;
    const size_t tstepA = 2 * hstepA, tstepB = 2 * hstepB;
    const unsigned ldsw = (unsigned)wid * 1024u;
    const int aoff = lds_byte(wr * 64 + fr, fq * 8), boff = lds_byte(wc * 32 + fr, fq * 8);
#define PG8_SA(b, h) (((b) * 2 + (h)) * HTB)
#define PG8_SB(b, h) ((4 + (b) * 2 + (h)) * HTB)
#define PG8_STAGE(bufoff, gbase, voff) do { _Pragma("unroll") for (int _i = 0; _i < 2; ++_i) \
        __builtin_amdgcn_global_load_lds((const unsigned*)((const char*)(gbase) + (voff)[_i]), (PG8_LAS unsigned*)(lds + (bufoff) + ldsw + _i * 8192), 16, 0, 0); } while (0)
#define PG8_LDA(dst, b, h) do { _Pragma("unroll") for (int m = 0; m < 4; ++m) _Pragma("unroll") for (int k = 0; k < 2; ++k) dst[m][k] = *(const PG8_LAS bf16x8*)(lds + PG8_SA(b, h) + aoff + m * 2048 + k * 1024); } while (0)
#define PG8_LDB(dst, b, h) do { _Pragma("unroll") for (int n = 0; n < 2; ++n) _Pragma("unroll") for (int k = 0; k < 2; ++k) dst[n][k] = *(const PG8_LAS bf16x8*)(lds + PG8_SB(b, h) + boff + n * 2048 + k * 1024); } while (0)
#define PG8_MMA(ai, bj, At, Bt) do { __builtin_amdgcn_s_setprio(1); _Pragma("unroll") for (int m = 0; m < 4; ++m) _Pragma("unroll") for (int n = 0; n < 2; ++n) _Pragma("unroll") for (int k = 0; k < 2; ++k) \
        acc[ai][bj][m][n] = __builtin_amdgcn_mfma_f32_16x16x32_bf16(Bt[n][k], At[m][k], acc[ai][bj][m][n], 0, 0, 0); __builtin_amdgcn_s_setprio(0); } while (0)
#define PG8_WAIT_V(n) asm volatile("s_waitcnt vmcnt(" #n ")" ::: "memory")
#define PG8_WAIT_L(n) asm volatile("s_waitcnt lgkmcnt(" #n ")" ::: "memory")
#define PG8_BAR __builtin_amdgcn_s_barrier()
#define PG8_SCHED __builtin_amdgcn_sched_barrier(0)
    Unit cur, nxt; int ui = 0;
    if (!S.next(0, cur)) return;
    f32x4 acc[2][2][4][2];
#pragma unroll
    for (int a = 0; a < 2; ++a)
#pragma unroll
        for (int b = 0; b < 2; ++b)
#pragma unroll
            for (int m = 0; m < 4; ++m)
#pragma unroll
                for (int n = 0; n < 2; ++n) acc[a][b][m][n] = (f32x4){0.f, 0.f, 0.f, 0.f};
    bf16x8 At[4][2], B0[2][2], B1[2][2];
    const char* cA = (const char*)g.A + (size_t)cur.pm * tstepA; const char* cB = (const char*)g.Bt + (size_t)cur.pn * tstepB;
    S.a_ready(cur);
    if constexpr (SP2) {
        PG8_STAGE(PG8_SB(0, 0), cB, voffB); PG8_STAGE(PG8_SB(0, 1), cB + hstepB, voffB); PG8_STAGE(PG8_SA(0, 0), cA, voffA); PG8_STAGE(PG8_SA(0, 1), cA + hstepA, voffA);
        if (wr == 1) PG8_BAR;
        PG8_WAIT_V(2); PG8_BAR;
        PG8_STAGE(PG8_SB(1, 0), cB + kstep, voffB); PG8_STAGE(PG8_SA(1, 0), cA + kstep, voffA); PG8_STAGE(PG8_SB(1, 1), cB + hstepB + kstep, voffB);
        PG8_WAIT_V(6); PG8_BAR;
    } else {
        PG8_STAGE(PG8_SB(0, 0), cB, voffB); PG8_STAGE(PG8_SA(0, 0), cA, voffA); PG8_STAGE(PG8_SB(0, 1), cB + hstepB, voffB); PG8_STAGE(PG8_SA(0, 1), cA + hstepA, voffA);
        if (wr == 1) PG8_BAR;
        PG8_WAIT_V(4); PG8_BAR;
        PG8_STAGE(PG8_SB(1, 0), cB + kstep, voffB); PG8_STAGE(PG8_SA(1, 0), cA + kstep, voffA); PG8_STAGE(PG8_SB(1, 1), cB + hstepB + kstep, voffB);
        PG8_WAIT_V(6); PG8_BAR;
    }
    for (;;) {
        const bool has_next = S.next(ui + 1, nxt);
        const char* nA = has_next ? (const char*)g.A + (size_t)nxt.pm * tstepA : cA; const char* nB = has_next ? (const char*)g.Bt + (size_t)nxt.pn * tstepB : cB;
        for (int t = 0; t < nt; t += 2) {
            const bool last = (t == nt - 2);
            const char* a1 = cA + (size_t)(t + 1) * kstep;
            const char* a2 = last ? nA : cA + (size_t)(t + 2) * kstep; const char* b2 = last ? nB : cB + (size_t)(t + 2) * kstep;
            const char* a3 = a2 + kstep; const char* b3 = b2 + kstep;
            if (last && has_next) S.a_ready(nxt);
            if constexpr (SP2) {
            PG8_LDB(B0, 0, 0); PG8_LDB(B1, 0, 1); PG8_SCHED; PG8_LDA(At, 0, 0); PG8_STAGE(PG8_SA(1, 1), a1 + hstepA, voffA);
            PG8_WAIT_V(8); PG8_WAIT_L(0); PG8_BAR; PG8_MMA(0, 0, At, B0); PG8_MMA(0, 1, At, B1); PG8_BAR; PG8_SCHED;
            PG8_LDA(At, 0, 1); PG8_STAGE(PG8_SB(0, 0), b2, voffB); PG8_STAGE(PG8_SB(0, 1), b2 + hstepB, voffB); PG8_STAGE(PG8_SA(0, 0), a2, voffA);
            PG8_WAIT_V(8); PG8_WAIT_L(0); PG8_BAR; PG8_MMA(1, 0, At, B0); PG8_MMA(1, 1, At, B1); PG8_BAR; PG8_SCHED;
            PG8_LDB(B0, 1, 0); PG8_LDB(B1, 1, 1); PG8_SCHED; PG8_LDA(At, 1, 0); PG8_STAGE(PG8_SA(0, 1), a2 + hstepA, voffA);
            PG8_WAIT_V(8); PG8_WAIT_L(0); PG8_BAR; PG8_MMA(0, 0, At, B0); PG8_MMA(0, 1, At, B1); PG8_BAR; PG8_SCHED;
            PG8_LDA(At, 1, 1); PG8_STAGE(PG8_SB(1, 0), b3, voffB); PG8_STAGE(PG8_SB(1, 1), b3 + hstepB, voffB); PG8_STAGE(PG8_SA(1, 0), a3, voffA);
            PG8_WAIT_V(8); PG8_WAIT_L(0); PG8_BAR; PG8_MMA(1, 0, At, B0); PG8_MMA(1, 1, At, B1); PG8_BAR; PG8_SCHED;
            } else {
            PG8_LDB(B0, 0, 0); PG8_SCHED; PG8_LDA(At, 0, 0); PG8_STAGE(PG8_SA(1, 1), a1 + hstepA, voffA);
            PG8_WAIT_L(8); PG8_BAR; PG8_WAIT_L(0); PG8_MMA(0, 0, At, B0); PG8_BAR; PG8_SCHED;
            PG8_LDB(B1, 0, 1); PG8_STAGE(PG8_SB(0, 0), b2, voffB);
            PG8_BAR; PG8_WAIT_L(0); PG8_MMA(0, 1, At, B1); PG8_BAR;
            PG8_LDA(At, 0, 1); PG8_STAGE(PG8_SA(0, 0), a2, voffA);
            PG8_BAR; PG8_WAIT_L(0); PG8_MMA(1, 0, At, B0); PG8_BAR; PG8_SCHED;
            PG8_STAGE(PG8_SB(0, 1), b2 + hstepB, voffB);
            PG8_WAIT_V(6); PG8_BAR; PG8_MMA(1, 1, At, B1); PG8_BAR;
            PG8_LDB(B0, 1, 0); PG8_SCHED; PG8_LDA(At, 1, 0); PG8_STAGE(PG8_SA(0, 1), a2 + hstepA, voffA);
            PG8_WAIT_L(8); PG8_BAR; PG8_WAIT_L(0); PG8_MMA(0, 0, At, B0); PG8_BAR; PG8_SCHED;
            PG8_LDB(B1, 1, 1); PG8_STAGE(PG8_SB(1, 0), b3, voffB);
            PG8_BAR; PG8_WAIT_L(0); PG8_MMA(0, 1, At, B1); PG8_BAR;
            PG8_LDA(At, 1, 1); PG8_STAGE(PG8_SA(1, 0), a3, voffA);
            PG8_BAR; PG8_WAIT_L(0); PG8_MMA(1, 0, At, B0); PG8_BAR; PG8_SCHED;
            PG8_STAGE(PG8_SB(1, 1), b3 + hstepB, voffB);
            PG8_WAIT_V(6); PG8_BAR; PG8_MMA(1, 1, At, B1); PG8_BAR;
            }
        }
        if constexpr (ALIGN_EPI) { if (wr == 0) PG8_BAR; }
        if constexpr (!Epi::AFTER_DRAIN) { E(acc, cur, wr, wc, fr, fq); S.done(cur); }
        if (!has_next) break;
#pragma unroll
        for (int a = 0; a < 2; ++a)
#pragma unroll
            for (int b = 0; b < 2; ++b)
#pragma unroll
                for (int m = 0; m < 4; ++m)
#pragma unroll
                    for (int n = 0; n < 2; ++n) acc[a][b][m][n] = (f32x4){0.f, 0.f, 0.f, 0.f};
        cur = nxt; cA = nA; cB = nB; ++ui;
        if constexpr (ALIGN_EPI) { if (wr == 1) PG8_BAR; }
    }
    PG8_WAIT_V(0);
    if constexpr (!ALIGN_EPI) { if (wr == 0) PG8_BAR; }
    PG8_BAR;
    if constexpr (Epi::AFTER_DRAIN) { E.fused(acc, cur, wr, wc, fr, fq, lds, wid, lane); S.done(cur); }
#undef PG8_SA
#undef PG8_SB
#undef PG8_STAGE
#undef PG8_LDA
#undef PG8_LDB
#undef PG8_MMA
#undef PG8_WAIT_V
#undef PG8_WAIT_L
#undef PG8_BAR
#undef PG8_SCHED
}
}

#define GAS __attribute__((address_space(1)))
#define LAS __attribute__((address_space(3)))
typedef unsigned short bf16;
typedef unsigned v4u __attribute__((ext_vector_type(4)));
typedef float f32x4 __attribute__((ext_vector_type(4)));
typedef short bf16x8 __attribute__((ext_vector_type(8)));
typedef GAS unsigned gu32;
typedef GAS unsigned long long gu64;
#define RLX_AGENT __ATOMIC_RELAXED, __HIP_MEMORY_SCOPE_AGENT
#define LDS_WAIT() asm volatile("s_waitcnt lgkmcnt(0)" ::: "memory")
#define VM_WAIT() asm volatile("s_waitcnt vmcnt(0)" ::: "memory")
__device__ __forceinline__ unsigned long long rt() { return __builtin_amdgcn_s_memrealtime(); }
__device__ __forceinline__ unsigned f2bf(float f) { unsigned u = __builtin_bit_cast(unsigned, f); return (u + 0x7fffu + ((u >> 16) & 1u)) >> 16; }
__device__ __forceinline__ unsigned pk2(float lo, float hi) { return f2bf(lo) | (f2bf(hi) << 16); }
#define XB_TMO      128
#define XB_XCNT(j)  (256  + 64 * (j))
#define XB_XSUB(j)  (1280 + 64 * (j))
#define XB_XGEN(j)  (2304 + 64 * (j))
#define XB_TOP      3328
#define XB_TOPGEN   3392
#define XCD_BAR_WORDS 3456
#define XB_SPIN_CAP (1u << 18)

__device__ __forceinline__ unsigned xb_ld(unsigned* p)              { return __hip_atomic_load(p, __ATOMIC_RELAXED, __HIP_MEMORY_SCOPE_AGENT); }
__device__ __forceinline__ unsigned xb_add(unsigned* p, unsigned v) { return __hip_atomic_fetch_add(p, v, __ATOMIC_RELAXED, __HIP_MEMORY_SCOPE_AGENT); }
__device__ __forceinline__ unsigned xb_xcc_id() { return (unsigned)__builtin_amdgcn_s_getreg((3 << 11) | 20) & 0xFu; }
#define XB_SPIN(cond, bar) do { unsigned _sp = 0; while (cond) { __builtin_amdgcn_s_sleep(1); \
    if ((++_sp & 255u) == 0u) { if (xb_ld(&(bar)[XB_TMO])) break; if (_sp > XB_SPIN_CAP) { atomicAdd(&(bar)[XB_TMO], 1u); break; } } } } while (0)

struct XcdBarrier {
    unsigned* bar; unsigned x;
    volatile LAS unsigned* st;
};

__device__ __forceinline__ XcdBarrier xcd_barrier_post(unsigned* bar, volatile LAS unsigned* st) {
    XcdBarrier b; b.bar = bar; b.x = xb_xcc_id(); b.st = st;
    if (threadIdx.x == 0) (void)xb_add(&bar[XB_XCNT(b.x)], 1u);
    return b;
}
__device__ __forceinline__ void xcd_barrier_complete(unsigned* bar, unsigned x, unsigned& nloc, unsigned& nx) {
    const unsigned G = gridDim.x * gridDim.y * gridDim.z;
    unsigned sum, cnt, mine, sp = 0u;
    for (;;) {
        sum = 0u; cnt = 0u; mine = 0u;
#pragma unroll
        for (unsigned j = 0; j < 16; ++j) { const unsigned c = xb_ld(&bar[XB_XCNT(j)]); sum += c; cnt += (c > 0u) ? 1u : 0u; mine = (j == x) ? c : mine; }
        if (sum == G) break;
        __builtin_amdgcn_s_sleep(1);
        if ((++sp & 255u) == 0u) { if (xb_ld(&bar[XB_TMO])) break; if (sp > XB_SPIN_CAP) { atomicAdd(&bar[XB_TMO], 1u); break; } }
    }
    nloc = mine > 0u ? mine : 1u; nx = cnt > 0u ? cnt : 1u;
}

__device__ __forceinline__ void xcd_barrier(const XcdBarrier& b) {
    asm volatile("s_waitcnt vmcnt(0)" ::: "memory");
    __syncthreads();
    if (threadIdx.x == 0) {
        unsigned* bar = b.bar;
        __builtin_amdgcn_s_waitcnt(0);
        unsigned nloc = b.st[0], nx = b.st[1];
        if (nloc == 0u) { xcd_barrier_complete(bar, b.x, nloc, nx); b.st[0] = nloc; b.st[1] = nx; }
        const unsigned old = xb_add(&bar[XB_XSUB(b.x)], 1u);
        const unsigned gen = old / nloc;
        if (old + 1u == (gen + 1u) * nloc) {
            __builtin_amdgcn_fence(__ATOMIC_RELEASE, "agent");
            asm volatile("s_waitcnt vmcnt(0)" ::: "memory");
            const unsigned og = xb_add(&bar[XB_TOP], 1u);
            const unsigned tg = og / nx;
            if (og + 1u == (tg + 1u) * nx) xb_add(&bar[XB_TOPGEN], 1u);
            else XB_SPIN(xb_ld(&bar[XB_TOPGEN]) == tg, bar);
            __builtin_amdgcn_fence(__ATOMIC_ACQUIRE, "agent");
            xb_add(&bar[XB_XGEN(b.x)], 1u);
            asm volatile("s_waitcnt vmcnt(0)" ::: "memory");
        } else {
            XB_SPIN(xb_ld(&bar[XB_XGEN(b.x)]) == gen, bar);
            __builtin_amdgcn_fence(__ATOMIC_ACQUIRE, "agent");
            asm volatile("s_waitcnt vmcnt(0)" ::: "memory");
        }
    }
    __syncthreads();
}
constexpr int NWAVES = 8;
constexpr int NB = 8, SEQ = 8192, DM = 1024, CTXL = 256;
constexpr int NTOK = NB * SEQ, NCTX = NB * CTXL, MROWS = NTOK + NCTX;
constexpr int ZLD = 4352, INCOLS = 4320, DFF = 2816;
constexpr int ZQ = 0, ZF = 512, ZI = 1536, ZOG = 2048, ZR = 2560;
constexpr float ALPHA = 1.189207115f;
constexpr size_t MiB = 1u << 20;
constexpr size_t WS_CTL = 0, CTL_ZERO_BYTES = 64 * 1024;
constexpr size_t WS_MOD = 1 * MiB, WS_LB = 1 * MiB + 256 * 1024, WS_W2T = 1 * MiB + 512 * 1024, WS_A2T = WS_W2T + 64 * 1024, WS_G2T = WS_A2T + 64 * 1024;
constexpr size_t WS_WIN = 2 * MiB, WS_WOUT = 11 * MiB, WS_WGU = 13 * MiB, WS_WD = 24 * MiB, WS_SB = 30 * MiB;
constexpr size_t WS_U = 34 * MiB, WS_Z = 166 * MiB, WS_YY = 727 * MiB, WS_VL = 855 * MiB, WS_G = 919 * MiB, WS_END = 983 * MiB;
constexpr int CW_BAR = 1024;
constexpr int LDS_BYTES = 159744, MISC_OFF = 157696;
static_assert(CW_BAR * 4 + 3456 * 4 <= (int)CTL_ZERO_BYTES, "ctl");

typedef unsigned short u16;
typedef float f32x16 __attribute__((ext_vector_type(16)));
typedef float f32x2 __attribute__((ext_vector_type(2)));
typedef short s16x4 __attribute__((ext_vector_type(4)));
typedef unsigned u32x2 __attribute__((ext_vector_type(2)));
#define MFMA32(a, b, c) __builtin_amdgcn_mfma_f32_32x32x16_bf16(a, b, c, 0, 0, 0)
#define BAR() __syncthreads()
__device__ __forceinline__ int launder(int v) { asm volatile("" : "+v"(v)); return v; }
__device__ __forceinline__ float sigm(float x) { return __builtin_amdgcn_rcpf(1.0f + __expf(-x)); }
__device__ __forceinline__ float bflo(unsigned u) { return __builtin_bit_cast(float, u << 16); }
__device__ __forceinline__ float bfhi(unsigned u) { return __builtin_bit_cast(float, u & 0xffff0000u); }
__device__ __forceinline__ unsigned pkbf(float lo, float hi) { return pg8::cvt_pk_bf16(lo, hi); }
__device__ __forceinline__ float h2f(unsigned short h) { return (float)__builtin_bit_cast(_Float16, h); }
__device__ __forceinline__ int arow(int i, int h5) { return (i & 3) + 8 * (i >> 2) + 4 * h5; }
__device__ __forceinline__ bf16x8 frag_kc(const LAS u16* X, int ld, int idx0, int k0, int lane) {
    return *(const LAS bf16x8*)(X + (idx0 + (lane & 31)) * ld + k0 + 8 * (lane >> 5));
}
__device__ __forceinline__ bf16x8 frag_tr(const LAS u16* X, int ld, int idx0, int k0, int lane) {
    const int g = lane >> 4, q = (lane >> 2) & 3, p = lane & 3;
    const LAS u16* a = X + (k0 + 8 * (g >> 1) + q) * ld + idx0 + 16 * (g & 1) + 4 * p;
    const s16x4 lo = __builtin_bit_cast(s16x4, __builtin_amdgcn_ds_read_tr16_b64_v4i16((LAS s16x4*)a));
    const s16x4 hi = __builtin_bit_cast(s16x4, __builtin_amdgcn_ds_read_tr16_b64_v4i16((LAS s16x4*)(a + 4 * ld)));
    return (bf16x8){lo[0], lo[1], lo[2], lo[3], hi[0], hi[1], hi[2], hi[3]};
}
__device__ __forceinline__ void st_tile_T(LAS u16* D, int ld, int row0, int col0, const f32x16& a, int lane) {
    LAS u16* p = D + (col0 + (lane & 31)) * ld + row0 + 4 * (lane >> 5);
#pragma unroll
    for (int g = 0; g < 4; ++g) { u32x2 w; w.x = pkbf(a[4 * g], a[4 * g + 1]); w.y = pkbf(a[4 * g + 2], a[4 * g + 3]); *(LAS u32x2*)(p + 8 * g) = w; }
}
__device__ __forceinline__ f32x16 zero16() { f32x16 z;
#pragma unroll
    for (int i = 0; i < 16; ++i) z[i] = 0.f; return z; }

__device__ __forceinline__ void transpose_item(const float* W, int N, u16* WT, int ldw, int k0, int n0, int drow0, LAS float* scr, int lane) {
#pragma unroll 8
    for (int i = 0; i < 32; ++i) { const int kk = 2 * i + (lane >> 5); scr[kk * 33 + (lane & 31)] = W[(size_t)(k0 + kk) * N + n0 + (lane & 31)]; }
    LDS_WAIT(); asm volatile("" ::: "memory");
    const int c = lane & 7;
#pragma unroll
    for (int j = 0; j < 4; ++j) { const int n = (lane >> 3) + 8 * j; const LAS float* s = scr + (8 * c) * 33 + n;
        v4u o; o.x = pkbf(s[0 * 33], s[1 * 33]); o.y = pkbf(s[2 * 33], s[3 * 33]); o.z = pkbf(s[4 * 33], s[5 * 33]); o.w = pkbf(s[6 * 33], s[7 * 33]);
        *(v4u*)(WT + (size_t)(drow0 + n) * ldw + k0 + 8 * c) = o; }
    LDS_WAIT(); asm volatile("" ::: "memory");
}
struct Params {
    const float *x, *c, *ctx, *c_ctx, *w_ada, *b_ada, *w_in, *lb_logits, *hg_norm_w, *mu, *w0, *w2, *a0, *a2, *g2, *kkw, *kaw, *rkw, *lnxw, *lnxb, *w_out, *ln1g, *ln1b, *wg, *wu, *wd, *ln2g, *ln2b;
    float* out; unsigned char* ws;
};
__device__ __forceinline__ void phase0a(const Params& p, LAS unsigned char* lds, int tid, int lane, int wave, int bid, int G) {
    float* mod = (float*)(p.ws + WS_MOD);
    for (int cb = bid; cb < 48; cb += G) {
        LAS float* sc = (LAS float*)lds; LAS float* red = sc + 9 * 1024;
        for (int i = tid; i < 9 * 1024; i += 512) { const int b = i >> 10, d = i & 1023; const float xv = b < 8 ? p.c[b * 1024 + d] : p.c_ctx[d]; sc[i] = xv * sigm(xv); }
        BAR();
        const int cl = tid & 127, dq = tid >> 7, col = cb * 128 + cl;
        float acc[9];
#pragma unroll
        for (int b = 0; b < 9; ++b) acc[b] = 0.f;
        for (int d = dq * 256; d < dq * 256 + 256; ++d) { const float w = p.w_ada[(size_t)d * 6144 + col];
#pragma unroll
            for (int b = 0; b < 9; ++b) acc[b] += sc[b * 1024 + d] * w; }
#pragma unroll
        for (int b = 0; b < 9; ++b) red[(dq * 9 + b) * 128 + cl] = acc[b];
        BAR();
        if (tid < 128) {
#pragma unroll
            for (int b = 0; b < 9; ++b) mod[b * 6144 + col] = ((red[(0 * 9 + b) * 128 + cl] + red[(1 * 9 + b) * 128 + cl]) + (red[(2 * 9 + b) * 128 + cl] + red[(3 * 9 + b) * 128 + cl])) + p.b_ada[col];
        }
        BAR();
    }
    {
        float* lb = (float*)(p.ws + WS_LB); u16* w2t = (u16*)(p.ws + WS_W2T); u16* a2t = (u16*)(p.ws + WS_A2T); u16* g2t = (u16*)(p.ws + WS_G2T); u16* wint = (u16*)(p.ws + WS_WIN);
        const int gt = bid * 512 + tid, GT = G * 512;
        for (int i = gt; i < 1024; i += GT) lb[i] = sigm(p.lb_logits[i] - p.lb_logits[1024 + i]);
        for (int i = gt; i < 2 * 512 * 32; i += GT) { const int l = i & 31, c = (i >> 5) & 511, d = i >> 14; const float a = p.w2[(d * 32 + l) * 512 + c], b = p.a2[(d * 32 + l) * 512 + c];
            w2t[i] = (u16)(pkbf(a, 0.f) & 0xffffu); a2t[i] = (u16)(pkbf(b, 0.f) & 0xffffu); }
        for (int i = gt; i < 512 * 96; i += GT) { const int l = i % 96, c = i / 96; g2t[i] = (u16)(pkbf(p.g2[l * 512 + c], 0.f) & 0xffffu); }
        for (int i = gt; i < 32 * 1024 / 2; i += GT) ((unsigned*)(wint + (size_t)INCOLS * 1024))[i] = 0u;
    }
    {
        LAS float* scr = (LAS float*)(lds + 65536 + wave * 8704);
        const int gw = bid * NWAVES + wave, NGW = G * NWAVES;
        constexpr int I_IN = 16 * 135, I_OUT = 16 * 32, I_G = 16 * 88, I_D = 44 * 32, NITEMS = I_IN + I_OUT + 2 * I_G + I_D;
        u16* wint = (u16*)(p.ws + WS_WIN); u16* woutt = (u16*)(p.ws + WS_WOUT); u16* wgut = (u16*)(p.ws + WS_WGU); u16* wdt = (u16*)(p.ws + WS_WD);
        for (int it = gw; it < NITEMS; it += NGW) {
            int r = it;
            if (r < I_IN) { const int kb = r / 135, nb = r % 135; transpose_item(p.w_in, INCOLS, wint, 1024, 64 * kb, 32 * nb, 32 * nb, scr, lane); continue; } r -= I_IN;
            if (r < I_OUT) { const int kb = r / 32, nb = r % 32; transpose_item(p.w_out, 1024, woutt, 1024, 64 * kb, 32 * nb, 32 * nb, scr, lane); continue; } r -= I_OUT;
            if (r < I_G) { const int kb = r / 88, nb = r % 88, n0 = 32 * nb; transpose_item(p.wg, DFF, wgut, 1024, 64 * kb, n0, 256 * (n0 >> 7) + (n0 & 127), scr, lane); continue; } r -= I_G;
            if (r < I_G) { const int kb = r / 88, nb = r % 88, n0 = 32 * nb; transpose_item(p.wu, DFF, wgut, 1024, 64 * kb, n0, 256 * (n0 >> 7) + 128 + (n0 & 127), scr, lane); continue; } r -= I_G;
            { const int kb = r / 32, nb = r % 32; transpose_item(p.wd, 1024, wdt, DFF, 64 * kb, 32 * nb, 32 * nb, scr, lane); }
        }
    }
}
__device__ __forceinline__ float wave_sum(float v) {
#pragma unroll
    for (int o = 1; o < 64; o <<= 1) v += __shfl_xor(v, o);
    return v;
}
__device__ __forceinline__ void phase0b(const Params& p, int lane, int wave, int bid, int G) {
    const float* mod = (const float*)(p.ws + WS_MOD); u16* U = (u16*)(p.ws + WS_U);
    const int gw = bid * NWAVES + wave, NGW = G * NWAVES;
    for (int m = gw; m < MROWS; m += NGW) {
        const float* xrow = m < NTOK ? p.x + (size_t)m * DM : p.ctx + (size_t)(m - NTOK) * DM;
        const int mb = m < NTOK ? (m >> 13) : 8;
        const f32x4* xr = (const f32x4*)xrow + lane; f32x4 v[4]; float s = 0.f;
#pragma unroll
        for (int j = 0; j < 4; ++j) { v[j] = xr[64 * j]; s += (v[j].x + v[j].y) + (v[j].z + v[j].w); }
        const float mean = wave_sum(s) * (1.f / DM); float s2 = 0.f;
#pragma unroll
        for (int j = 0; j < 4; ++j) { v[j] = v[j] - mean; s2 += (v[j].x * v[j].x + v[j].y * v[j].y) + (v[j].z * v[j].z + v[j].w * v[j].w); }
        const float rstd = 1.f / sqrtf(wave_sum(s2) * (1.f / DM) + 1e-6f);
        const f32x4* sh = (const f32x4*)(mod + mb * 6144) + lane; const f32x4* scp = (const f32x4*)(mod + mb * 6144 + 1024) + lane;
        u32x2* o8 = (u32x2*)(U + (size_t)m * DM) + lane;
#pragma unroll
        for (int j = 0; j < 4; ++j) { const f32x4 a = sh[64 * j], b = scp[64 * j]; const f32x4 r = v[j] * rstd * (b + 1.0f) + a; u32x2 w; w.x = pkbf(r.x, r.y); w.y = pkbf(r.z, r.w); o8[64 * j] = w; }
    }
}
__device__ __forceinline__ void chain_chunk(int n, int dir, int b, bool& isctx, int& tbase, long& rowbase) {
    isctx = n < 4;
    if (isctx) { const int cc = dir ? 3 - n : n; tbase = cc * 64; rowbase = (long)NTOK + b * CTXL + tbase; }
    else { const int xc = dir ? 127 - (n - 4) : n - 4; tbase = xc * 64; rowbase = (long)b * SEQ + tbase; }
}
constexpr int HG_LD = 136;
constexpr int HG_QT = 0, HG_KT = 17408, HG_VV = 34816, HG_ST = 52224, HG_PT = 87040, HG_TOT = 96256, HG_EM = 100352, HG_EE = 100864, HG_DD = 101376;
__device__ __forceinline__ void hgrn_chain(const Params& p, LAS unsigned char* lds, int tid, int lane_in, int wave, int b, int h, int dir) {
    const u16* Z = (const u16*)(p.ws + WS_Z); u16* O = (u16*)(p.ws + WS_U);
    LAS u16* QT = (LAS u16*)(lds + HG_QT); LAS u16* KT = (LAS u16*)(lds + HG_KT); LAS u16* VV = (LAS u16*)(lds + HG_VV); LAS u16* ST = (LAS u16*)(lds + HG_ST); LAS u16* PT = (LAS u16*)(lds + HG_PT);
    LAS float* TOT = (LAS float*)(lds + HG_TOT); LAS float* EM = (LAS float*)(lds + HG_EM); LAS float* EE = (LAS float*)(lds + HG_EE); LAS float* DD = (LAS float*)(lds + HG_DD);
    const int kb = wave >> 1, vb0 = 2 * (wave & 1);
    const int oti = wave >> 2, ovi = wave & 3;
    f32x16 S0 = zero16(), S1 = zero16();
    for (int n = 0; n < 132; ++n) {
        bool isctx; int tbase; long rowbase; chain_chunk(n, dir, b, isctx, tbase, rowbase);
        const int lane = launder(tid) & 63, h5 = lane >> 5, r = lane & 31;
        float qv[8][2], kc[8][2], bb[8][2]; float cum0 = 0.f, cum1 = 0.f;
#pragma unroll
        for (int i = 0; i < 8; ++i) {
            const int j = 8 * wave + i; const long row = rowbase + (dir ? 63 - j : j);
            const u16* zr = Z + row * ZLD;
            const unsigned uq = *(const unsigned*)(zr + ZQ + h * 128 + 2 * lane), uf = *(const unsigned*)(zr + ZF + 512 * dir + h * 128 + 2 * lane), uv = *(const unsigned*)(zr + ZI + h * 128 + 2 * lane);
            *(LAS unsigned*)(VV + j * HG_LD + 2 * lane) = uv;
            const float l0 = h2f((unsigned short)(uf & 0xffffu)), l1 = h2f((unsigned short)(uf >> 16));
            qv[i][0] = bflo(uq); qv[i][1] = bfhi(uq);
            kc[i][0] = 1.0f - __expf(l0); kc[i][1] = 1.0f - __expf(l1);
            cum0 += l0; cum1 += l1; bb[i][0] = cum0; bb[i][1] = cum1;
        }
        *(LAS f32x2*)(TOT + wave * 128 + 2 * lane) = (f32x2){cum0, cum1};
        BAR();
        float base0 = 0.f, base1 = 0.f, m0 = 0.f, m1 = 0.f, t0 = 0.f, t1 = 0.f;
#pragma unroll
        for (int w = 0; w < 8; ++w) { const f32x2 t = *(const LAS f32x2*)(TOT + w * 128 + 2 * lane);
            if (w < wave) { base0 += t.x; base1 += t.y; } if (w < 4) { m0 += t.x; m1 += t.y; } t0 += t.x; t1 += t.y; }
#pragma unroll
        for (int i = 0; i < 8; ++i) {
            const int j = 8 * wave + i;
            const float e0 = __expf(base0 + bb[i][0] - m0), e1 = __expf(base1 + bb[i][1] - m1);
            *(LAS unsigned*)(QT + j * HG_LD + 2 * lane) = pkbf(qv[i][0] * e0, qv[i][1] * e1);
            *(LAS unsigned*)(KT + j * HG_LD + 2 * lane) = pkbf(kc[i][0] * __builtin_amdgcn_rcpf(e0), kc[i][1] * __builtin_amdgcn_rcpf(e1));
        }
        if (wave == 0) { *(LAS f32x2*)(EM + 2 * lane) = (f32x2){__expf(m0), __expf(m1)}; *(LAS f32x2*)(EE + 2 * lane) = (f32x2){__expf(t0 - m0), __expf(t1 - m1)}; *(LAS f32x2*)(DD + 2 * lane) = (f32x2){__expf(t0), __expf(t1)}; }
        BAR();
#pragma unroll
        for (int tt = 0; tt < 2; ++tt) {
            f32x16 sc = tt ? S1 : S0;
#pragma unroll
            for (int g = 0; g < 4; ++g) { const f32x4 em = *(const LAS f32x4*)(EM + 32 * kb + 8 * g + 4 * h5);
#pragma unroll
                for (int e = 0; e < 4; ++e) sc[4 * g + e] *= em[e]; }
            st_tile_T(ST, HG_LD, 32 * kb, 32 * (vb0 + tt), sc, lane);
        }
        if (wave < 3) {
            const int ti = wave >= 1 ? 1 : 0, si = wave == 2 ? 1 : 0;
            f32x16 a = zero16();
#pragma unroll
            for (int ks = 0; ks < 8; ++ks) a = MFMA32(frag_kc(QT, HG_LD, 32 * ti, 16 * ks, lane), frag_kc(KT, HG_LD, 32 * si, 16 * ks, lane), a);
#pragma unroll
            for (int i = 0; i < 16; ++i) { const int t = 32 * ti + arow(i, h5), s = 32 * si + r; if (s > t) a[i] = 0.f; }
            st_tile_T(PT, 72, 32 * ti, 32 * si, a, lane);
        }
        BAR();
        f32x16 o = zero16();
#pragma unroll
        for (int ks = 0; ks < 8; ++ks) o = MFMA32(frag_kc(QT, HG_LD, 32 * oti, 16 * ks, lane), frag_kc(ST, HG_LD, 32 * ovi, 16 * ks, lane), o);
#pragma unroll
        for (int ks = 0; ks < 4; ++ks) if (ks < 2 * (oti + 1)) o = MFMA32(frag_tr(PT, 72, 32 * oti, 16 * ks, lane), frag_tr(VV, HG_LD, 32 * ovi, 16 * ks, lane), o);
        if (!isctx) {
#pragma unroll
            for (int i = 0; i < 16; ++i) { const int j = 32 * oti + arow(i, h5); const long row = rowbase + (dir ? 63 - j : j);
                O[row * 1024 + dir * 512 + h * 128 + 32 * ovi + r] = (u16)(pkbf(o[i], 0.f) & 0xffffu); }
        }
#pragma unroll
        for (int tt = 0; tt < 2; ++tt) {
            f32x16 g = zero16();
#pragma unroll
            for (int ks = 0; ks < 4; ++ks) g = MFMA32(frag_tr(KT, HG_LD, 32 * kb, 16 * ks, lane), frag_tr(VV, HG_LD, 32 * (vb0 + tt), 16 * ks, lane), g);
#pragma unroll
            for (int gq = 0; gq < 4; ++gq) { const f32x4 dd = *(const LAS f32x4*)(DD + 32 * kb + 8 * gq + 4 * h5), ee = *(const LAS f32x4*)(EE + 32 * kb + 8 * gq + 4 * h5);
#pragma unroll
                for (int e = 0; e < 4; ++e) { if (tt) S1[4 * gq + e] = dd[e] * S1[4 * gq + e] + ee[e] * g[4 * gq + e]; else S0[4 * gq + e] = dd[e] * S0[4 * gq + e] + ee[e] * g[4 * gq + e]; } }
        }
        BAR();
    }
}
constexpr int RW_W2 = 0, RW_A2 = 5120, RW_WD = 10240, RW_AD = 15360, RW_GS = 20480, RW_WP = 33792, RW_AP = 50688, RW_TOT = 67584;
constexpr int RW_LF = 10240, RW_TB = 27648, RW_LB = 36864, RW_AAK = 46080, RW_ARB = 55296, RW_ARK = 64512;
constexpr int RW_AT = 73728, RW_BT = 82944, RW_KT = 92160, RW_RT = 101376, RW_BP = 110592, RW_KP = 119808, RW_VV = 129024, RW_PC = 138240, RW_TMP = 138496, RW_SBT = 143616;
constexpr int RW_XB = RW_BT, RW_UB = RW_KT;
#ifdef DBG_RW
__device__ __forceinline__ bool badv(const f32x16& a) { bool b = false;
#pragma unroll
    for (int i = 0; i < 16; ++i) b |= !(fabsf(a[i]) < 1e30f); return b; }
#define DBG_CHK(code, cond) do { if (__any(cond)) { if (mybad > (code)) mybad = (code); } } while (0)
#else
#define DBG_CHK(code, cond) do { } while (0)
#endif
__device__ __forceinline__ long nbr_row(bool isctx, int quarter, long row, int tloc, bool& valid) {
    if (isctx) { if (quarter < 2) { valid = tloc > 0; return row - 1; } valid = tloc < CTXL - 1; return row + 1; }
    if (quarter == 0) { valid = (tloc & 63) > 0; return row - 1; }
    if (quarter == 1) { valid = (tloc & 63) < 63; return row + 1; }
    if (quarter == 2) { valid = tloc >= 64; return row - 64; }
    valid = tloc < SEQ - 64; return row + 64;
}
__device__ __forceinline__ void rwkv_chain(const Params& p, LAS unsigned char* lds, int tid, int lane_in, int wave, int b, int h, int dir) {
    const u16* Z = (const u16*)(p.ws + WS_Z); u16* YY = (u16*)(p.ws + WS_YY); u16* VL = (u16*)(p.ws + WS_VL); u16* GG = (u16*)(p.ws + WS_G); float* SBv = (float*)(p.ws + WS_SB);
    const u16* G2T = (const u16*)(p.ws + WS_G2T);
#ifdef DBG_RW
    unsigned char* lds_raw_dbg = (unsigned char*)lds;
#endif
    LAS u16* W2s = (LAS u16*)(lds + RW_W2); LAS u16* A2s = (LAS u16*)(lds + RW_A2); LAS u16* WDs = (LAS u16*)(lds + RW_WD); LAS u16* ADs = (LAS u16*)(lds + RW_AD); LAS u16* GSs = (LAS u16*)(lds + RW_GS);
    LAS float* WP = (LAS float*)(lds + RW_WP); LAS float* AP = (LAS float*)(lds + RW_AP); LAS float* TOT = (LAS float*)(lds + RW_TOT); LAS float* PC = (LAS float*)(lds + RW_PC);
    LAS float* LF = (LAS float*)(lds + RW_LF); LAS u16* TB = (LAS u16*)(lds + RW_TB); LAS u16* LB = (LAS u16*)(lds + RW_LB);
    LAS u16* AAK = (LAS u16*)(lds + RW_AAK); LAS u16* ARB = (LAS u16*)(lds + RW_ARB); LAS u16* ARK = (LAS u16*)(lds + RW_ARK);
    LAS u16* ATs = (LAS u16*)(lds + RW_AT); LAS u16* BTs = (LAS u16*)(lds + RW_BT); LAS u16* KTs = (LAS u16*)(lds + RW_KT); LAS u16* RTs = (LAS u16*)(lds + RW_RT);
    LAS u16* BPs = (LAS u16*)(lds + RW_BP); LAS u16* KPs = (LAS u16*)(lds + RW_KP); LAS u16* VVs = (LAS u16*)(lds + RW_VV); LAS u16* TMP = (LAS u16*)(lds + RW_TMP); LAS u16* SBT = (LAS u16*)(lds + RW_SBT);
    LAS u16* XB = (LAS u16*)(lds + RW_XB); LAS u16* UB = (LAS u16*)(lds + RW_UB);
    const int t2 = (wave & 3) >> 1, c2 = wave & 1;
    {   const u16* w2t = (const u16*)(p.ws + WS_W2T) + (size_t)(dir * 512 + h * 64) * 32; const u16* a2t = (const u16*)(p.ws + WS_A2T) + (size_t)(dir * 512 + h * 64) * 32;
        for (int i = tid; i < 64 * 32; i += 512) { const int c = i >> 5, l = i & 31; W2s[c * 40 + l] = w2t[i]; A2s[c * 40 + l] = a2t[i]; } }
    const int hc0 = h * 64 + 2 * (lane_in & 31), cg0 = tid & 7;
    const float mur0 = p.mu[hc0], mur1 = p.mu[hc0 + 1], muk0 = p.mu[512 + hc0], muk1 = p.mu[512 + hc0 + 1], muv0 = p.mu[1024 + hc0], muv1 = p.mu[1024 + hc0 + 1];
    const int qr = hc0 / 440, qk = (512 + hc0) / 440, qv = (1024 + hc0) / 440;
    const float w00 = p.w0[dir * 512 + hc0], w01 = p.w0[dir * 512 + hc0 + 1], a00 = p.a0[dir * 512 + hc0], a01 = p.a0[dir * 512 + hc0 + 1];
    const float kk0 = p.kkw[hc0], kk1 = p.kkw[hc0 + 1], ka0 = p.kaw[hc0], ka1 = p.kaw[hc0 + 1], rk0 = p.rkw[hc0], rk1 = p.rkw[hc0 + 1];
    f32x4 muw, mua;
#pragma unroll
    for (int e = 0; e < 4; ++e) { muw[e] = p.mu[1536 + dir * 32 + 4 * cg0 + e]; mua[e] = p.mu[1600 + dir * 32 + 4 * cg0 + e]; }
    f32x16 S = zero16();
    BAR();
    for (int n = 0; n < 132; ++n) {
        bool isctx; int tbase; long rowbase; chain_chunk(n, dir, b, isctx, tbase, rowbase);
        const bool wr_out = !isctx, do_g = (!isctx) && (dir == 0);
        const int ltid = launder(tid), lane = ltid & 63, h5 = lane >> 5, r = lane & 31;
        const int tg = ltid >> 5, c0 = 2 * r, hc = h * 64 + c0;
        const int tok8 = ltid >> 3, cg = ltid & 7;
#ifdef DBG_RW
        volatile LAS unsigned* dbgw = (volatile LAS unsigned*)(lds + MISC_OFF + 64); int mybad = 99; if (tid == 0 && n == 0) { dbgw[1] = 9999u; dbgw[2] = 0u; }
        BAR();
        DBG_CHK(1, wave < 4 && badv(S));
#endif
        float rv[4][2], kv[4][2], vv[4][2];
#pragma unroll
        for (int i = 0; i < 4; ++i) {
            const int j = 4 * tg + i, tl = dir ? 63 - j : j; const long row = rowbase + tl; const int tloc = tbase + tl;
            bool v0, v1, v2; const long n0 = nbr_row(isctx, qr, row, tloc, v0), n1 = nbr_row(isctx, qk, row, tloc, v1), n2 = nbr_row(isctx, qv, row, tloc, v2);
            const u16* zc = Z + row * ZLD + ZR + hc;
            const unsigned ur = *(const unsigned*)zc, uk = *(const unsigned*)(zc + 512), uv = *(const unsigned*)(zc + 1024);
            const unsigned nr = v0 ? *(const unsigned*)(Z + n0 * ZLD + ZR + hc) : 0u, nk = v1 ? *(const unsigned*)(Z + n1 * ZLD + ZR + 512 + hc) : 0u, nv = v2 ? *(const unsigned*)(Z + n2 * ZLD + ZR + 1024 + hc) : 0u;
            rv[i][0] = bflo(ur) + mur0 * (bflo(nr) - bflo(ur)); rv[i][1] = bfhi(ur) + mur1 * (bfhi(nr) - bfhi(ur));
            kv[i][0] = bflo(uk) + muk0 * (bflo(nk) - bflo(uk)); kv[i][1] = bfhi(uk) + muk1 * (bfhi(nk) - bfhi(uk));
            vv[i][0] = bflo(uv) + muv0 * (bflo(nv) - bflo(uv)); vv[i][1] = bfhi(uv) + muv1 * (bfhi(nv) - bfhi(uv));
            if (do_g) *(unsigned*)(VL + row * 512 + hc) = pkbf(vv[i][0], vv[i][1]);
        }
        {
            const int j = tok8, tl = dir ? 63 - j : j; const long row = rowbase + tl; const int tloc = tbase + tl;
            bool vd; const long nd = nbr_row(isctx, 3, row, tloc, vd);
            const u16* zc = Z + row * ZLD + ZR; const u16* zn = Z + nd * ZLD + ZR;
            const u32x2 cw = *(const u32x2*)(zc + 1536 + dir * 32 + 4 * cg), ca = *(const u32x2*)(zc + 1600 + dir * 32 + 4 * cg);
            u32x2 nw = (u32x2){0u, 0u}, na = nw; if (vd) { nw = *(const u32x2*)(zn + 1536 + dir * 32 + 4 * cg); na = *(const u32x2*)(zn + 1600 + dir * 32 + 4 * cg); }
            float wl[4], al[4];
            wl[0] = bflo(cw.x) + muw[0] * (bflo(nw.x) - bflo(cw.x)); wl[1] = bfhi(cw.x) + muw[1] * (bfhi(nw.x) - bfhi(cw.x)); wl[2] = bflo(cw.y) + muw[2] * (bflo(nw.y) - bflo(cw.y)); wl[3] = bfhi(cw.y) + muw[3] * (bfhi(nw.y) - bfhi(cw.y));
            al[0] = bflo(ca.x) + mua[0] * (bflo(na.x) - bflo(ca.x)); al[1] = bfhi(ca.x) + mua[1] * (bfhi(na.x) - bfhi(ca.x)); al[2] = bflo(ca.y) + mua[2] * (bflo(na.y) - bflo(ca.y)); al[3] = bfhi(ca.y) + mua[3] * (bfhi(na.y) - bfhi(ca.y));
#pragma unroll
            for (int e = 0; e < 4; ++e) wl[e] = 1.0f - 2.0f * __builtin_amdgcn_rcpf(1.0f + __expf(2.0f * wl[e]));
            *(LAS u32x2*)(WDs + j * 40 + 4 * cg) = (u32x2){pkbf(wl[0], wl[1]), pkbf(wl[2], wl[3])};
            *(LAS u32x2*)(ADs + j * 40 + 4 * cg) = (u32x2){pkbf(al[0], al[1]), pkbf(al[2], al[3])};
            if (do_g) {
#pragma unroll
                for (int k3 = 0; k3 < 3; ++k3) { const int gc = 1664 + 12 * cg + 4 * k3;
                    const u32x2 cgd = *(const u32x2*)(zc + gc); u32x2 ngd = (u32x2){0u, 0u}; if (vd) ngd = *(const u32x2*)(zn + gc);
                    const f32x4 mg = *(const f32x4*)(p.mu + gc);
                    const float g0 = bflo(cgd.x) + mg[0] * (bflo(ngd.x) - bflo(cgd.x)), g1 = bfhi(cgd.x) + mg[1] * (bfhi(ngd.x) - bfhi(cgd.x)), g2 = bflo(cgd.y) + mg[2] * (bflo(ngd.y) - bflo(cgd.y)), g3 = bfhi(cgd.y) + mg[3] * (bfhi(ngd.y) - bfhi(cgd.y));
                    *(LAS u32x2*)(GSs + j * 104 + 12 * cg + 4 * k3) = (u32x2){pkbf(sigm(g0), sigm(g1)), pkbf(sigm(g2), sigm(g3))}; }
            }
        }
        BAR();
        {
            const LAS u16* Xs = wave < 4 ? WDs : ADs; const LAS u16* Ws = wave < 4 ? W2s : A2s; LAS float* Dst = wave < 4 ? WP : AP;
            f32x16 a = zero16();
#pragma unroll
            for (int ks = 0; ks < 2; ++ks) a = MFMA32(frag_kc(Xs, 40, 32 * t2, 16 * ks, lane), frag_kc(Ws, 40, 32 * c2, 16 * ks, lane), a);
            DBG_CHK(2, badv(a));
#pragma unroll
            for (int i = 0; i < 16; ++i) Dst[(32 * t2 + arow(i, h5)) * 66 + 32 * c2 + r] = a[i];
            if (do_g && wave >= 4) {
                f32x16 g = zero16();
#pragma unroll
                for (int ks = 0; ks < 6; ++ks) { const bf16x8 bfr = *(const bf16x8*)(G2T + (size_t)(h * 64 + 32 * c2 + r) * 96 + 16 * ks + 8 * h5);
                    g = MFMA32(frag_kc(GSs, 104, 32 * t2, 16 * ks, lane), bfr, g); }
#pragma unroll
                for (int i = 0; i < 16; ++i) { const long row = rowbase + 32 * t2 + arow(i, h5); GG[row * 512 + h * 64 + 32 * c2 + r] = (u16)(pkbf(g[i], 0.f) & 0xffffu); }
            }
        }
        BAR();
        if (wave < 4) st_tile_T(SBT, 72, 32 * t2, 32 * c2, S, lane);
        float lw[4][2], av[4][2], bv[4][2], kd[4][2], cl[4][2]; float cum0 = 0.f, cum1 = 0.f;
#pragma unroll
        for (int i = 0; i < 4; ++i) {
            const int j = 4 * tg + i;
            const f32x2 wp = *(const LAS f32x2*)(WP + j * 66 + c0), ap = *(const LAS f32x2*)(AP + j * 66 + c0);
            lw[i][0] = -0.6065306597f * sigm(wp.x + w00); lw[i][1] = -0.6065306597f * sigm(wp.y + w01);
            const float ag0 = sigm(ap.x + a00), ag1 = sigm(ap.y + a01);
            float k0 = kv[i][0] * kk0, k1 = kv[i][1] * kk1; float ss = k0 * k0 + k1 * k1;
            kd[i][0] = kv[i][0] * (1.0f + (ag0 - 1.0f) * ka0); kd[i][1] = kv[i][1] * (1.0f + (ag1 - 1.0f) * ka1);
            float sb = rv[i][0] * kd[i][0] * rk0 + rv[i][1] * kd[i][1] * rk1;
#pragma unroll
            for (int o = 1; o < 32; o <<= 1) { ss += __shfl_xor(ss, o); sb += __shfl_xor(sb, o); }
            const float inv = 1.0f / fmaxf(sqrtf(ss), 1e-12f); k0 *= inv; k1 *= inv;
            av[i][0] = -k0; av[i][1] = -k1; bv[i][0] = k0 * ag0; bv[i][1] = k1 * ag1;
            cum0 += lw[i][0]; cum1 += lw[i][1]; cl[i][0] = cum0; cl[i][1] = cum1;
            if (wr_out && r == 0) { const int tl = dir ? 63 - j : j; SBv[((size_t)dir * NTOK + rowbase + tl) * 8 + h] = sb; }
        }
        *(LAS f32x2*)(TOT + tg * 64 + c0) = (f32x2){cum0, cum1};
        BAR();
        float base0 = 0.f, base1 = 0.f, tt0 = 0.f, tt1 = 0.f;
#pragma unroll
        for (int g = 0; g < 16; ++g) { const f32x2 t = *(const LAS f32x2*)(TOT + g * 64 + c0); if (g < tg) { base0 += t.x; base1 += t.y; } tt0 += t.x; tt1 += t.y; }
#pragma unroll
        for (int i = 0; i < 4; ++i) {
            const int j = 4 * tg + i;
            const float cs0 = base0 + cl[i][0], cs1 = base1 + cl[i][1];
            const float E0 = __expf(cs0), E1 = __expf(cs1), I0 = __builtin_amdgcn_rcpf(E0), I1 = __builtin_amdgcn_rcpf(E1);
            const float X0 = __expf(cs0 - lw[i][0]), X1 = __expf(cs1 - lw[i][1]), P0 = __expf(tt0 - cs0), P1 = __expf(tt1 - cs1);
            *(LAS unsigned*)(ATs + j * 72 + c0) = pkbf(av[i][0] * X0, av[i][1] * X1);
            *(LAS unsigned*)(BTs + j * 72 + c0) = pkbf(bv[i][0] * I0, bv[i][1] * I1);
            *(LAS unsigned*)(KTs + j * 72 + c0) = pkbf(kd[i][0] * I0, kd[i][1] * I1);
            *(LAS unsigned*)(RTs + j * 72 + c0) = pkbf(rv[i][0] * E0, rv[i][1] * E1);
            *(LAS unsigned*)(BPs + j * 72 + c0) = pkbf(bv[i][0] * P0, bv[i][1] * P1);
            *(LAS unsigned*)(KPs + j * 72 + c0) = pkbf(kd[i][0] * P0, kd[i][1] * P1);
            *(LAS unsigned*)(VVs + j * 72 + c0) = pkbf(vv[i][0], vv[i][1]);
            DBG_CHK(3, !(fabsf(av[i][0] * X0) < 1e30f) || !(fabsf(bv[i][0] * I0) < 1e30f) || !(fabsf(kd[i][0] * I0) < 1e30f) || !(fabsf(rv[i][0] * E0) < 1e30f) || !(fabsf(bv[i][1] * P1) < 1e30f) || !(fabsf(kd[i][1] * P1) < 1e30f) || !(fabsf(vv[i][0]) < 1e30f));
        }
        if (tg == 0) *(LAS f32x2*)(PC + c0) = (f32x2){__expf(tt0), __expf(tt1)};
        BAR();
        {
            const int mtx = wave & 3; const LAS u16* Am = mtx < 2 ? ATs : RTs; const LAS u16* Bm = (mtx & 1) ? KTs : BTs; LAS u16* Dm = (LAS u16*)(lds + RW_LB + 9216 * mtx);
            const int ntile = wave < 4 ? 2 : 1;
#pragma unroll
            for (int q = 0; q < 2; ++q) if (q < ntile) {
                const int ti = wave < 4 ? 1 - q : 1, ii = wave < 4 ? 0 : 1;
                f32x16 a = zero16();
#pragma unroll
                for (int ks = 0; ks < 4; ++ks) a = MFMA32(frag_kc(Am, 72, 32 * ti, 16 * ks, lane), frag_kc(Bm, 72, 32 * ii, 16 * ks, lane), a);
#pragma unroll
                for (int i = 0; i < 16; ++i) { const int t = 32 * ti + arow(i, h5), ic = 32 * ii + r; const bool keep = mtx < 2 ? (ic < t) : (ic <= t); if (!keep) a[i] = 0.f; }
                DBG_CHK(4, badv(a));
                st_tile_T(Dm, 72, 32 * ti, 32 * ii, a, lane);
                if (mtx == 0) {
#pragma unroll
                    for (int i = 0; i < 16; ++i) LF[(32 * ti + arow(i, h5)) * 68 + 32 * ii + r] = a[i];
                }
            }
        }
        BAR();
        f32x16 acc = zero16();
        if (wave == 0) {
            const int bi = lane >> 4, jj = lane & 15; float Td[16];
#pragma unroll
            for (int i = 0; i < 16; ++i) {
                float s = (i == jj) ? 1.0f : 0.0f;
                const LAS float* Lr = LF + (16 * bi + i) * 68 + 16 * bi;
#pragma unroll
                for (int k4 = 0; k4 < 4; ++k4) if (4 * k4 < i) { const f32x4 lv = *(const LAS f32x4*)(Lr + 4 * k4);
#pragma unroll
                    for (int e = 0; e < 4; ++e) if (4 * k4 + e < i) s += lv[e] * Td[4 * k4 + e]; }
                Td[i] = s;
            }
            DBG_CHK(5, !(fabsf(Td[15]) < 1e30f) || !(fabsf(Td[7]) < 1e30f));
            LAS u16* tp = TB + (16 * bi + jj) * 72 + 16 * bi;
            *(LAS v4u*)tp = (v4u){pkbf(Td[0], Td[1]), pkbf(Td[2], Td[3]), pkbf(Td[4], Td[5]), pkbf(Td[6], Td[7])};
            *(LAS v4u*)(tp + 8) = (v4u){pkbf(Td[8], Td[9]), pkbf(Td[10], Td[11]), pkbf(Td[12], Td[13]), pkbf(Td[14], Td[15])};
            LAS u16* zp = TB + (16 * bi + jj) * 72 + 16 * (bi ^ 1);
            *(LAS v4u*)zp = (v4u){0u, 0u, 0u, 0u}; *(LAS v4u*)(zp + 8) = (v4u){0u, 0u, 0u, 0u};
        }
        {
            const LAS u16* Am = wave < 4 ? ARK : AAK; const LAS u16* Xm = wave < 4 ? RTs : ATs;
#pragma unroll
            for (int ks = 0; ks < 4; ++ks) if (ks < 2 * (t2 + 1)) acc = MFMA32(frag_tr(Am, 72, 32 * t2, 16 * ks, lane), frag_tr(VVs, 72, 32 * c2, 16 * ks, lane), acc);
#pragma unroll
            for (int ks = 0; ks < 4; ++ks) acc = MFMA32(frag_kc(Xm, 72, 32 * t2, 16 * ks, lane), frag_tr(SBT, 72, 32 * c2, 16 * ks, lane), acc);
            DBG_CHK(6, badv(acc));
            if (wave >= 4) st_tile_T(XB, 72, 32 * t2, 32 * c2, acc, lane);
        }
        BAR();
        if (wave < 2) {
            const int o = 32 * wave; f32x16 a = zero16();
#pragma unroll
            for (int ks = 0; ks < 2; ++ks) a = MFMA32(frag_tr(LB, 72, o, o + 16 * ks, lane), frag_kc(TB, 72, o, o + 16 * ks, lane), a);
            DBG_CHK(7, badv(a));
            st_tile_T(TMP + wave * 1280, 40, 0, 0, a, lane);
        }
        BAR();
        if (wave < 2) {
            const int o = 32 * wave; f32x16 a = zero16();
#pragma unroll
            for (int ks = 0; ks < 2; ++ks) a = MFMA32(frag_tr(TB, 72, o, o + 16 * ks, lane), frag_kc(TMP + wave * 1280, 40, 0, 16 * ks, lane), a);
            DBG_CHK(8, badv(a));
            if (r < 16) { LAS u16* q = TB + (o + r) * 72 + o + 4 * h5;
#pragma unroll
                for (int g = 2; g < 4; ++g) *(LAS u32x2*)(q + 8 * g) = (u32x2){pkbf(a[4 * g], a[4 * g + 1]), pkbf(a[4 * g + 2], a[4 * g + 3])}; }
        }
        BAR();
        if (wave == 0) {
            f32x16 a = zero16();
#pragma unroll
            for (int ks = 0; ks < 2; ++ks) a = MFMA32(frag_tr(LB, 72, 32, 16 * ks, lane), frag_kc(TB, 72, 0, 16 * ks, lane), a);
            DBG_CHK(9, badv(a));
            st_tile_T(TMP, 40, 0, 0, a, lane);
        }
        BAR();
        if (wave == 0) {
            f32x16 a = zero16();
#pragma unroll
            for (int ks = 0; ks < 2; ++ks) a = MFMA32(frag_tr(TB, 72, 32, 32 + 16 * ks, lane), frag_kc(TMP, 40, 0, 16 * ks, lane), a);
            DBG_CHK(10, badv(a));
            st_tile_T(TB, 72, 32, 0, a, lane);
        }
        BAR();
        if (wave >= 4) {
            f32x16 u = zero16();
#pragma unroll
            for (int ks = 0; ks < 4; ++ks) if (ks < 2 * (t2 + 1)) u = MFMA32(frag_tr(TB, 72, 32 * t2, 16 * ks, lane), frag_kc(XB, 72, 32 * c2, 16 * ks, lane), u);
            DBG_CHK(11, badv(u));
            st_tile_T(UB, 72, 32 * t2, 32 * c2, u, lane);
        }
        BAR();
        if (wave < 4) {
#pragma unroll
            for (int ks = 0; ks < 4; ++ks) if (ks < 2 * (t2 + 1)) acc = MFMA32(frag_tr(ARB, 72, 32 * t2, 16 * ks, lane), frag_kc(UB, 72, 32 * c2, 16 * ks, lane), acc);
            DBG_CHK(12, badv(acc));
            if (wr_out) {
#pragma unroll
                for (int i = 0; i < 16; ++i) { const int j = 32 * t2 + arow(i, h5); const long row = rowbase + (dir ? 63 - j : j);
                    YY[row * 1024 + dir * 512 + h * 64 + 32 * c2 + r] = (u16)(pkbf(acc[i], 0.f) & 0xffffu); }
            }
            const float pc = PC[32 * c2 + r];
#pragma unroll
            for (int i = 0; i < 16; ++i) S[i] *= pc;
#pragma unroll
            for (int ks = 0; ks < 4; ++ks) S = MFMA32(frag_kc(UB, 72, 32 * t2, 16 * ks, lane), frag_tr(BPs, 72, 32 * c2, 16 * ks, lane), S);
#pragma unroll
            for (int ks = 0; ks < 4; ++ks) S = MFMA32(frag_tr(VVs, 72, 32 * t2, 16 * ks, lane), frag_tr(KPs, 72, 32 * c2, 16 * ks, lane), S);
            DBG_CHK(13, badv(S));
        }
        BAR();
#ifdef DBG_RW
        if (lane == 0) dbgw[4 + wave] = (unsigned)mybad;
        BAR();
        if (tid == 0) { unsigned mn = 99u; for (int w = 0; w < 8; ++w) mn = dbgw[4 + w] < mn ? dbgw[4 + w] : mn; if (dbgw[1] == 9999u && mn != 99u) { dbgw[1] = (unsigned)n; dbgw[2] = mn; } }
        BAR();
        if (wr_out && wave < 4) { const float cv = dbgw[1] == 9999u ? 0.f : (DBG_MODE == 1 ? 10.0f * (float)(140 - (int)dbgw[1]) : 100.0f * (float)dbgw[2]);
#pragma unroll
            for (int i = 0; i < 16; ++i) { const int j = 32 * t2 + arow(i, h5); const long row = rowbase + (dir ? 63 - j : j);
                YY[row * 1024 + dir * 512 + h * 64 + 32 * c2 + r] = (u16)(pkbf(cv, 0.f) & 0xffffu); } }
        BAR();
#endif
    }
}
#define CU_SYNC() do { asm volatile("s_waitcnt vmcnt(0)" ::: "memory"); __syncthreads(); __builtin_amdgcn_fence(__ATOMIC_ACQUIRE, "agent"); asm volatile("s_waitcnt vmcnt(0)" ::: "memory"); __syncthreads(); } while (0)
__device__ __forceinline__ void unpack8(const v4u u, float (&f)[8]) { f[0] = bflo(u.x); f[1] = bfhi(u.x); f[2] = bflo(u.y); f[3] = bfhi(u.y); f[4] = bflo(u.z); f[5] = bfhi(u.z); f[6] = bflo(u.w); f[7] = bfhi(u.w); }
__device__ __forceinline__ void combine_panel(const Params& p, int pm, int lane, int wave) {
    const u16* Z = (const u16*)(p.ws + WS_Z); const u16* O = (const u16*)(p.ws + WS_U); u16* YY = (u16*)(p.ws + WS_YY); const u16* VL = (const u16*)(p.ws + WS_VL); const u16* GG = (const u16*)(p.ws + WS_G);
    const float* SBv = (const float*)(p.ws + WS_SB);
    float nw[8], lw_[8], lb_[8];
#pragma unroll
    for (int e = 0; e < 8; ++e) { nw[e] = p.hg_norm_w[((8 * lane) & 127) + e]; lw_[e] = p.lnxw[8 * lane + e]; lb_[e] = p.lnxb[8 * lane + e]; }
    const int hh = lane >> 3;
    for (int i = 0; i < 32; ++i) {
        const long row = (long)pm * 256 + wave * 32 + i;
        const v4u uof = *(const v4u*)(O + row * 1024 + 8 * lane), uob = *(const v4u*)(O + row * 1024 + 512 + 8 * lane), uog = *(const v4u*)(Z + row * ZLD + ZOG + 8 * lane);
        const v4u uyf = *(const v4u*)(YY + row * 1024 + 8 * lane), uyb = *(const v4u*)(YY + row * 1024 + 512 + 8 * lane), uv = *(const v4u*)(VL + row * 512 + 8 * lane), ug = *(const v4u*)(GG + row * 512 + 8 * lane);
        const float sfb = SBv[(size_t)row * 8 + hh] + SBv[((size_t)NTOK + row) * 8 + hh];
        float a[8], b[8], c[8], o[8];
        unpack8(uof, a); unpack8(uob, b); unpack8(uog, c);
        float ss = 0.f;
#pragma unroll
        for (int e = 0; e < 8; ++e) { o[e] = a[e] + b[e]; ss += o[e] * o[e]; }
        ss += __shfl_xor(ss, 1); ss += __shfl_xor(ss, 2); ss += __shfl_xor(ss, 4); ss += __shfl_xor(ss, 8);
        const float rs = 1.0f / sqrtf(ss * (1.0f / 128.0f) + 1e-5f);
        v4u wh;
        wh.x = pkbf(o[0] * rs * nw[0] * c[0], o[1] * rs * nw[1] * c[1]); wh.y = pkbf(o[2] * rs * nw[2] * c[2], o[3] * rs * nw[3] * c[3]);
        wh.z = pkbf(o[4] * rs * nw[4] * c[4], o[5] * rs * nw[5] * c[5]); wh.w = pkbf(o[6] * rs * nw[6] * c[6], o[7] * rs * nw[7] * c[7]);
        float yf[8], yb[8], vv[8], gg[8], y[8];
        unpack8(uyf, yf); unpack8(uyb, yb); unpack8(uv, vv); unpack8(ug, gg);
        float sm = 0.f;
#pragma unroll
        for (int e = 0; e < 8; ++e) { y[e] = yf[e] + yb[e]; sm += y[e]; }
        sm += __shfl_xor(sm, 1); sm += __shfl_xor(sm, 2); sm += __shfl_xor(sm, 4);
        const float mean = sm * (1.0f / 64.0f); float sq = 0.f;
#pragma unroll
        for (int e = 0; e < 8; ++e) { y[e] -= mean; sq += y[e] * y[e]; }
        sq += __shfl_xor(sq, 1); sq += __shfl_xor(sq, 2); sq += __shfl_xor(sq, 4);
        const float rstd = 1.0f / sqrtf(sq * (1.0f / 64.0f) + 64e-5f);
#pragma unroll
        for (int e = 0; e < 8; ++e) y[e] = (y[e] * rstd * lw_[e] + lb_[e] + sfb * vv[e]) * gg[e];
        v4u wr; wr.x = pkbf(y[0], y[1]); wr.y = pkbf(y[2], y[3]); wr.z = pkbf(y[4], y[5]); wr.w = pkbf(y[6], y[7]);
        *(v4u*)(YY + row * 1024 + 8 * lane) = wh; *(v4u*)(YY + row * 1024 + 512 + 8 * lane) = wr;
    }
}
__device__ __forceinline__ void ln1_panel(const Params& p, int pm, int lane, int wave) {
    const float* mod = (const float*)(p.ws + WS_MOD) + (size_t)((pm * 256) >> 13) * 6144; u16* U = (u16*)(p.ws + WS_U);
    for (int i = 0; i < 32; ++i) {
        const long row = (long)pm * 256 + wave * 32 + i;
        f32x4* xr = (f32x4*)(p.out + row * DM) + lane; f32x4 v[4]; float s = 0.f;
#pragma unroll
        for (int j = 0; j < 4; ++j) { v[j] = xr[64 * j]; s += (v[j].x + v[j].y) + (v[j].z + v[j].w); }
        float mean = wave_sum(s) * (1.f / DM), s2 = 0.f;
#pragma unroll
        for (int j = 0; j < 4; ++j) { v[j] = v[j] - mean; s2 += (v[j].x * v[j].x + v[j].y * v[j].y) + (v[j].z * v[j].z + v[j].w * v[j].w); }
        float rstd = 1.f / sqrtf(wave_sum(s2) * (1.f / DM) + 1e-5f); s = 0.f;
#pragma unroll
        for (int j = 0; j < 4; ++j) { const f32x4 g = ((const f32x4*)p.ln1g)[lane + 64 * j], bb = ((const f32x4*)p.ln1b)[lane + 64 * j]; v[j] = v[j] * rstd * g + bb; xr[64 * j] = v[j]; s += (v[j].x + v[j].y) + (v[j].z + v[j].w); }
        mean = wave_sum(s) * (1.f / DM); s2 = 0.f;
#pragma unroll
        for (int j = 0; j < 4; ++j) { v[j] = v[j] - mean; s2 += (v[j].x * v[j].x + v[j].y * v[j].y) + (v[j].z * v[j].z + v[j].w * v[j].w); }
        rstd = 1.f / sqrtf(wave_sum(s2) * (1.f / DM) + 1e-6f);
        u32x2* o8 = (u32x2*)(U + row * DM) + lane;
#pragma unroll
        for (int j = 0; j < 4; ++j) { const f32x4 sh = ((const f32x4*)(mod + 3072))[lane + 64 * j], sc = ((const f32x4*)(mod + 4096))[lane + 64 * j]; const f32x4 r = v[j] * rstd * (sc + 1.0f) + sh; u32x2 w; w.x = pkbf(r.x, r.y); w.y = pkbf(r.z, r.w); o8[64 * j] = w; }
    }
}
__device__ __forceinline__ void ln2_panel(const Params& p, int pm, int lane, int wave) {
    for (int i = 0; i < 32; ++i) {
        const long row = (long)pm * 256 + wave * 32 + i;
        f32x4* xr = (f32x4*)(p.out + row * DM) + lane; f32x4 v[4]; float s = 0.f;
#pragma unroll
        for (int j = 0; j < 4; ++j) { v[j] = xr[64 * j]; s += (v[j].x + v[j].y) + (v[j].z + v[j].w); }
        const float mean = wave_sum(s) * (1.f / DM); float s2 = 0.f;
#pragma unroll
        for (int j = 0; j < 4; ++j) { v[j] = v[j] - mean; s2 += (v[j].x * v[j].x + v[j].y * v[j].y) + (v[j].z * v[j].z + v[j].w * v[j].w); }
        const float rstd = 1.f / sqrtf(wave_sum(s2) * (1.f / DM) + 1e-5f);
#pragma unroll
        for (int j = 0; j < 4; ++j) { const f32x4 g = ((const f32x4*)p.ln2g)[lane + 64 * j], bb = ((const f32x4*)p.ln2b)[lane + 64 * j]; f32x4 o = v[j] * rstd * g + bb;
#ifdef DBG_SANITIZE
            for (int e = 0; e < 4; ++e) if (!(fabsf(o[e]) < 1e30f)) o[e] = 0.f;
#endif
            xr[64 * j] = o; }
    }
}

#define DBG_SANITIZE 1
#ifndef N_LAUNCHES
#define N_LAUNCHES 5
#endif
__global__ void __launch_bounds__(NWAVES * 64, 2) mega_fwd(Params p, int ph_lo, int ph_hi) {
    extern __shared__ __attribute__((aligned(16))) unsigned char lds_raw[];
    LAS unsigned char* lds = (LAS unsigned char*)lds_raw;
    const int tid = threadIdx.x, lane = tid & 63, wave = __builtin_amdgcn_readfirstlane(tid >> 6), bid = blockIdx.x, G = gridDim.x;
    volatile LAS unsigned* MISC = (volatile LAS unsigned*)(lds + MISC_OFF);
    if (tid < 32) MISC[tid] = 0u;
    __syncthreads();
    XcdBarrier bar; bar.bar = (unsigned*)(p.ws + WS_CTL) + CW_BAR; bar.x = 0; bar.st = nullptr;
    if (N_LAUNCHES == 1) bar = xcd_barrier_post((unsigned*)(p.ws + WS_CTL) + CW_BAR, MISC + 8);
#ifndef PHASE_MASK
#define PHASE_MASK 31
#endif
#define IN(k) (((PHASE_MASK >> (k)) & 1) && ph_lo <= (k) && (k) < ph_hi)
#define SEAM(k) do { if (N_LAUNCHES == 1 && IN(k) && IN((k) + 1)) xcd_barrier(bar); } while (0)
    if (IN(0)) { phase0a(p, lds, tid, lane, wave, bid, G); } SEAM(0);
    if (IN(1)) { phase0b(p, lane, wave, bid, G); } SEAM(1);
    if (IN(2)) {
        pg8::Gemm g{(const u16*)(p.ws + WS_U), (const u16*)(p.ws + WS_WIN), MROWS, ZLD, DM, DM, DM}; pg8::StaticOrder S; S.init(MROWS, ZLD, G, bid);
        pg8::EpiZ E{(u16*)(p.ws + WS_Z), ZLD, (const float*)(p.ws + WS_LB)};
        pg8::gemm_phase<pg8::EpiZ, pg8::StaticOrder, true, true>(lds, g, S, E, tid);
    } SEAM(2);
    if (IN(3)) {
        for (int task = bid; task < 192; task += G) {
            if (task < 128) rwkv_chain(p, lds, tid, lane, wave, task >> 4, (task >> 1) & 7, task & 1);
            else { const int t = task - 128; hgrn_chain(p, lds, tid, lane, wave, t >> 3, (t >> 1) & 3, t & 1); }
            __syncthreads();
        }
    } SEAM(3);
    if (IN(4)) {
#if defined(DBG_STAGE) && (DBG_STAGE == 1 || DBG_STAGE == 2)
        for (int pm = bid; pm < NTOK / 256; pm += G) {
            const u16* Z = (const u16*)(p.ws + WS_Z); const u16* O = (const u16*)(p.ws + WS_U); const u16* YYr = (const u16*)(p.ws + WS_YY); const u16* VL = (const u16*)(p.ws + WS_VL); const u16* GG = (const u16*)(p.ws + WS_G); const float* SBv = (const float*)(p.ws + WS_SB);
            for (int i = 0; i < 32; ++i) { const long row = (long)pm * 256 + wave * 32 + i;
                for (int c = lane; c < 1024; c += 64) {
                    float v;
                    if (DBG_STAGE == 1) v = bflo(Z[row * ZLD + c]) + bflo(Z[row * ZLD + 1536 + c]) + bflo(Z[row * ZLD + 2560 + c]) + bflo(Z[row * ZLD + 3296 + c]) + h2f(Z[row * ZLD + 512 + c]);
                    else if (1) { v = bflo(YYr[row * 1024 + c]); if (!(fabsf(v) < 1e30f)) v = 1000.f; } else { auto bad = [](float x) { return !(fabsf(x) < 1e30f); };
                        v = (bad(bflo(O[row * 1024 + c])) ? 100.f : 0.f) + (bad(bflo(YYr[row * 1024 + c])) ? 200.f : 0.f) + (bad(bflo(VL[row * 512 + (c & 511)])) ? 400.f : 0.f) + (bad(bflo(GG[row * 512 + (c & 511)])) ? 800.f : 0.f) + (bad(SBv[(size_t)row * 8 + (c & 7)] + SBv[((size_t)NTOK + row) * 8 + (c & 7)]) ? 1600.f : 0.f); }
                    if (!(fabsf(v) < 1e30f)) v = 0.f;
                    p.out[row * 1024 + c] = v; } }
        }
#else
        for (int pm = bid; pm < NTOK / 256; pm += G) {
            const float* mod = (const float*)(p.ws + WS_MOD) + (size_t)((pm * 256) >> 13) * 6144;
            combine_panel(p, pm, launder(lane), wave);
            CU_SYNC();
#if defined(DBG_STAGE) && DBG_STAGE == 3
            { const u16* YYr = (const u16*)(p.ws + WS_YY); for (int i = 0; i < 32; ++i) { const long row = (long)pm * 256 + wave * 32 + i; for (int c = lane; c < 1024; c += 64) { float v = bflo(YYr[row * 1024 + c]); if (!(fabsf(v) < 1e30f)) v = 0.f; p.out[row * 1024 + c] = v; } } continue; }
#endif
            { pg8::Gemm g{(const u16*)(p.ws + WS_YY), (const u16*)(p.ws + WS_WOUT), NTOK, DM, DM, DM, DM}; pg8::PanelOrder S{pm, 4};
              pg8::EpiRes E{p.x, p.out, DM, mod + 2048, ALPHA};
              pg8::gemm_phase<pg8::EpiRes, pg8::PanelOrder, true, true>(lds, g, S, E, launder(tid)); }
            CU_SYNC();
#if defined(DBG_STAGE) && DBG_STAGE == 4
            { const int ll = launder(lane); for (int i = 0; i < 32; ++i) { const long row = (long)pm * 256 + wave * 32 + i; for (int c = ll; c < 1024; c += 64) { float v = p.out[row * 1024 + c]; if (!(fabsf(v) < 1e30f)) v = 0.f; p.out[row * 1024 + c] = v; } } continue; }
#endif
            ln1_panel(p, pm, launder(lane), wave);
            CU_SYNC();
#if defined(DBG_STAGE) && DBG_STAGE == 5
            { const int ll = launder(lane); for (int i = 0; i < 32; ++i) { const long row = (long)pm * 256 + wave * 32 + i; for (int c = ll; c < 1024; c += 64) { float v = p.out[row * 1024 + c]; if (!(fabsf(v) < 1e30f)) v = 0.f; p.out[row * 1024 + c] = v; } } continue; }
#endif
            { pg8::Gemm g{(const u16*)(p.ws + WS_U), (const u16*)(p.ws + WS_WGU), NTOK, 2 * DFF, DM, DM, DM}; pg8::PanelOrder S{pm, 22};
              pg8::EpiGU E{(u16*)(p.ws + WS_Z), ZLD};
              pg8::gemm_phase<pg8::EpiGU, pg8::PanelOrder, true, true>(lds, g, S, E, launder(tid)); }
            CU_SYNC();
            { pg8::Gemm g{(const u16*)(p.ws + WS_Z), (const u16*)(p.ws + WS_WD), NTOK, DM, DFF, ZLD, DFF}; pg8::PanelOrder S{pm, 4};
              pg8::EpiRes E{p.out, p.out, DM, mod + 5120, ALPHA};
              pg8::gemm_phase<pg8::EpiRes, pg8::PanelOrder, true, true>(lds, g, S, E, launder(tid)); }
            CU_SYNC();
#if defined(DBG_STAGE) && DBG_STAGE == 6
            { const int ll = launder(lane); for (int i = 0; i < 32; ++i) { const long row = (long)pm * 256 + wave * 32 + i; for (int c = ll; c < 1024; c += 64) { float v = p.out[row * 1024 + c]; if (!(fabsf(v) < 1e30f)) v = 0.f; p.out[row * 1024 + c] = v; } } continue; }
#endif
            ln2_panel(p, pm, launder(lane), wave);
            CU_SYNC();
        }
#endif
    }
#undef IN
#undef SEAM
}

extern "C" void kernel_launch(void* const* d_in, const int* in_sizes, int n_in, void* d_out, int out_size, void* d_ws, size_t ws_size, hipStream_t stream) {
    static int grid = 0;
    if (grid == 0) {
        if (n_in != 28 || in_sizes[0] != NTOK * DM || out_size != NTOK * DM || ws_size < WS_END) { fprintf(stderr, "kernel_launch: unexpected shapes: n_in %d in0 %d out %d ws %zu (need %zu)\n", n_in, n_in > 0 ? in_sizes[0] : -1, out_size, ws_size, (size_t)WS_END); grid = -1; return; }
        int dev = 0, cus = 0, per_cu = 0;
        if (hipGetDevice(&dev) != hipSuccess || hipDeviceGetAttribute(&cus, hipDeviceAttributeMultiprocessorCount, dev) != hipSuccess) { grid = -1; return; }
        if (hipFuncSetAttribute((const void*)mega_fwd, hipFuncAttributeMaxDynamicSharedMemorySize, LDS_BYTES) != hipSuccess) { fprintf(stderr, "kernel_launch: hipFuncSetAttribute failed\n"); grid = -1; return; }
        if (hipOccupancyMaxActiveBlocksPerMultiprocessor(&per_cu, (const void*)mega_fwd, NWAVES * 64, LDS_BYTES) != hipSuccess || per_cu < 1) { fprintf(stderr, "kernel_launch: occupancy query says %d blocks per CU\n", per_cu); (void)hipGetLastError(); grid = -1; return; }
        grid = cus;
    }
    if (grid < 0) return;
    Params p{};
    const float** pp = (const float**)&p;
    for (int i = 0; i < 28; ++i) pp[i] = (const float*)d_in[i];
    p.out = (float*)d_out; p.ws = (unsigned char*)d_ws;
#if N_LAUNCHES == 1
    if (hipMemsetAsync((char*)d_ws + WS_CTL, 0, CTL_ZERO_BYTES, stream) != hipSuccess) { fprintf(stderr, "kernel_launch: memset failed\n"); return; }
    hipLaunchKernelGGL(mega_fwd, dim3(grid), dim3(NWAVES * 64), LDS_BYTES, stream, p, 0, 5);
#else
    for (int ph = 0; ph < 5; ++ph) hipLaunchKernelGGL(mega_fwd, dim3(grid), dim3(NWAVES * 64), LDS_BYTES, stream, p, ph, ph + 1);
#endif
}
```

```cpp
#include <hip/hip_runtime.h>
#include <cstdio>
#include <cstdint>

namespace pg8 {
#define PG8_LAS __attribute__((address_space(3)))
#define PG8_GAS __attribute__((address_space(1)))
typedef unsigned short bf16_t;
typedef short bf16x8 __attribute__((ext_vector_type(8)));
typedef float f32x4 __attribute__((ext_vector_type(4)));
typedef unsigned u32x4 __attribute__((ext_vector_type(4)));
constexpr int BM = 256, BK = 64, HALF = 128, HTB = HALF * BK * 2, STAGE_BYTES = 8 * HTB, NXCD = 8, WGM = 8;

__host__ __device__ __forceinline__ int lds_byte(int r, int c) { const int st = (r >> 4) * 2 + (c >> 5), rr = r & 15, cc = c & 31, ob = rr * 64 + cc * 2; return st * 1024 + (ob ^ (((ob >> 9) & 1) << 5)); }
__host__ __device__ __forceinline__ void stage_rc(int b, int& R, int& C) { const int st = b / 1024, sb = b % 1024, swz = sb ^ (((sb >> 9) & 1) << 5); R = (st >> 1) * 16 + swz / 64; C = (st & 1) * 32 + (swz % 64) / 2; }
__host__ __device__ __forceinline__ int perm32(int rho) { const int n = rho >> 4, i = rho & 15; return 8 * (i >> 2) + 4 * n + (i & 3); }

struct Unit { int pm, pn; };
struct Gemm { const bf16_t* A; const bf16_t* Bt; int M, N, K, lda, ldb; long adelta; int ksplit; };

struct StaticOrder {
    int nM, nN, nwg, G, c, wgm, gap_at, gap;
    __host__ __device__ void init(int M, int N, int G_, int c_, int wgm_ = WGM) { nM = M / BM; nN = N / BM; nwg = nM * nN; G = G_; c = c_; wgm = wgm_; gap_at = 1 << 30; gap = 0; }
    __host__ __device__ bool next(int i, Unit& u) const {
        const long L = (long)i * G + c; if (L >= nwg) return false;
        int wgid = (int)L; { const int q = nwg / NXCD, r = nwg % NXCD, xcd = wgid % NXCD, off = wgid / NXCD; wgid = (xcd < r ? xcd * (q + 1) : r * (q + 1) + (xcd - r) * q) + off; }
        const int nig = wgm * nN, gid = wgid / nig, fm = gid * wgm, gsz = (nM - fm) < wgm ? (nM - fm) : wgm;
        u.pm = fm + ((wgid % nig) % gsz); u.pn = (wgid % nig) / gsz; if (u.pn >= gap_at) u.pn += gap; return true;
    }
    __device__ __forceinline__ void a_ready(const Unit&) const {}
    __device__ __forceinline__ void done(const Unit&) const {}
};
struct OgOrder {
    int c, G, nM;
    __device__ __forceinline__ bool next(int i, Unit& u) const { const int pm = c + G * (i >> 1); if (pm >= nM) return false; u.pm = pm; u.pn = 8 + (i & 1); return true; }
    __device__ __forceinline__ void a_ready(const Unit&) const {}
    __device__ __forceinline__ void done(const Unit&) const {}
};
struct InProjOrder {
    int c, G, nx, nN, nctx;
    __device__ __forceinline__ bool next(int i, Unit& u) const {
        const int npan = c < nx ? (nx - c + G - 1) / G : 0;
        if (i < nN * npan) { u.pm = c + G * (i / nN); u.pn = i % nN; return true; }
        const int j = c + G * (i - nN * npan); if (j >= nctx) return false;
        u.pm = nx + j / nN; u.pn = j % nN; return true;
    }
    __device__ __forceinline__ void a_ready(const Unit&) const {}
    __device__ __forceinline__ void done(const Unit&) const {}
};
struct PanelOrder {
    int pm, n;
    __device__ __forceinline__ bool next(int i, Unit& u) const { if (i >= n) return false; u.pm = pm; u.pn = i; return true; }
    __device__ __forceinline__ void a_ready(const Unit&) const {}
    __device__ __forceinline__ void done(const Unit&) const {}
};
typedef float f32x2_t __attribute__((ext_vector_type(2))); typedef __bf16 bf16x2_t __attribute__((ext_vector_type(2)));
__device__ __forceinline__ unsigned cvt_pk_bf16(float lo, float hi) { const f32x2_t v = {lo, hi}; const bf16x2_t b = __builtin_convertvector(v, bf16x2_t); return __builtin_bit_cast(unsigned, b); }
__device__ __forceinline__ float sigm(float x) { return __builtin_amdgcn_rcpf(1.0f + __expf(-x)); }
__device__ __forceinline__ unsigned pk_f16(float lo, float hi) { const _Float16 a = (_Float16)lo, b = (_Float16)hi; return (unsigned)__builtin_bit_cast(unsigned short, a) | ((unsigned)__builtin_bit_cast(unsigned short, b) << 16); }

struct EpiZ {
    static constexpr bool PERM = true, AFTER_DRAIN = false; static constexpr int NVM = 16;
    bf16_t* Z; int ldz; const float* lb; int force_raw;
    __device__ __forceinline__ void operator()(const f32x4 (&acc)[2][2][4][2], const Unit& u, int wr, int wc, int fr, int fq) const {
        const int row0 = u.pm * BM + wr * 64 + fr, col0 = u.pn * BM + wc * 32 + 8 * fq;
        const int mode = force_raw ? 0 : ((u.pn < 2 || u.pn == 8 || u.pn == 9) ? 1 : ((u.pn >= 2 && u.pn < 6) ? 2 : 0));
#ifdef PROBE_P1RAW
        if (force_raw == 5) {
#pragma unroll
            for (int ai = 0; ai < 2; ++ai)
#pragma unroll
                for (int m = 0; m < 4; ++m)
#pragma unroll
                    for (int bj = 0; bj < 2; ++bj) { const f32x4 v0 = acc[ai][bj][m][0], v1 = acc[ai][bj][m][1]; u32x4 w;
                        w.x = cvt_pk_bf16(v0[0], v0[1]); w.y = cvt_pk_bf16(v0[2], v0[3]); w.z = cvt_pk_bf16(v1[0], v1[1]); w.w = cvt_pk_bf16(v1[2], v1[3]);
                        *(u32x4*)(Z + (size_t)(row0 + ai * HALF + m * 16) * 1792 + (u.pn % 7) * 256 + wc * 64 + bj * 32 + 8 * fq) = w; }
            return;
        }
#endif
#pragma unroll
        for (int bj = 0; bj < 2; ++bj) {
#pragma unroll
            for (int ai = 0; ai < 2; ++ai)
#pragma unroll
                for (int m = 0; m < 4; ++m) {
                    f32x4 v0 = acc[ai][bj][m][0], v1 = acc[ai][bj][m][1]; u32x4 w;
                    if (mode == 1) {
#pragma unroll
                        for (int e = 0; e < 4; ++e) { v0[e] = v0[e] * sigm(v0[e]); v1[e] = v1[e] * sigm(v1[e]); }
                    }
                    if (mode == 2) { w.x = pk_f16(v0[0], v0[1]); w.y = pk_f16(v0[2], v0[3]); w.z = pk_f16(v1[0], v1[1]); w.w = pk_f16(v1[2], v1[3]); }
                    else { w.x = cvt_pk_bf16(v0[0], v0[1]); w.y = cvt_pk_bf16(v0[2], v0[3]); w.z = cvt_pk_bf16(v1[0], v1[1]); w.w = cvt_pk_bf16(v1[2], v1[3]); }
#ifdef PROBE_P1RAW
                    if (force_raw == 3) *(u32x4*)(Z + (size_t)(u.pn % 7) * (67584 * 256) + (size_t)(row0 + ai * HALF + m * 16) * 256 + wc * 32 + 8 * fq + bj * HALF) = w;
                    else if (force_raw == 4) *(u32x4*)(Z + (size_t)(row0 + ai * HALF + m * 16) * 1792 + (u.pn % 7) * 256 + wc * 32 + 8 * fq + bj * HALF) = w;
                    else
#endif
                    __builtin_nontemporal_store(w, (u32x4*)(Z + (size_t)(row0 + ai * HALF + m * 16) * ldz + col0 + bj * HALF));
                }
        }
    }
};
struct EpiNull {
    static constexpr bool PERM = true, AFTER_DRAIN = false; static constexpr int NVM = 0;
    __device__ __forceinline__ void operator()(const f32x4 (&acc)[2][2][4][2], const Unit& u, int wr, int wc, int fr, int fq) const {
#pragma unroll
        for (int ai = 0; ai < 2; ++ai)
#pragma unroll
            for (int bj = 0; bj < 2; ++bj)
#pragma unroll
                for (int m = 0; m < 4; ++m)
#pragma unroll
                    for (int n = 0; n < 2; ++n) asm volatile("" :: "v"(acc[ai][bj][m][n]));
    }
};
struct EpiGU {
    static constexpr bool PERM = true, AFTER_DRAIN = false; static constexpr int NVM = 8;
    bf16_t* H; int ldh;
    __device__ __forceinline__ void operator()(const f32x4 (&acc)[2][2][4][2], const Unit& u, int wr, int wc, int fr, int fq) const {
        const int row0 = u.pm * BM + wr * 64 + fr, col0 = u.pn * HALF + wc * 32 + 8 * fq;
#pragma unroll
        for (int ai = 0; ai < 2; ++ai)
#pragma unroll
            for (int m = 0; m < 4; ++m) {
                f32x4 g0 = acc[ai][0][m][0], g1 = acc[ai][0][m][1]; const f32x4 u0 = acc[ai][1][m][0], u1 = acc[ai][1][m][1];
#pragma unroll
                for (int e = 0; e < 4; ++e) { g0[e] = g0[e] * sigm(g0[e]) * u0[e]; g1[e] = g1[e] * sigm(g1[e]) * u1[e]; }
                u32x4 w; w.x = cvt_pk_bf16(g0[0], g0[1]); w.y = cvt_pk_bf16(g0[2], g0[3]); w.z = cvt_pk_bf16(g1[0], g1[1]); w.w = cvt_pk_bf16(g1[2], g1[3]);
                *(PG8_GAS u32x4*)(H + (size_t)(row0 + ai * HALF + m * 16) * ldh + col0) = w;
            }
    }
};
template <bool LOC>
struct EpiGate {
    static constexpr bool PERM = true, AFTER_DRAIN = false; static constexpr int NVM = 16;
    bf16_t* F; int ldf; const float* gate0;
    const PG8_LAS float* gl;
    __device__ __forceinline__ void operator()(const f32x4 (&acc)[2][2][4][2], const Unit& u, int wr, int wc, int fr, int fq) const {
        const int row0 = u.pm * BM + wr * 64 + fr, col0 = u.pn * BM + wc * 32 + 8 * fq;
        const float* gate = gate0 + (size_t)(u.pm >> 5) * 6144;
#pragma unroll
        for (int bj = 0; bj < 2; ++bj) {
            f32x4 g0, g1;
            if (LOC) { g0 = *(const PG8_LAS f32x4*)(gl + col0 + bj * HALF); g1 = *(const PG8_LAS f32x4*)(gl + col0 + bj * HALF + 4); }
            else { g0 = *(const PG8_GAS f32x4*)(gate + col0 + bj * HALF); g1 = *(const PG8_GAS f32x4*)(gate + col0 + bj * HALF + 4); }
#pragma unroll
            for (int ai = 0; ai < 2; ++ai)
#pragma unroll
                for (int m = 0; m < 4; ++m) { const f32x4 v0 = acc[ai][bj][m][0] * g0, v1 = acc[ai][bj][m][1] * g1;
                    u32x4 w; w.x = cvt_pk_bf16(v0[0], v0[1]); w.y = cvt_pk_bf16(v0[2], v0[3]); w.z = cvt_pk_bf16(v1[0], v1[1]); w.w = cvt_pk_bf16(v1[2], v1[3]);
                    *(PG8_GAS u32x4*)(F + (size_t)(row0 + ai * HALF + m * 16) * ldf + col0 + bj * HALF) = w; } }
    }
};

template <class Epi, class Sched, bool ALIGN_EPI = false, bool SP2 = false>
__device__ __forceinline__ void gemm_phase(PG8_LAS unsigned char* lds, const Gemm g, const Sched& S, const Epi& E, const int tid) {
    const int wid = __builtin_amdgcn_readfirstlane(tid >> 6), lane = tid & 63, wr = wid >> 2, wc = wid & 3, fr = lane & 15, fq = lane >> 4;
    const int K = g.K, nt = K / BK;
    unsigned voffA[2], voffB[2];
#pragma unroll
    for (int i = 0; i < 2; ++i) { int R, C; stage_rc(tid * 16 + i * 8192, R, C); const int Rb = Epi::PERM ? ((R & ~31) + perm32(R & 31)) : R;
        voffA[i] = (unsigned)(R * g.lda + C) * 2u; voffB[i] = (unsigned)(Rb * g.ldb + C) * 2u; }
    const size_t kstep = (size_t)(BK * 2);
    const size_t hstepA = (size_t)HALF * g.lda * 2, hstepB = (size_t)HALF * g.ldb * 2;
    const size_t tstepA = 2 * hstepA, tstepB = 2 * hstepB;
    const unsigned ldsw = (unsigned)wid * 1024u;
    const int aoff = lds_byte(wr * 64 + fr, fq * 8), boff = lds_byte(wc * 32 + fr, fq * 8);
#define PG8_SA(b, h) (((b) * 2 + (h)) * HTB)
#define PG8_SB(b, h) ((4 + (b) * 2 + (h)) * HTB)
#define PG8_STAGE(bufoff, gbase, voff) do { _Pragma("unroll") for (int _i = 0; _i < 2; ++_i) \
        __builtin_amdgcn_global_load_lds((const unsigned*)((const char*)(gbase) + (voff)[_i]), (PG8_LAS unsigned*)(lds + (bufoff) + ldsw + _i * 8192), 16, 0, 0); } while (0)
#define PG8_LDA(dst, b, h) do { _Pragma("unroll") for (int m = 0; m < 4; ++m) _Pragma("unroll") for (int k = 0; k < 2; ++k) dst[m][k] = *(const PG8_LAS bf16x8*)(lds + PG8_SA(b, h) + aoff + m * 2048 + k * 1024); } while (0)
#define PG8_LDB(dst, b, h) do { _Pragma("unroll") for (int n = 0; n < 2; ++n) _Pragma("unroll") for (int k = 0; k < 2; ++k) dst[n][k] = *(const PG8_LAS bf16x8*)(lds + PG8_SB(b, h) + boff + n * 2048 + k * 1024); } while (0)
#define PG8_MMA(ai, bj, At, Bt) do { __builtin_amdgcn_s_setprio(1); _Pragma("unroll") for (int m = 0; m < 4; ++m) _Pragma("unroll") for (int n = 0; n < 2; ++n) _Pragma("unroll") for (int k = 0; k < 2; ++k) \
        acc[ai][bj][m][n] = __builtin_amdgcn_mfma_f32_16x16x32_bf16(Bt[n][k], At[m][k], acc[ai][bj][m][n], 0, 0, 0); __builtin_amdgcn_s_setprio(0); } while (0)
#define PG8_WAIT_V(n) asm volatile("s_waitcnt vmcnt(" #n ")" ::: "memory")
#define PG8_WAIT_L(n) asm volatile("s_waitcnt lgkmcnt(" #n ")" ::: "memory")
#define PG8_BAR __builtin_amdgcn_s_barrier()
#define PG8_SCHED __builtin_amdgcn_sched_barrier(0)
    Unit cur, nxt; int ui = 0;
    bool pe = false;
#define PG8_WAIT_VN(n) asm volatile("s_waitcnt vmcnt(%0)" :: "n"(n) : "memory")
    if (!S.next(0, cur)) return;
    f32x4 acc[2][2][4][2];
#pragma unroll
    for (int a = 0; a < 2; ++a)
#pragma unroll
        for (int b = 0; b < 2; ++b)
#pragma unroll
            for (int m = 0; m < 4; ++m)
#pragma unroll
                for (int n = 0; n < 2; ++n) acc[a][b][m][n] = (f32x4){0.f, 0.f, 0.f, 0.f};
    bf16x8 At[4][2], B0[2][2], B1[2][2];
    const char* cA = (const char*)g.A + (size_t)cur.pm * tstepA; const char* cB = (const char*)g.Bt + (size_t)cur.pn * tstepB;
    S.a_ready(cur);
    if constexpr (SP2) {
        PG8_STAGE(PG8_SB(0, 0), cB, voffB); PG8_STAGE(PG8_SB(0, 1), cB + hstepB, voffB); PG8_STAGE(PG8_SA(0, 0), cA, voffA); PG8_STAGE(PG8_SA(0, 1), cA + hstepA, voffA);
        if (wr == 1) PG8_BAR;
        PG8_WAIT_V(2); PG8_BAR;
        PG8_STAGE(PG8_SB(1, 0), cB + kstep, voffB); PG8_STAGE(PG8_SA(1, 0), cA + kstep, voffA); PG8_STAGE(PG8_SB(1, 1), cB + hstepB + kstep, voffB);
        PG8_WAIT_V(6); PG8_BAR;
    } else {
        PG8_STAGE(PG8_SB(0, 0), cB, voffB); PG8_STAGE(PG8_SA(0, 0), cA, voffA); PG8_STAGE(PG8_SB(0, 1), cB + hstepB, voffB); PG8_STAGE(PG8_SA(0, 1), cA + hstepA, voffA);
        if (wr == 1) PG8_BAR;
        PG8_WAIT_V(4); PG8_BAR;
        PG8_STAGE(PG8_SB(1, 0), cB + kstep, voffB); PG8_STAGE(PG8_SA(1, 0), cA + kstep, voffA); PG8_STAGE(PG8_SB(1, 1), cB + hstepB + kstep, voffB);
        PG8_WAIT_V(6); PG8_BAR;
    }
    for (;;) {
        const bool has_next = S.next(ui + 1, nxt);
        const char* nA = has_next ? (const char*)g.A + (size_t)nxt.pm * tstepA : cA; const char* nB = has_next ? (const char*)g.Bt + (size_t)nxt.pn * tstepB : cB;
        for (int t = 0; t < nt; t += 2) {
            const bool last = (t == nt - 2);
            const long ad1 = t >= g.ksplit ? g.adelta : 0, ad2 = t + 2 >= g.ksplit ? g.adelta : 0;
            const char* a1 = cA + (size_t)(t + 1) * kstep + ad1;
            const char* a2 = last ? nA : cA + (size_t)(t + 2) * kstep + ad2; const char* b2 = last ? nB : cB + (size_t)(t + 2) * kstep;
            const char* a3 = a2 + kstep; const char* b3 = b2 + kstep;
            if (last && has_next) S.a_ready(nxt);
            if constexpr (SP2) {
            int pef = __builtin_amdgcn_readfirstlane((pe && t == 0) ? 1 : 0); asm volatile("" : "+s"(pef)); const bool pe0 = pef != 0;
            PG8_LDB(B0, 0, 0); PG8_LDB(B1, 0, 1); PG8_SCHED; PG8_LDA(At, 0, 0); if (!pe0) PG8_STAGE(PG8_SA(1, 1), a1 + hstepA, voffA);
            if (pe0) PG8_WAIT_VN(8 + Epi::NVM); else PG8_WAIT_V(8);
            PG8_WAIT_L(0); PG8_BAR; PG8_MMA(0, 0, At, B0); PG8_MMA(0, 1, At, B1); PG8_BAR; PG8_SCHED;
            PG8_LDA(At, 0, 1); PG8_STAGE(PG8_SB(0, 0), b2, voffB); PG8_STAGE(PG8_SB(0, 1), b2 + hstepB, voffB); PG8_STAGE(PG8_SA(0, 0), a2, voffA);
            if (pe0) PG8_WAIT_VN(8 + Epi::NVM); else PG8_WAIT_V(8);
            PG8_WAIT_L(0); PG8_BAR; PG8_MMA(1, 0, At, B0); PG8_MMA(1, 1, At, B1); PG8_BAR; PG8_SCHED;
            PG8_LDB(B0, 1, 0); PG8_LDB(B1, 1, 1); PG8_SCHED; PG8_LDA(At, 1, 0); PG8_STAGE(PG8_SA(0, 1), a2 + hstepA, voffA);
            if (pe0) PG8_WAIT_VN(8 + Epi::NVM); else PG8_WAIT_V(8);
            PG8_WAIT_L(0); PG8_BAR; PG8_MMA(0, 0, At, B0); PG8_MMA(0, 1, At, B1); PG8_BAR; PG8_SCHED;
            PG8_LDA(At, 1, 1); PG8_STAGE(PG8_SB(1, 0), b3, voffB); PG8_STAGE(PG8_SB(1, 1), b3 + hstepB, voffB); PG8_STAGE(PG8_SA(1, 0), a3, voffA);
            PG8_WAIT_V(8); PG8_WAIT_L(0); PG8_BAR; PG8_MMA(1, 0, At, B0); PG8_MMA(1, 1, At, B1); PG8_BAR; PG8_SCHED;
            } else {
            PG8_LDB(B0, 0, 0); PG8_SCHED; PG8_LDA(At, 0, 0); PG8_STAGE(PG8_SA(1, 1), a1 + hstepA, voffA);
            PG8_WAIT_L(8); PG8_BAR; PG8_WAIT_L(0); PG8_MMA(0, 0, At, B0); PG8_BAR; PG8_SCHED;
            PG8_LDB(B1, 0, 1); PG8_STAGE(PG8_SB(0, 0), b2, voffB);
            PG8_BAR; PG8_WAIT_L(0); PG8_MMA(0, 1, At, B1); PG8_BAR;
            PG8_LDA(At, 0, 1); PG8_STAGE(PG8_SA(0, 0), a2, voffA);
            PG8_BAR; PG8_WAIT_L(0); PG8_MMA(1, 0, At, B0); PG8_BAR; PG8_SCHED;
            PG8_STAGE(PG8_SB(0, 1), b2 + hstepB, voffB);
            PG8_WAIT_V(6); PG8_BAR; PG8_MMA(1, 1, At, B1); PG8_BAR;
            PG8_LDB(B0, 1, 0); PG8_SCHED; PG8_LDA(At, 1, 0); PG8_STAGE(PG8_SA(0, 1), a2 + hstepA, voffA);
            PG8_WAIT_L(8); PG8_BAR; PG8_WAIT_L(0); PG8_MMA(0, 0, At, B0); PG8_BAR; PG8_SCHED;
            PG8_LDB(B1, 1, 1); PG8_STAGE(PG8_SB(1, 0), b3, voffB);
            PG8_BAR; PG8_WAIT_L(0); PG8_MMA(0, 1, At, B1); PG8_BAR;
            PG8_LDA(At, 1, 1); PG8_STAGE(PG8_SA(1, 0), a3, voffA);
            PG8_BAR; PG8_WAIT_L(0); PG8_MMA(1, 0, At, B0); PG8_BAR; PG8_SCHED;
            PG8_STAGE(PG8_SB(1, 1), b3 + hstepB, voffB);
            PG8_WAIT_V(6); PG8_BAR; PG8_MMA(1, 1, At, B1); PG8_BAR;
            }
        }
        if constexpr (SP2) { if (has_next) { PG8_STAGE(PG8_SA(1, 1), nA + kstep + hstepA, voffA); pe = true; } }
        if constexpr (ALIGN_EPI) { if (wr == 0) PG8_BAR; }
        if constexpr (!Epi::AFTER_DRAIN) { E(acc, cur, wr, wc, fr, fq); S.done(cur); }
        if (!has_next) break;
#pragma unroll
        for (int a = 0; a < 2; ++a)
#pragma unroll
            for (int b = 0; b < 2; ++b)
#pragma unroll
                for (int m = 0; m < 4; ++m)
#pragma unroll
                    for (int n = 0; n < 2; ++n) acc[a][b][m][n] = (f32x4){0.f, 0.f, 0.f, 0.f};
        cur = nxt; cA = nA; cB = nB; ++ui;
        if constexpr (ALIGN_EPI) { if (wr == 1) PG8_BAR; }
    }
    PG8_WAIT_V(0);
    if constexpr (!ALIGN_EPI) { if (wr == 0) PG8_BAR; }
    PG8_BAR;
    if constexpr (Epi::AFTER_DRAIN) { E.fused(acc, cur, wr, wc, fr, fq, lds, wid, lane); S.done(cur); }
#undef PG8_SA
#undef PG8_SB
#undef PG8_STAGE
#undef PG8_LDA
#undef PG8_LDB
#undef PG8_MMA
#undef PG8_WAIT_V
#undef PG8_WAIT_VN
#undef PG8_WAIT_L
#undef PG8_BAR
#undef PG8_SCHED
}
}

#define GAS __attribute__((address_space(1)))
#define LAS __attribute__((address_space(3)))
typedef unsigned short bf16;
typedef unsigned v4u __attribute__((ext_vector_type(4)));
typedef float f32x4 __attribute__((ext_vector_type(4)));
typedef short bf16x8 __attribute__((ext_vector_type(8)));
typedef GAS unsigned gu32;
typedef GAS unsigned long long gu64;
#define RLX_AGENT __ATOMIC_RELAXED, __HIP_MEMORY_SCOPE_AGENT
#define LDS_WAIT() asm volatile("s_waitcnt lgkmcnt(0)" ::: "memory")
#define VM_WAIT() asm volatile("s_waitcnt vmcnt(0)" ::: "memory")
__device__ __forceinline__ unsigned long long rt() { return __builtin_amdgcn_s_memrealtime(); }
__device__ __forceinline__ unsigned f2bf(float f) { unsigned u = __builtin_bit_cast(unsigned, f); return (u + 0x7fffu + ((u >> 16) & 1u)) >> 16; }
__device__ __forceinline__ unsigned pk2(float lo, float hi) { return f2bf(lo) | (f2bf(hi) << 16); }
#define XB_TMO      128
#define XB_XCNT(j)  (256  + 64 * (j))
#define XB_XSUB(j)  (1280 + 64 * (j))
#define XB_XGEN(j)  (2304 + 64 * (j))
#define XB_TOP      3328
#define XB_TOPGEN   3392
#define XCD_BAR_WORDS 3456
#define XB_SPIN_CAP (1u << 18)

__device__ __forceinline__ unsigned xb_ld(unsigned* p)              { return __hip_atomic_load(p, __ATOMIC_RELAXED, __HIP_MEMORY_SCOPE_AGENT); }
__device__ __forceinline__ unsigned xb_add(unsigned* p, unsigned v) { return __hip_atomic_fetch_add(p, v, __ATOMIC_RELAXED, __HIP_MEMORY_SCOPE_AGENT); }
__device__ __forceinline__ unsigned xb_xcc_id() { return (unsigned)__builtin_amdgcn_s_getreg((3 << 11) | 20) & 0xFu; }
#define XB_SPIN(cond, bar) do { unsigned _sp = 0; while (cond) { __builtin_amdgcn_s_sleep(1); \
    if ((++_sp & 255u) == 0u) { if (xb_ld(&(bar)[XB_TMO])) break; if (_sp > XB_SPIN_CAP) { atomicAdd(&(bar)[XB_TMO], 1u); break; } } } } while (0)

struct XcdBarrier {
    unsigned* bar; unsigned x;
    volatile LAS unsigned* st;
};

__device__ __forceinline__ XcdBarrier xcd_barrier_post(unsigned* bar, volatile LAS unsigned* st) {
    XcdBarrier b; b.bar = bar; b.x = xb_xcc_id(); b.st = st;
    if (threadIdx.x == 0) (void)xb_add(&bar[XB_XCNT(b.x)], 1u);
    return b;
}
__device__ __forceinline__ void xcd_barrier_complete(unsigned* bar, unsigned x, unsigned& nloc, unsigned& nx) {
    const unsigned G = gridDim.x * gridDim.y * gridDim.z;
    unsigned sum, cnt, mine, sp = 0u;
    for (;;) {
        sum = 0u; cnt = 0u; mine = 0u;
#pragma unroll
        for (unsigned j = 0; j < 16; ++j) { const unsigned c = xb_ld(&bar[XB_XCNT(j)]); sum += c; cnt += (c > 0u) ? 1u : 0u; mine = (j == x) ? c : mine; }
        if (sum == G) break;
        __builtin_amdgcn_s_sleep(1);
        if ((++sp & 255u) == 0u) { if (xb_ld(&bar[XB_TMO])) break; if (sp > XB_SPIN_CAP) { atomicAdd(&bar[XB_TMO], 1u); break; } }
    }
    nloc = mine > 0u ? mine : 1u; nx = cnt > 0u ? cnt : 1u;
}

__device__ __forceinline__ void xcd_barrier(const XcdBarrier& b) {
    asm volatile("s_waitcnt vmcnt(0)" ::: "memory");
    __syncthreads();
    if (threadIdx.x == 0) {
        unsigned* bar = b.bar;
        __builtin_amdgcn_s_waitcnt(0);
        unsigned nloc = b.st[0], nx = b.st[1];
        if (nloc == 0u) { xcd_barrier_complete(bar, b.x, nloc, nx); b.st[0] = nloc; b.st[1] = nx; }
        const unsigned old = xb_add(&bar[XB_XSUB(b.x)], 1u);
        const unsigned gen = old / nloc;
        if (old + 1u == (gen + 1u) * nloc) {
            __builtin_amdgcn_fence(__ATOMIC_RELEASE, "agent");
            asm volatile("s_waitcnt vmcnt(0)" ::: "memory");
            const unsigned og = xb_add(&bar[XB_TOP], 1u);
            const unsigned tg = og / nx;
            if (og + 1u == (tg + 1u) * nx) xb_add(&bar[XB_TOPGEN], 1u);
            else XB_SPIN(xb_ld(&bar[XB_TOPGEN]) == tg, bar);
            __builtin_amdgcn_fence(__ATOMIC_ACQUIRE, "agent");
            xb_add(&bar[XB_XGEN(b.x)], 1u);
            asm volatile("s_waitcnt vmcnt(0)" ::: "memory");
        } else {
            XB_SPIN(xb_ld(&bar[XB_XGEN(b.x)]) == gen, bar);
            __builtin_amdgcn_fence(__ATOMIC_ACQUIRE, "agent");
            asm volatile("s_waitcnt vmcnt(0)" ::: "memory");
        }
    }
    __syncthreads();
}
constexpr int NWAVES = 8;
constexpr int NB = 8, SEQ = 8192, DM = 1024, CTXL = 256;
constexpr int NTOK = NB * SEQ, NCTX = NB * CTXL, MROWS = NTOK + NCTX;
constexpr int ZLD = 4352, INCOLS = 4320, DFF = 2816;
constexpr int ZQ = 0, ZF = 512, ZI = 1536, ZOG = 2048, ZR = 2560;
constexpr float ALPHA = 1.189207115f;
constexpr size_t MiB = 1u << 20;
constexpr size_t WS_CTL = 0, CTL_ZERO_BYTES = 64 * 1024;
constexpr size_t WS_MOD = 1 * MiB, WS_LB = 1 * MiB + 256 * 1024, WS_W2T = 1 * MiB + 512 * 1024, WS_A2T = WS_W2T + 64 * 1024, WS_G2T = WS_A2T + 64 * 1024;
constexpr size_t WS_WIN = 2 * MiB, WS_WOUT = 11 * MiB, WS_WGU = 13 * MiB, WS_WD = 24 * MiB, WS_SB = 30 * MiB;
constexpr size_t WS_U = 34 * MiB, WS_Z = 166 * MiB, WS_YY = 727 * MiB, WS_VL = 855 * MiB, WS_G = 919 * MiB, WS_END = 983 * MiB;
constexpr int CW_HG = 8448;
constexpr int CW_BAR = 1024;
constexpr int LDS_BYTES = 159744, MISC_OFF = 157696, EPI_OFF = 131072;
static_assert(CW_BAR * 4 + 3456 * 4 <= (int)CTL_ZERO_BYTES, "ctl");

typedef unsigned short u16;
typedef float f32x16 __attribute__((ext_vector_type(16)));
typedef float f32x2 __attribute__((ext_vector_type(2)));
typedef short s16x4 __attribute__((ext_vector_type(4)));
typedef unsigned u32x2 __attribute__((ext_vector_type(2)));
#define MFMA32(a, b, c) __builtin_amdgcn_mfma_f32_32x32x16_bf16(a, b, c, 0, 0, 0)
#define BAR() __syncthreads()
#define LBAR() do { asm volatile("s_waitcnt lgkmcnt(0)" ::: "memory"); __builtin_amdgcn_s_barrier(); asm volatile("" ::: "memory"); } while (0)
__device__ __forceinline__ int launder(int v) { asm volatile("" : "+v"(v)); return v; }
__device__ __forceinline__ int fresh_tid(int wave) { int l; asm volatile("v_mbcnt_lo_u32_b32 %0, -1, 0\n\tv_mbcnt_hi_u32_b32 %0, -1, %0" : "=v"(l)); return wave * 64 + l; }
__device__ __forceinline__ unsigned char* launder_sp(unsigned char* q) { asm volatile("" : "+s"(q)); return q; }
__device__ __forceinline__ float sigm(float x) { return __builtin_amdgcn_rcpf(1.0f + __expf(-x)); }
__device__ __forceinline__ float dppf(float x, const int ctrl) { return x; }
#define DPP_ADD(x, ctrl) x += __builtin_bit_cast(float, __builtin_amdgcn_update_dpp(0, __builtin_bit_cast(int, x), ctrl, 0xF, 0xF, true))
__device__ __forceinline__ float sum8(float x) { DPP_ADD(x, 0xB1); DPP_ADD(x, 0x4E); DPP_ADD(x, 0x141); return x; }
__device__ __forceinline__ float sum16(float x) { DPP_ADD(x, 0xB1); DPP_ADD(x, 0x4E); DPP_ADD(x, 0x141); DPP_ADD(x, 0x140); return x; }
__device__ __forceinline__ float sum32(float x) { x = sum16(x); x += __builtin_bit_cast(float, __builtin_amdgcn_ds_swizzle(__builtin_bit_cast(int, x), 0x401F)); return x; }
__device__ __forceinline__ float bflo(unsigned u) { return __builtin_bit_cast(float, u << 16); }
__device__ __forceinline__ float bfhi(unsigned u) { return __builtin_bit_cast(float, u & 0xffff0000u); }
__device__ __forceinline__ unsigned pkbf(float lo, float hi) { return pg8::cvt_pk_bf16(lo, hi); }
__device__ __forceinline__ float h2f(unsigned short h) { return (float)__builtin_bit_cast(_Float16, h); }
__device__ __forceinline__ void unpack8(const v4u u, float (&f)[8]) { f[0] = bflo(u.x); f[1] = bfhi(u.x); f[2] = bflo(u.y); f[3] = bfhi(u.y); f[4] = bflo(u.z); f[5] = bfhi(u.z); f[6] = bflo(u.w); f[7] = bfhi(u.w); }
__device__ __forceinline__ int arow(int i, int h5) { return (i & 3) + 8 * (i >> 2) + 4 * h5; }
__device__ __forceinline__ bf16x8 frag_kc(const LAS u16* X, int ld, int idx0, int k0, int lane) {
    return *(const LAS bf16x8*)(X + (idx0 + (lane & 31)) * ld + k0 + 8 * (lane >> 5));
}
__device__ __forceinline__ bf16x8 frag_tr(const LAS u16* X, int ld, int idx0, int k0, int lane) {
    const int g = lane >> 4, q = (lane >> 2) & 3, p = lane & 3;
    const LAS u16* a = X + (k0 + 8 * (g >> 1) + q) * ld + idx0 + 16 * (g & 1) + 4 * p;
    const s16x4 lo = __builtin_bit_cast(s16x4, __builtin_amdgcn_ds_read_tr16_b64_v4i16((LAS s16x4*)a));
    const s16x4 hi = __builtin_bit_cast(s16x4, __builtin_amdgcn_ds_read_tr16_b64_v4i16((LAS s16x4*)(a + 4 * ld)));
    return (bf16x8){lo[0], lo[1], lo[2], lo[3], hi[0], hi[1], hi[2], hi[3]};
}
__device__ __forceinline__ void st_tile_T(LAS u16* D, int ld, int row0, int col0, const f32x16& a, int lane) {
    LAS u16* p = D + (col0 + (lane & 31)) * ld + row0 + 4 * (lane >> 5);
#pragma unroll
    for (int g = 0; g < 4; ++g) { u32x2 w; w.x = pkbf(a[4 * g], a[4 * g + 1]); w.y = pkbf(a[4 * g + 2], a[4 * g + 3]); *(LAS u32x2*)(p + 8 * g) = w; }
}
__device__ __forceinline__ f32x16 zero16() { f32x16 z;
#pragma unroll
    for (int i = 0; i < 16; ++i) z[i] = 0.f; return z; }

__device__ __forceinline__ void transpose_item(const float* W, int N, u16* WT, int ldw, int k0, int n0, int drow0, LAS float* scr, int lane) {
    float t[32];
#pragma unroll
    for (int i = 0; i < 32; ++i) { const int kk = 2 * i + (lane >> 5); t[i] = W[(size_t)(k0 + kk) * N + n0 + (lane & 31)]; }
#pragma unroll
    for (int i = 0; i < 32; ++i) { const int kk = 2 * i + (lane >> 5); scr[kk * 33 + (lane & 31)] = t[i]; }
    LDS_WAIT(); asm volatile("" ::: "memory");
    const int c = lane & 7;
#pragma unroll
    for (int j = 0; j < 4; ++j) { const int n = (lane >> 3) + 8 * j; const LAS float* s = scr + (8 * c) * 33 + n;
        v4u o; o.x = pkbf(s[0 * 33], s[1 * 33]); o.y = pkbf(s[2 * 33], s[3 * 33]); o.z = pkbf(s[4 * 33], s[5 * 33]); o.w = pkbf(s[6 * 33], s[7 * 33]);
        *(v4u*)(WT + (size_t)(drow0 + n) * ldw + k0 + 8 * c) = o; }
    LDS_WAIT(); asm volatile("" ::: "memory");
}
struct Params {
    const float *x, *c, *ctx, *c_ctx, *w_ada, *b_ada, *w_in, *lb_logits, *hg_norm_w, *mu, *w0, *w2, *a0, *a2, *g2, *kkw, *kaw, *rkw, *lnxw, *lnxb, *w_out, *ln1g, *ln1b, *wg, *wu, *wd, *ln2g, *ln2b;
    float* out; unsigned char* ws;
};
constexpr int WI_IN = 16 * 135, WI_OUT = 16 * 32, WI_G = 16 * 88, WI_D = 44 * 32, WI_ALL = WI_IN + WI_OUT + 2 * WI_G + WI_D;
__device__ __forceinline__ void weight_items(const Params& p, LAS unsigned char* lds, int lane, int wave, int gw, int NGW, int first, int last) {
    LAS float* scr = (LAS float*)(lds + 65536 + wave * 8704);
    u16* wint = (u16*)(p.ws + WS_WIN); u16* woutt = (u16*)(p.ws + WS_WOUT); u16* wgut = (u16*)(p.ws + WS_WGU); u16* wdt = (u16*)(p.ws + WS_WD);
    for (int it = first + gw; it < last; it += NGW) {
        int r = it;
        if (r < WI_IN) { const int kb = r / 135, nb = r % 135; transpose_item(p.w_in, INCOLS, wint, 1024, 64 * kb, 32 * nb, 32 * nb, scr, lane); continue; } r -= WI_IN;
        if (r < WI_OUT) { const int kb = r / 32, nb = r % 32; transpose_item(p.w_out, 1024, woutt, 1024, 64 * kb, 32 * nb, 32 * nb, scr, lane); continue; } r -= WI_OUT;
        if (r < WI_G) { const int kb = r / 88, nb = r % 88, n0 = 32 * nb; transpose_item(p.wg, DFF, wgut, 1024, 64 * kb, n0, 256 * (n0 >> 7) + (n0 & 127), scr, lane); continue; } r -= WI_G;
        if (r < WI_G) { const int kb = r / 88, nb = r % 88, n0 = 32 * nb; transpose_item(p.wu, DFF, wgut, 1024, 64 * kb, n0, 256 * (n0 >> 7) + 128 + (n0 & 127), scr, lane); continue; } r -= WI_G;
        { const int kb = r / 32, nb = r % 32; transpose_item(p.wd, 1024, wdt, DFF, 64 * kb, 32 * nb, 32 * nb, scr, lane); }
    }
}
__device__ __forceinline__ void phase0a(const Params& p, LAS unsigned char* lds, int tid, int lane, int wave, int bid, int G) {
    float* mod = (float*)(p.ws + WS_MOD);
    for (int cb = bid; cb < 192; cb += G) {
        LAS float* sc = (LAS float*)lds; LAS float* red = sc + 9 * 1024;
        for (int i = tid; i < 9 * 1024; i += 512) { const int b = i >> 10, d = i & 1023; const float xv = b < 8 ? p.c[b * 1024 + d] : p.c_ctx[d]; sc[i] = xv * sigm(xv); }
        BAR();
        const int cl = tid & 31, dq = tid >> 5, col = cb * 32 + cl;
        float acc[9];
#pragma unroll
        for (int b = 0; b < 9; ++b) acc[b] = 0.f;
#pragma unroll
        for (int hb = 0; hb < 2; ++hb) { float w[32];
#pragma unroll
            for (int j = 0; j < 32; ++j) w[j] = p.w_ada[(size_t)(dq * 64 + hb * 32 + j) * 6144 + col];
#pragma unroll
            for (int j = 0; j < 32; ++j) {
#pragma unroll
                for (int b = 0; b < 9; ++b) acc[b] += sc[b * 1024 + dq * 64 + hb * 32 + j] * w[j]; } }
#pragma unroll
        for (int b = 0; b < 9; ++b) red[(dq * 9 + b) * 32 + cl] = acc[b];
        BAR();
        if (tid < 288) { const int b = tid >> 5; float s = 0.f;
#pragma unroll
            for (int q = 0; q < 16; ++q) s += red[(q * 9 + b) * 32 + cl];
            mod[b * 6144 + col] = s + p.b_ada[col]; }
        BAR();
    }
    {
        float* lb = (float*)(p.ws + WS_LB); u16* w2t = (u16*)(p.ws + WS_W2T); u16* a2t = (u16*)(p.ws + WS_A2T); u16* g2t = (u16*)(p.ws + WS_G2T); u16* wint = (u16*)(p.ws + WS_WIN);
        const int gt = bid * 512 + tid, GT = G * 512;
        for (int i = gt; i < 1024; i += GT) lb[i] = sigm(p.lb_logits[i] - p.lb_logits[1024 + i]);
        for (int i = gt; i < 2 * 512 * 32; i += GT) { const int l = i & 31, c = (i >> 5) & 511, d = i >> 14; const float a = p.w2[(d * 32 + l) * 512 + c], b = p.a2[(d * 32 + l) * 512 + c];
            w2t[i] = (u16)(pkbf(a, 0.f) & 0xffffu); a2t[i] = (u16)(pkbf(b, 0.f) & 0xffffu); }
        for (int i = gt; i < 512 * 96; i += GT) { const int l = i % 96, c = i / 96; g2t[i] = (u16)(pkbf(p.g2[l * 512 + c], 0.f) & 0xffffu); }
        for (int i = gt; i < 32 * 1024 / 2; i += GT) ((unsigned*)(wint + (size_t)INCOLS * 1024))[i] = 0u;
    }
    {   const int NGW = G * NWAVES, gw = G == 256 ? (bid >= 192 ? (bid - 192) * NWAVES + wave : 512 + bid * NWAVES + wave) : bid * NWAVES + wave;
        weight_items(p, lds, lane, wave, gw, NGW, 0, WI_ALL); }
}
__device__ __forceinline__ float wave_sum(float v) { v = sum32(v); v += __shfl_xor(v, 32); return v; }
__device__ __forceinline__ void phase0b(const Params& p, int lane, int wave, int bid, int G) {
    const float* mod = (const float*)(p.ws + WS_MOD); u16* U = (u16*)(p.ws + WS_U);
    const int gw = bid * NWAVES + wave, NGW = G * NWAVES;
    constexpr int RB = 4;
    for (int mg = gw; mg < MROWS / RB; mg += NGW) {
        const int m0 = mg * RB;
        const float* xrow = m0 < NTOK ? p.x + (size_t)m0 * DM : p.ctx + (size_t)(m0 - NTOK) * DM;
        const int mb = m0 < NTOK ? (m0 >> 13) : 8;
        f32x4 v[RB][4]; float s[RB], mean[RB], rstd[RB];
#pragma unroll
        for (int q = 0; q < RB; ++q)
#pragma unroll
            for (int j = 0; j < 4; ++j) v[q][j] = ((const f32x4*)(xrow + (size_t)q * DM))[lane + 64 * j];
#pragma unroll
        for (int q = 0; q < RB; ++q) { s[q] = 0.f;
#pragma unroll
            for (int j = 0; j < 4; ++j) s[q] += (v[q][j].x + v[q][j].y) + (v[q][j].z + v[q][j].w); }
#pragma unroll
        for (int q = 0; q < RB; ++q) mean[q] = wave_sum(s[q]) * (1.f / DM);
#pragma unroll
        for (int q = 0; q < RB; ++q) { s[q] = 0.f;
#pragma unroll
            for (int j = 0; j < 4; ++j) { v[q][j] = v[q][j] - mean[q]; s[q] += (v[q][j].x * v[q][j].x + v[q][j].y * v[q][j].y) + (v[q][j].z * v[q][j].z + v[q][j].w * v[q][j].w); } }
#pragma unroll
        for (int q = 0; q < RB; ++q) rstd[q] = 1.f / sqrtf(wave_sum(s[q]) * (1.f / DM) + 1e-6f);
#pragma unroll
        for (int j = 0; j < 4; ++j) { const f32x4 a = ((const f32x4*)(mod + mb * 6144))[lane + 64 * j], b = ((const f32x4*)(mod + mb * 6144 + 1024))[lane + 64 * j];
#pragma unroll
            for (int q = 0; q < RB; ++q) { const f32x4 r = v[q][j] * rstd[q] * (b + 1.0f) + a; u32x2 w; w.x = pkbf(r.x, r.y); w.y = pkbf(r.z, r.w); ((u32x2*)(U + (size_t)(m0 + q) * DM))[lane + 64 * j] = w; } }
    }
}
__device__ __forceinline__ void chain_chunk(int n, int dir, int b, bool& isctx, int& tbase, long& rowbase) {
    isctx = n < 4;
    if (isctx) { const int cc = dir ? 3 - n : n; tbase = cc * 64; rowbase = (long)NTOK + b * CTXL + tbase; }
    else { const int xc = dir ? 127 - (n - 4) : n - 4; tbase = xc * 64; rowbase = (long)b * SEQ + tbase; }
}
constexpr int HG_LD = 136;
constexpr int HG_QT = 0, HG_KT = 17408, HG_VV = 34816, HG_ST = 52224, HG_PT = 87040, HG_TOT = 96256, HG_EM = 100352, HG_EE = 100864, HG_DD = 101376;
__device__ __forceinline__ void hgrn_chain(const Params& p, LAS unsigned char* lds, int tid, int lane_in, int wave, int b, int h, int dir) {
    LAS u16* QT = (LAS u16*)(lds + HG_QT); LAS u16* KT = (LAS u16*)(lds + HG_KT); LAS u16* VV = (LAS u16*)(lds + HG_VV); LAS u16* ST = (LAS u16*)(lds + HG_ST); LAS u16* PT = (LAS u16*)(lds + HG_PT);
    LAS float* TOT = (LAS float*)(lds + HG_TOT); LAS float* EM = (LAS float*)(lds + HG_EM); LAS float* EE = (LAS float*)(lds + HG_EE); LAS float* DD = (LAS float*)(lds + HG_DD);
    const int kb = wave >> 1, vb0 = 2 * (wave & 1);
    const int oti = wave >> 2, ovi = wave & 3;
    f32x16 S0 = zero16(), S1 = zero16();
    unsigned pq_[8], pf_[8], pv_[8];
#define HG_LOAD(nn) do { bool ic_; int tb_; long rb_; chain_chunk((nn), dir, b, ic_, tb_, rb_); const int ln_ = fresh_tid(wave) & 63; \
        const char* zb_ = (const char*)(Z + rb_ * ZLD); \
        _Pragma("unroll") for (int i = 0; i < 8; ++i) { const int j = 8 * wave + i; const int off = (dir ? 63 - j : j) * (ZLD * 2) + (h * 128 + 2 * ln_) * 2; \
            pq_[i] = *(const unsigned*)(zb_ + (long)(off + ZQ * 2)); pf_[i] = *(const unsigned*)(zb_ + (long)(off + (ZF + 512 * dir) * 2)); pv_[i] = *(const unsigned*)(zb_ + (long)(off + ZI * 2)); } } while (0)
    { const u16* Z = (const u16*)(p.ws + WS_Z); HG_LOAD(0); }
    for (int n = 0; n < 132; ++n) {
        bool isctx; int tbase; long rowbase; chain_chunk(n, dir, b, isctx, tbase, rowbase);
        unsigned char* wsl = launder_sp(p.ws); const u16* Z = (const u16*)(wsl + WS_Z); u16* O = (u16*)launder_sp((unsigned char*)p.out);
        const int lane = fresh_tid(wave) & 63, h5 = lane >> 5, r = lane & 31;
        float bb[8][2], om[8][2]; float cum0 = 0.f, cum1 = 0.f;
        const f32x2 lbv = *(const f32x2*)((const float*)(wsl + WS_LB) + 512 * dir + h * 128 + 2 * lane);
#pragma unroll
        for (int i = 0; i < 8; ++i) {
            const int j = 8 * wave + i;
            *(LAS unsigned*)(VV + j * HG_LD + 2 * lane) = pv_[i];
            const float f0 = lbv.x + (1.0f - lbv.x) * pg8::sigm(h2f((unsigned short)(pf_[i] & 0xffffu))), f1 = lbv.y + (1.0f - lbv.y) * pg8::sigm(h2f((unsigned short)(pf_[i] >> 16)));
            om[i][0] = 1.0f - f0; om[i][1] = 1.0f - f1;
            cum0 += __logf(f0); cum1 += __logf(f1); bb[i][0] = cum0; bb[i][1] = cum1;
        }
        *(LAS f32x2*)(TOT + wave * 128 + 2 * lane) = (f32x2){cum0, cum1};
        LBAR();
        float base0 = 0.f, base1 = 0.f, m0 = 0.f, m1 = 0.f, t0 = 0.f, t1 = 0.f;
#pragma unroll
        for (int w = 0; w < 8; ++w) { const f32x2 t = *(const LAS f32x2*)(TOT + w * 128 + 2 * lane);
            if (w < wave) { base0 += t.x; base1 += t.y; } if (w < 4) { m0 += t.x; m1 += t.y; } t0 += t.x; t1 += t.y; }
#pragma unroll
        for (int i = 0; i < 8; ++i) {
            const int j = 8 * wave + i;
            const float e0 = __expf(base0 + bb[i][0] - m0), e1 = __expf(base1 + bb[i][1] - m1);
            *(LAS unsigned*)(QT + j * HG_LD + 2 * lane) = pkbf(bflo(pq_[i]) * e0, bfhi(pq_[i]) * e1);
            *(LAS unsigned*)(KT + j * HG_LD + 2 * lane) = pkbf(om[i][0] * __builtin_amdgcn_rcpf(e0), om[i][1] * __builtin_amdgcn_rcpf(e1));
        }
        if (wave == 0) { *(LAS f32x2*)(EM + 2 * lane) = (f32x2){__expf(m0), __expf(m1)}; *(LAS f32x2*)(EE + 2 * lane) = (f32x2){__expf(t0 - m0), __expf(t1 - m1)}; *(LAS f32x2*)(DD + 2 * lane) = (f32x2){__expf(t0), __expf(t1)}; }
        if (n + 1 < 132) { HG_LOAD(n + 1); }
        LBAR();
#pragma unroll
        for (int tt = 0; tt < 2; ++tt) {
            f32x16 sc = tt ? S1 : S0;
#pragma unroll
            for (int g = 0; g < 4; ++g) { const f32x4 em = *(const LAS f32x4*)(EM + 32 * kb + 8 * g + 4 * h5);
#pragma unroll
                for (int e = 0; e < 4; ++e) sc[4 * g + e] *= em[e]; }
            st_tile_T(ST, HG_LD, 32 * kb, 32 * (vb0 + tt), sc, lane);
        }
        if (wave < 3) {
            const int ti = wave >= 1 ? 1 : 0, si = wave == 2 ? 1 : 0;
            f32x16 a = zero16();
#pragma unroll
            for (int ks = 0; ks < 8; ++ks) a = MFMA32(frag_kc(QT, HG_LD, 32 * ti, 16 * ks, lane), frag_kc(KT, HG_LD, 32 * si, 16 * ks, lane), a);
#pragma unroll
            for (int i = 0; i < 16; ++i) { const int t = 32 * ti + arow(i, h5), s = 32 * si + r; if (s > t) a[i] = 0.f; }
            st_tile_T(PT, 72, 32 * ti, 32 * si, a, lane);
        }
        LBAR();
        f32x16 o = zero16();
#pragma unroll
        for (int ks = 0; ks < 8; ++ks) o = MFMA32(frag_kc(QT, HG_LD, 32 * oti, 16 * ks, lane), frag_kc(ST, HG_LD, 32 * ovi, 16 * ks, lane), o);
#pragma unroll
        for (int ks = 0; ks < 4; ++ks) if (ks < 2 * (oti + 1)) o = MFMA32(frag_tr(PT, 72, 32 * oti, 16 * ks, lane), frag_tr(VV, HG_LD, 32 * ovi, 16 * ks, lane), o);
        if (!isctx) {
#pragma unroll
            for (int i = 0; i < 16; ++i) { const int j = 32 * oti + arow(i, h5); const long row = rowbase + (dir ? 63 - j : j);
                O[row * 1024 + dir * 512 + h * 128 + 32 * ovi + r] = (u16)(pkbf(o[i], 0.f) & 0xffffu); }
        }
#pragma unroll
        for (int tt = 0; tt < 2; ++tt) {
            f32x16 g = zero16();
#pragma unroll
            for (int ks = 0; ks < 4; ++ks) g = MFMA32(frag_tr(KT, HG_LD, 32 * kb, 16 * ks, lane), frag_tr(VV, HG_LD, 32 * (vb0 + tt), 16 * ks, lane), g);
#pragma unroll
            for (int gq = 0; gq < 4; ++gq) { const f32x4 dd = *(const LAS f32x4*)(DD + 32 * kb + 8 * gq + 4 * h5), ee = *(const LAS f32x4*)(EE + 32 * kb + 8 * gq + 4 * h5);
#pragma unroll
                for (int e = 0; e < 4; ++e) { if (tt) S1[4 * gq + e] = dd[e] * S1[4 * gq + e] + ee[e] * g[4 * gq + e]; else S0[4 * gq + e] = dd[e] * S0[4 * gq + e] + ee[e] * g[4 * gq + e]; } }
        }
        LBAR();
    }
}
#ifndef RQ_E1
#define RQ_E1 1
#endif
#ifndef RQ_INV
#define RQ_INV 1
#endif
#ifndef RQ_M1
#define RQ_M1 1
#endif
#ifndef RQ_E2A
#define RQ_E2A 1
#endif
#ifndef RQ_E2B
#define RQ_E2B 1
#endif
#ifndef RQ_M2
#define RQ_M2 1
#endif
constexpr int RW_WD = 0, RW_AD = 5120, RW_W2 = 10240, RW_A2 = 15360, RW_TOT = 0;
constexpr int RW_LW = 23552, RW_AG = 32768;
constexpr int RW_AT = 41984, RW_BT = 51200, RW_KT = 60416, RW_RT = 69632, RW_VV = 78848;
constexpr int RW_LF = 88064, RW_TB = 93184, RW_LB = 102400, RW_AAK = 111616, RW_ARB = 120832, RW_ARK = 130048;
constexpr int RW_TMP = 139264, RW_SBT = 144384, RW_PC = 153600;
static_assert(RW_PC + 256 <= MISC_OFF, "rwkv lds map");
__device__ __forceinline__ bf16x8 frag_trp(const LAS u16* X, int ld, int idx0, int k0, int lane) {
    const int g = lane >> 4, q = (lane >> 2) & 3, p = lane & 3;
    const LAS u16* a = X + (k0 + 4 * (g >> 1) + q) * ld + idx0 + 16 * (g & 1) + 4 * p;
    const s16x4 lo = __builtin_bit_cast(s16x4, __builtin_amdgcn_ds_read_tr16_b64_v4i16((LAS s16x4*)a));
    const s16x4 hi = __builtin_bit_cast(s16x4, __builtin_amdgcn_ds_read_tr16_b64_v4i16((LAS s16x4*)(a + 8 * ld)));
    return (bf16x8){lo[0], lo[1], lo[2], lo[3], hi[0], hi[1], hi[2], hi[3]};
}
__device__ __forceinline__ bf16x8 acc_frag(const f32x16& x, const int s) {
    const v4u w = (v4u){pkbf(x[8 * s], x[8 * s + 1]), pkbf(x[8 * s + 2], x[8 * s + 3]), pkbf(x[8 * s + 4], x[8 * s + 5]), pkbf(x[8 * s + 6], x[8 * s + 7])};
    return __builtin_bit_cast(bf16x8, w);
}
#define WAVE_LDS_SYNC() asm volatile("s_waitcnt lgkmcnt(0)" ::: "memory")
__device__ __forceinline__ void rwkv_chain(const Params& p, LAS unsigned char* lds, int tid, int lane_in, int wave, int b, int h, int dir) {
    LAS u16* WDs = (LAS u16*)(lds + RW_WD); LAS u16* ADs = (LAS u16*)(lds + RW_AD); LAS u16* W2s = (LAS u16*)(lds + RW_W2); LAS u16* A2s = (LAS u16*)(lds + RW_A2); LAS float* TOT = (LAS float*)(lds + RW_TOT);
    LAS u16* LWh = (LAS u16*)(lds + RW_LW); LAS u16* AGb = (LAS u16*)(lds + RW_AG); LAS float* PC = (LAS float*)(lds + RW_PC);
    LAS float* LF = (LAS float*)(lds + RW_LF); LAS u16* TB = (LAS u16*)(lds + RW_TB); LAS u16* LB = (LAS u16*)(lds + RW_LB);
    LAS u16* AAK = (LAS u16*)(lds + RW_AAK); LAS u16* ARB = (LAS u16*)(lds + RW_ARB); LAS u16* ARK = (LAS u16*)(lds + RW_ARK);
    LAS u16* ATs = (LAS u16*)(lds + RW_AT); LAS u16* BTs = (LAS u16*)(lds + RW_BT); LAS u16* KTs = (LAS u16*)(lds + RW_KT); LAS u16* RTs = (LAS u16*)(lds + RW_RT);
    LAS u16* VVs = (LAS u16*)(lds + RW_VV); LAS u16* TMP = (LAS u16*)(lds + RW_TMP); LAS u16* SBT = (LAS u16*)(lds + RW_SBT);
    const int t2 = (wave & 3) >> 1, c2 = wave & 1;
    unsigned pc_[4][3], pn_[4][3]; u32x2 pw_[4];
#define RW_LOAD(nn) do { bool ic_; int tb_; long rb_; chain_chunk((nn), dir, b, ic_, tb_, rb_); \
        const int lt_ = fresh_tid(wave), tg_ = lt_ >> 5, hc_ = h * 64 + 2 * (lt_ & 31), tok_ = lt_ >> 3, cg_ = lt_ & 7; \
        const int qr = hc_ / 440, qk = (512 + hc_) / 440, qv = (1024 + hc_) / 440; \
        const char* zb_ = (const char*)(Z + rb_ * ZLD + ZR);                         \
        const bool e0_ = ic_ ? (tb_ == 0) : true, e1_ = ic_ ? (tb_ == CTXL - 64) : true, vu_ = tb_ >= 64, vdn_ = tb_ < SEQ - 64; \
          \
        const int kr_ = ic_ ? (qr < 2 ? 0 : 1) : qr, kk_ = ic_ ? (qk < 2 ? 0 : 1) : qk, kv_ = ic_ ? (qv < 2 ? 0 : 1) : qv, kd_ = ic_ ? 1 : 3; \
        const int RB_ = ZLD * 2; \
        const int dr_ = kr_ == 0 ? -RB_ : kr_ == 1 ? RB_ : kr_ == 2 ? -64 * RB_ : 64 * RB_, dk_ = kk_ == 0 ? -RB_ : kk_ == 1 ? RB_ : kk_ == 2 ? -64 * RB_ : 64 * RB_, dv_ = kv_ == 0 ? -RB_ : kv_ == 1 ? RB_ : kv_ == 2 ? -64 * RB_ : 64 * RB_, dd_ = kd_ == 1 ? RB_ : 64 * RB_; \
        _Pragma("unroll") for (int i = 0; i < 4; ++i) { const int j = 4 * tg_ + i, tl = dir ? 63 - j : j; \
            const bool a0 = !(e0_ && tl == 0), a1 = !(e1_ && tl == 63); \
            const bool v0 = kr_ == 0 ? a0 : kr_ == 1 ? a1 : kr_ == 2 ? vu_ : vdn_, v1 = kk_ == 0 ? a0 : kk_ == 1 ? a1 : kk_ == 2 ? vu_ : vdn_, v2 = kv_ == 0 ? a0 : kv_ == 1 ? a1 : kv_ == 2 ? vu_ : vdn_; \
            const int off = tl * RB_ + hc_ * 2; \
            pc_[i][0] = *(const unsigned*)(zb_ + (long)off); pc_[i][1] = *(const unsigned*)(zb_ + (long)(off + 1024)); pc_[i][2] = *(const unsigned*)(zb_ + (long)(off + 2048)); \
            const unsigned x0 = *(const unsigned*)(zb_ + (long)(off + (v0 ? dr_ : 0))), x1 = *(const unsigned*)(zb_ + (long)(off + 1024 + (v1 ? dk_ : 0))), x2 = *(const unsigned*)(zb_ + (long)(off + 2048 + (v2 ? dv_ : 0))); \
            pn_[i][0] = v0 ? x0 : 0u; pn_[i][1] = v1 ? x1 : 0u; pn_[i][2] = v2 ? x2 : 0u; } \
        { const int j = tok_, tl = dir ? 63 - j : j; const bool vd = kd_ == 1 ? !(e1_ && tl == 63) : vdn_; \
            const int offw = tl * RB_ + (1536 + dir * 32 + 4 * cg_) * 2, offn = offw + (vd ? dd_ : 0); \
            pw_[0] = *(const u32x2*)(zb_ + (long)offw); pw_[1] = *(const u32x2*)(zb_ + (long)(offw + 128)); \
            const u32x2 yw = *(const u32x2*)(zb_ + (long)offn), ya = *(const u32x2*)(zb_ + (long)(offn + 128)); \
            pw_[2] = vd ? yw : (u32x2){0u, 0u}; pw_[3] = vd ? ya : (u32x2){0u, 0u}; \
 } \
    } while (0)
    { const u16* Z = (const u16*)(p.ws + WS_Z); RW_LOAD(0); }
#define LOAD_CA() do { const int l_ = fresh_tid(wave), hc_ = h * 64 + 2 * (l_ & 31), cg_ = l_ & 7; cA_mur = *(const f32x2*)(p.mu + hc_); cA_muk = *(const f32x2*)(p.mu + 512 + hc_); cA_muv = *(const f32x2*)(p.mu + 1024 + hc_); \
        cA_muw = *(const f32x4*)(p.mu + 1536 + dir * 32 + 4 * cg_); cA_mua = *(const f32x4*)(p.mu + 1600 + dir * 32 + 4 * cg_); } while (0)
#define LOAD_CC() do { const int hc_ = h * 64 + 2 * (fresh_tid(wave) & 31); cC_kk = *(const f32x2*)(p.kkw + hc_); cC_ka = *(const f32x2*)(p.kaw + hc_); cC_rk = *(const f32x2*)(p.rkw + hc_); } while (0)
    f32x16 Sa = zero16();
    f32x2 cA_mur, cA_muk, cA_muv, cC_kk, cC_ka, cC_rk; f32x4 cA_muw, cA_mua;
    {   const u16* w2t = (const u16*)(p.ws + WS_W2T) + (size_t)(dir * 512 + h * 64) * 32; const u16* a2t = (const u16*)(p.ws + WS_A2T) + (size_t)(dir * 512 + h * 64) * 32;
        for (int i = tid; i < 64 * 32; i += 512) { const int c = i >> 5, l = i & 31; W2s[c * 40 + l] = w2t[i]; A2s[c * 40 + l] = a2t[i]; } }
    float rv[4][2], kv[4][2], vv[4][2];
    float lw[4][2], av[4][2], bv[4][2], kd[4][2], cl[4][2];
    if (wave < 4) st_tile_T(SBT, 72, 32 * (wave >> 1), 32 * (wave & 1), Sa, lane_in);
    LOAD_CA();
    LBAR();
#ifdef DBG_TSTAGE
    unsigned tacc = 0, tprev = 0;
#define TNOW(v) do { unsigned long long t64_; asm volatile("s_memtime %0\n\ts_waitcnt lgkmcnt(0)" : "=s"(t64_)); v = (unsigned)t64_; } while (0)
#define TSTB(k) do { if ((k) == DBG_TSTAGE && DBG_BUSY) { unsigned tn_; TNOW(tn_); tacc += tn_ - tprev; } } while (0)
#define TST(k) do { unsigned tn_; TNOW(tn_); if ((k) == DBG_TSTAGE && !DBG_BUSY) tacc += tn_ - tprev; tprev = tn_; } while (0)
#else
#define TSTB(k) do { } while (0)
#define TST(k) do { } while (0)
#endif
    for (int n = -1; n < 132; ++n) {
        const bool e_on = n + 1 < 132, s_on = n >= 0;
        unsigned char* wsl = launder_sp(p.ws);
        const u16* Z = (const u16*)(wsl + WS_Z); u16* YY = (u16*)(wsl + WS_YY); u16* VL = (u16*)(wsl + WS_VL); u16* GG = (u16*)(wsl + WS_G); float* SBv = (float*)(wsl + WS_SB);
        bool isctxE = false, isctxS = false; int tbaseE = 0, tbaseS = 0; long rowbaseE = 0, rowbaseS = 0;
        if (e_on) chain_chunk(n + 1, dir, b, isctxE, tbaseE, rowbaseE);
        if (s_on) chain_chunk(n, dir, b, isctxS, tbaseS, rowbaseS);
        const bool do_g = e_on && (!isctxE) && (dir == 0), wr_sb = e_on && !isctxE, wr_y = s_on && !isctxS;
        const int ltid = fresh_tid(wave), lane = ltid & 63, h5 = lane >> 5, r = lane & 31;
        const int tg = ltid >> 5, c0 = 2 * r, hc = h * 64 + c0, tok8 = ltid >> 3, cg = ltid & 7;
        for (int rq = 0; rq < RQ_E1; ++rq) if (e_on) {
            const f32x2 mur = cA_mur, muk = cA_muk, muv = cA_muv;
            const float mur0 = mur.x, mur1 = mur.y, muk0 = muk.x, muk1 = muk.y, muv0 = muv.x, muv1 = muv.y;
            const f32x4 muw = cA_muw, mua = cA_mua;
#pragma unroll
            for (int i = 0; i < 4; ++i) {
                const unsigned ur = pc_[i][0], uk = pc_[i][1], uv = pc_[i][2], nr = pn_[i][0], nk = pn_[i][1], nv = pn_[i][2];
                rv[i][0] = bflo(ur) + mur0 * (bflo(nr) - bflo(ur)); rv[i][1] = bfhi(ur) + mur1 * (bfhi(nr) - bfhi(ur));
                kv[i][0] = bflo(uk) + muk0 * (bflo(nk) - bflo(uk)); kv[i][1] = bfhi(uk) + muk1 * (bfhi(nk) - bfhi(uk));
                vv[i][0] = bflo(uv) + muv0 * (bflo(nv) - bflo(uv)); vv[i][1] = bfhi(uv) + muv1 * (bfhi(nv) - bfhi(uv));
            }
            if (do_g) {
#pragma unroll
                for (int i = 0; i < 4; ++i) { const int j = 4 * tg + i, tl = dir ? 63 - j : j; *(unsigned*)(VL + (rowbaseE + tl) * 512 + hc) = pkbf(vv[i][0], vv[i][1]); }
            }
            {
                const int j = tok8;
                const u32x2 cw = pw_[0], ca = pw_[1], nw = pw_[2], na = pw_[3];
                float wl[4], al[4];
                wl[0] = bflo(cw.x) + muw[0] * (bflo(nw.x) - bflo(cw.x)); wl[1] = bfhi(cw.x) + muw[1] * (bfhi(nw.x) - bfhi(cw.x)); wl[2] = bflo(cw.y) + muw[2] * (bflo(nw.y) - bflo(cw.y)); wl[3] = bfhi(cw.y) + muw[3] * (bfhi(nw.y) - bfhi(cw.y));
                al[0] = bflo(ca.x) + mua[0] * (bflo(na.x) - bflo(ca.x)); al[1] = bfhi(ca.x) + mua[1] * (bfhi(na.x) - bfhi(ca.x)); al[2] = bflo(ca.y) + mua[2] * (bflo(na.y) - bflo(ca.y)); al[3] = bfhi(ca.y) + mua[3] * (bfhi(na.y) - bfhi(ca.y));
#pragma unroll
                for (int e = 0; e < 4; ++e) wl[e] = 1.0f - 2.0f * __builtin_amdgcn_rcpf(1.0f + __expf(2.0f * wl[e]));
                *(LAS u32x2*)(WDs + j * 40 + 4 * cg) = (u32x2){pkbf(wl[0], wl[1]), pkbf(wl[2], wl[3])};
                *(LAS u32x2*)(ADs + j * 40 + 4 * cg) = (u32x2){pkbf(al[0], al[1]), pkbf(al[2], al[3])};
            }
        }
        for (int rq = 0; rq < RQ_INV; ++rq) if (s_on && wave < 2) {
            const int bi = 2 * wave + ((lane >> 4) & 1), jj = lane & 15; float Td[16];
            int lfo = bi * 320;
#pragma unroll
            for (int i = 0; i < 16; ++i) {
                float s = (i == jj) ? 1.0f : 0.0f;
                const LAS float* Lr = LF + lfo + i * 20;
#pragma unroll
                for (int k4 = 0; k4 < 4; ++k4) if (4 * k4 < i) { const f32x4 lv = *(const LAS f32x4*)(Lr + 4 * k4);
#pragma unroll
                    for (int e = 0; e < 4; ++e) if (4 * k4 + e < i) s += lv[e] * Td[4 * k4 + e]; }
                Td[i] = s;
                if (i == 5 || i == 9 || i == 12) asm volatile("" : "+v"(lfo) : "v"(Td[i - 2]));
            }
            LAS u16* tp = TB + (16 * bi + jj) * 72 + 16 * bi;
            *(LAS v4u*)tp = (v4u){pkbf(Td[0], Td[1]), pkbf(Td[2], Td[3]), pkbf(Td[4], Td[5]), pkbf(Td[6], Td[7])};
            *(LAS v4u*)(tp + 8) = (v4u){pkbf(Td[8], Td[9]), pkbf(Td[10], Td[11]), pkbf(Td[12], Td[13]), pkbf(Td[14], Td[15])};
            LAS u16* zp = TB + (16 * bi + jj) * 72 + 16 * (bi ^ 1);
            *(LAS v4u*)zp = (v4u){0u, 0u, 0u, 0u}; *(LAS v4u*)(zp + 8) = (v4u){0u, 0u, 0u, 0u};
            WAVE_LDS_SYNC();
            const int o = 32 * wave; f32x16 a = zero16();
#pragma unroll
            for (int ks = 0; ks < 2; ++ks) a = MFMA32(frag_tr(LB, 72, o, o + 16 * ks, lane), frag_kc(TB, 72, o, o + 16 * ks, lane), a);
            st_tile_T(TMP + wave * 1280, 40, 0, 0, a, lane);
            WAVE_LDS_SYNC();
            a = zero16();
#pragma unroll
            for (int ks = 0; ks < 2; ++ks) a = MFMA32(frag_tr(TB, 72, o, o + 16 * ks, lane), frag_kc(TMP + wave * 1280, 40, 0, 16 * ks, lane), a);
            if (r < 16) { LAS u16* q = TB + (o + r) * 72 + o + 4 * h5;
#pragma unroll
                for (int g = 2; g < 4; ++g) *(LAS u32x2*)(q + 8 * g) = (u32x2){pkbf(a[4 * g], a[4 * g + 1]), pkbf(a[4 * g + 2], a[4 * g + 3])}; }
        }
        TSTB(0);
        LBAR();
        TST(0);
        for (int rq = 0; rq < RQ_M1; ++rq) if (e_on && wave >= 4) {
#pragma unroll
            for (int q = 0; q < 2; ++q) {
                const int tile = 2 * (wave - 4) + q;
                const int isa = tile >> 2, tt2 = (tile >> 1) & 1, cc2 = tile & 1;
                const LAS u16* Xs = isa ? ADs : WDs; const LAS u16* Ws = isa ? A2s : W2s;
                const float mbias = isa ? p.a0[dir * 512 + h * 64 + 32 * cc2 + r] : p.w0[dir * 512 + h * 64 + 32 * cc2 + r];
                f32x16 a = zero16();
#pragma unroll
                for (int ks = 0; ks < 2; ++ks) a = MFMA32(frag_kc(Xs, 40, 32 * tt2, 16 * ks, lane), frag_kc(Ws, 40, 32 * cc2, 16 * ks, lane), a);
                if (!isa) {
#pragma unroll
                    for (int i = 0; i < 16; ++i) { const _Float16 hv = (_Float16)(-0.6065306597f * sigm(a[i] + mbias)); LWh[(32 * tt2 + arow(i, h5)) * 72 + 32 * cc2 + r] = __builtin_bit_cast(unsigned short, hv); }
                } else {
#pragma unroll
                    for (int i = 0; i < 16; ++i) AGb[(32 * tt2 + arow(i, h5)) * 72 + 32 * cc2 + r] = (u16)(pkbf(sigm(a[i] + mbias), 0.f) & 0xffffu);
                }
            }
        }
        if (s_on && wave < 4) {
            const int v0 = 32 * (wave >> 1), ci = wave & 1, cs = 32 * ci;
            bf16x8 vf[4], sf[4];
#pragma unroll
            for (int ks = 0; ks < 4; ++ks) { vf[ks] = frag_tr(VVs, 72, v0, 16 * ks, lane); sf[ks] = frag_tr(SBT, 72, v0, 16 * ks, lane); }
            f32x16 A0 = zero16();
            { bf16x8 fa[6];
#pragma unroll
              for (int ks = 0; ks < 2; ++ks) fa[ks] = frag_tr(AAK, 72, 0, 16 * ks, lane);
#pragma unroll
              for (int ks = 0; ks < 4; ++ks) fa[2 + ks] = frag_kc(ATs, 72, 0, 16 * ks, lane);
#pragma unroll
              for (int ks = 0; ks < 2; ++ks) A0 = MFMA32(fa[ks], vf[ks], A0);
#pragma unroll
              for (int ks = 0; ks < 4; ++ks) A0 = MFMA32(fa[2 + ks], sf[ks], A0); }
            bf16x8 ut0, ut1;
            { const bf16x8 t0 = frag_trp(TB, 72, 0, 0, lane), t1 = frag_trp(TB, 72, 0, 16, lane); f32x16 Ut = zero16();
              Ut = MFMA32(t0, acc_frag(A0, 0), Ut); Ut = MFMA32(t1, acc_frag(A0, 1), Ut);
              ut0 = acc_frag(Ut, 0); ut1 = acc_frag(Ut, 1); }
            if (ci == 0) {
                A0 = zero16();
                bf16x8 fa[8];
#pragma unroll
                for (int ks = 0; ks < 2; ++ks) { fa[ks] = frag_tr(ARK, 72, 0, 16 * ks, lane); fa[6 + ks] = frag_trp(ARB, 72, 0, 16 * ks, lane); }
#pragma unroll
                for (int ks = 0; ks < 4; ++ks) fa[2 + ks] = frag_kc(RTs, 72, 0, 16 * ks, lane);
#pragma unroll
                for (int ks = 0; ks < 2; ++ks) A0 = MFMA32(fa[ks], vf[ks], A0);
#pragma unroll
                for (int ks = 0; ks < 4; ++ks) A0 = MFMA32(fa[2 + ks], sf[ks], A0);
                A0 = MFMA32(fa[6], ut0, A0); A0 = MFMA32(fa[7], ut1, A0);
                if (wr_y) {
#pragma unroll
                    for (int i = 0; i < 16; ++i) { const int j0 = arow(i, h5); const long r0 = rowbaseS + (dir ? 63 - j0 : j0); YY[r0 * 1024 + dir * 512 + h * 64 + v0 + r] = (u16)(pkbf(A0[i], 0.f) & 0xffffu); }
                }
            }
            { const bf16x8 b0 = frag_trp(BTs, 72, cs, 0, lane), b1 = frag_trp(BTs, 72, cs, 16, lane);
              Sa = MFMA32(ut0, b0, Sa); Sa = MFMA32(ut1, b1, Sa); }
            A0 = zero16();
            { bf16x8 fa[10];
#pragma unroll
              for (int ks = 0; ks < 4; ++ks) { fa[ks] = frag_tr(AAK, 72, 32, 16 * ks, lane); fa[4 + ks] = frag_kc(ATs, 72, 32, 16 * ks, lane); }
              fa[8] = frag_trp(LB, 72, 32, 0, lane); fa[9] = frag_trp(LB, 72, 32, 16, lane);
#pragma unroll
              for (int ks = 0; ks < 4; ++ks) A0 = MFMA32(fa[ks], vf[ks], A0);
#pragma unroll
              for (int ks = 0; ks < 4; ++ks) A0 = MFMA32(fa[4 + ks], sf[ks], A0);
              A0 = MFMA32(fa[8], ut0, A0); A0 = MFMA32(fa[9], ut1, A0); }
            bf16x8 ub0, ub1;
            { const bf16x8 t0 = frag_trp(TB, 72, 32, 32, lane), t1 = frag_trp(TB, 72, 32, 48, lane); f32x16 Ub = zero16();
              Ub = MFMA32(t0, acc_frag(A0, 0), Ub); Ub = MFMA32(t1, acc_frag(A0, 1), Ub);
              ub0 = acc_frag(Ub, 0); ub1 = acc_frag(Ub, 1); }
            if (ci == 1) {
                A0 = zero16();
                bf16x8 fa[12];
#pragma unroll
                for (int ks = 0; ks < 4; ++ks) { fa[ks] = frag_tr(ARK, 72, 32, 16 * ks, lane); fa[4 + ks] = frag_kc(RTs, 72, 32, 16 * ks, lane); fa[8 + ks] = frag_trp(ARB, 72, 32, 16 * ks, lane); }
#pragma unroll
                for (int ks = 0; ks < 4; ++ks) A0 = MFMA32(fa[ks], vf[ks], A0);
#pragma unroll
                for (int ks = 0; ks < 4; ++ks) A0 = MFMA32(fa[4 + ks], sf[ks], A0);
                A0 = MFMA32(fa[8], ut0, A0); A0 = MFMA32(fa[9], ut1, A0); A0 = MFMA32(fa[10], ub0, A0); A0 = MFMA32(fa[11], ub1, A0);
                if (wr_y) {
#pragma unroll
                    for (int i = 0; i < 16; ++i) { const int j1 = 32 + arow(i, h5); const long r1 = rowbaseS + (dir ? 63 - j1 : j1); YY[r1 * 1024 + dir * 512 + h * 64 + v0 + r] = (u16)(pkbf(A0[i], 0.f) & 0xffffu); }
                }
            }
            { bf16x8 fb[6];
              fb[0] = frag_trp(BTs, 72, cs, 32, lane); fb[1] = frag_trp(BTs, 72, cs, 48, lane);
#pragma unroll
              for (int ks = 0; ks < 4; ++ks) fb[2 + ks] = frag_tr(KTs, 72, cs, 16 * ks, lane);
              Sa = MFMA32(ub0, fb[0], Sa); Sa = MFMA32(ub1, fb[1], Sa);
#pragma unroll
              for (int ks = 0; ks < 4; ++ks) Sa = MFMA32(vf[ks], fb[2 + ks], Sa); }
            { const float pca = PC[cs + r];
#pragma unroll
              for (int i = 0; i < 16; ++i) Sa[i] *= pca; }
        }
        if (e_on) { LOAD_CC(); }
        TSTB(1);
        LBAR();
        TST(1);
        if (s_on && wave < 4) st_tile_T(SBT, 72, 32 * (wave >> 1), 32 * (wave & 1), Sa, lane);
        float cum0 = 0.f, cum1 = 0.f; float sbv[4];
        for (int rq = 0; rq < RQ_E2A; ++rq) if (e_on) {
            cum0 = 0.f; cum1 = 0.f;
            const f32x2 kkp = cC_kk, kap = cC_ka, rkp = cC_rk;
            const float kk0 = kkp.x, kk1 = kkp.y, ka0 = kap.x, ka1 = kap.y, rk0 = rkp.x, rk1 = rkp.y;
            unsigned lwu[4], agu[4];
#pragma unroll
            for (int i = 0; i < 4; ++i) { const int j = 4 * tg + i; lwu[i] = *(const LAS unsigned*)(LWh + j * 72 + c0); agu[i] = *(const LAS unsigned*)(AGb + j * 72 + c0); }
#pragma unroll
            for (int i = 0; i < 4; ++i) {
                lw[i][0] = h2f((unsigned short)(lwu[i] & 0xffffu)); lw[i][1] = h2f((unsigned short)(lwu[i] >> 16));
                const float ag0 = bflo(agu[i]), ag1 = bfhi(agu[i]);
                float k0 = kv[i][0] * kk0, k1 = kv[i][1] * kk1; float ss = k0 * k0 + k1 * k1;
                kd[i][0] = kv[i][0] * (1.0f + (ag0 - 1.0f) * ka0); kd[i][1] = kv[i][1] * (1.0f + (ag1 - 1.0f) * ka1);
                float sb = rv[i][0] * kd[i][0] * rk0 + rv[i][1] * kd[i][1] * rk1;
                ss = sum32(ss); sb = sum32(sb); sbv[i] = sb;
                const float inv = 1.0f / fmaxf(sqrtf(ss), 1e-12f); k0 *= inv; k1 *= inv;
                av[i][0] = -k0; av[i][1] = -k1; bv[i][0] = k0 * ag0; bv[i][1] = k1 * ag1;
                cum0 += lw[i][0]; cum1 += lw[i][1]; cl[i][0] = cum0; cl[i][1] = cum1;
            }
            if (wr_sb && r == 0) {
#pragma unroll
                for (int i = 0; i < 4; ++i) { const int j = 4 * tg + i, tl = dir ? 63 - j : j; SBv[((size_t)dir * NTOK + rowbaseE + tl) * 8 + h] = sbv[i]; }
            }
            *(LAS f32x2*)(TOT + tg * 64 + c0) = (f32x2){cum0, cum1};
#pragma unroll
            for (int i = 0; i < 4; ++i) *(LAS unsigned*)(VVs + (4 * tg + i) * 72 + c0) = pkbf(vv[i][0], vv[i][1]);
            if (n + 2 < 132) { RW_LOAD(n + 2); }
        }
        TSTB(2);
        LBAR();
        TST(2);
        for (int rq = 0; rq < RQ_E2B; ++rq) if (e_on) {
            float base0 = 0.f, base1 = 0.f, tt0 = 0.f, tt1 = 0.f;
#pragma unroll
            for (int g = 0; g < 16; ++g) { const f32x2 t = *(const LAS f32x2*)(TOT + g * 64 + c0); if (g < tg) { base0 += t.x; base1 += t.y; } tt0 += t.x; tt1 += t.y; }
            float Xp0 = __expf(base0), Xp1 = __expf(base1);
#pragma unroll
            for (int i = 0; i < 4; ++i) {
                const int j = 4 * tg + i;
                const float E0 = __expf(base0 + cl[i][0]), E1 = __expf(base1 + cl[i][1]), I0 = __builtin_amdgcn_rcpf(E0), I1 = __builtin_amdgcn_rcpf(E1);
                *(LAS unsigned*)(ATs + j * 72 + c0) = pkbf(av[i][0] * Xp0, av[i][1] * Xp1);
                *(LAS unsigned*)(BTs + j * 72 + c0) = pkbf(bv[i][0] * I0, bv[i][1] * I1);
                *(LAS unsigned*)(KTs + j * 72 + c0) = pkbf(kd[i][0] * I0, kd[i][1] * I1);
                *(LAS unsigned*)(RTs + j * 72 + c0) = pkbf(rv[i][0] * E0, rv[i][1] * E1);
                Xp0 = E0; Xp1 = E1;
            }
            if (tg == 0) *(LAS f32x2*)(PC + c0) = (f32x2){__expf(tt0), __expf(tt1)};
        }
        TSTB(3);
        LBAR();
        TST(3);
        for (int rq = 0; rq < RQ_M2; ++rq) if (e_on) {
            const int mtx = wave & 3; const LAS u16* Am = mtx < 2 ? ATs : RTs; const LAS u16* Bm = (mtx & 1) ? KTs : BTs; LAS u16* Dm = (LAS u16*)(lds + RW_LB + 9216 * mtx);
            const int ntile = wave < 4 ? 2 : 1;
#pragma unroll
            for (int q = 0; q < 2; ++q) if (q < ntile) {
                const int ti = wave < 4 ? 1 - q : 1, ii = wave < 4 ? 0 : 1;
                f32x16 a = zero16();
#pragma unroll
                for (int ks = 0; ks < 4; ++ks) a = MFMA32(frag_kc(Am, 72, 32 * ti, 16 * ks, lane), frag_kc(Bm, 72, 32 * ii, 16 * ks, lane), a);
#pragma unroll
                for (int i = 0; i < 16; ++i) { const int lim = (ti != ii) ? 64 : (arow(i, h5) + (mtx < 2 ? 0 : 1)); a[i] = (r < lim) ? a[i] : 0.f; }
                st_tile_T(Dm, 72, 32 * ti, 32 * ii, a, lane);
                if (mtx == 0 && ti == ii) {
#pragma unroll
                    for (int i = 0; i < 16; ++i) { const int t = arow(i, h5); if ((t >> 4) == (r >> 4)) LF[(2 * ti + (t >> 4)) * 320 + (t & 15) * 20 + (r & 15)] = a[i]; }
                }
            }
        }
        if (n + 2 < 132) { LOAD_CA(); }
        TSTB(4);
        LBAR();
        TST(4);
    }
#ifdef DBG_TSTAGE
    if (b == 0 && h == 0 && dir == 0 && wave == DBG_TWAVE && (lane_in == 0)) ((float*)(p.ws + WS_CTL))[8192] = __expf(floorf(__logf((float)tacc / 133.0f) * 20.0f + 0.5f) * 0.05f);
#endif
#undef RW_LOAD
}

__device__ __forceinline__ void gate_panel(const Params& p, LAS unsigned char* lds, int lane, int wave, int pm) {
    const u16* Z = (const u16*)(p.ws + WS_Z); u16* GG = (u16*)(p.ws + WS_G); const u16* G2T = (const u16*)(p.ws + WS_G2T);
    LAS u16* Gs = (LAS u16*)(lds + wave * 6656);
    const int r = lane & 31, h5 = lane >> 5;
    {   const int rr = lane >> 1, half = lane & 1; const long row = (long)pm * 256 + wave * 32 + rr; const bool vd = (row & (SEQ - 1)) < SEQ - 64;
        const u16* zc = Z + row * ZLD + ZR + 1664 + 48 * half; const u16* zn = zc + (vd ? 64 * ZLD : 0);
#pragma unroll
        for (int q = 0; q < 6; ++q) { const v4u c = *(const v4u*)(zc + 8 * q); v4u nb = *(const v4u*)(zn + 8 * q); if (!vd) nb = (v4u){0u, 0u, 0u, 0u};
            const f32x4 m0 = *(const f32x4*)(p.mu + 1664 + 48 * half + 8 * q), m1 = *(const f32x4*)(p.mu + 1664 + 48 * half + 8 * q + 4);
            float cv[8], nv[8]; unpack8(c, cv); unpack8(nb, nv);
            float g[8];
#pragma unroll
            for (int e = 0; e < 8; ++e) { const float mu = e < 4 ? m0[e] : m1[e - 4]; g[e] = sigm(cv[e] + mu * (nv[e] - cv[e])); }
            *(LAS v4u*)(Gs + rr * 104 + 48 * half + 8 * q) = (v4u){pkbf(g[0], g[1]), pkbf(g[2], g[3]), pkbf(g[4], g[5]), pkbf(g[6], g[7])}; } }
    asm volatile("s_waitcnt lgkmcnt(0)" ::: "memory");
    bf16x8 af[6];
#pragma unroll
    for (int ks = 0; ks < 6; ++ks) af[ks] = frag_kc(Gs, 104, 0, 16 * ks, lane);
    for (int ct = 0; ct < 16; ++ct) {
        f32x16 a = zero16();
        const u16* bp = G2T + (size_t)(32 * ct + r) * 96 + 8 * h5;
#pragma unroll
        for (int ks = 0; ks < 6; ++ks) a = MFMA32(af[ks], *(const bf16x8*)(bp + 16 * ks), a);
#pragma unroll
        for (int i = 0; i < 16; ++i) { const long row = (long)pm * 256 + wave * 32 + arow(i, h5); GG[row * 512 + 32 * ct + r] = (u16)(pkbf(a[i], 0.f) & 0xffffu); }
    }
    asm volatile("s_waitcnt lgkmcnt(0)" ::: "memory");
}
#define CU_SYNC() do { asm volatile("s_waitcnt vmcnt(0)" ::: "memory"); __syncthreads(); __builtin_amdgcn_fence(__ATOMIC_ACQUIRE, "agent"); asm volatile("s_waitcnt vmcnt(0)" ::: "memory"); __syncthreads(); } while (0)
__device__ __forceinline__ void hgrn_combine_panel(const Params& p, int pm, int lane, int wave) {
    const u16* Z = (const u16*)(p.ws + WS_Z); u16* O = (u16*)p.out;
    float nw[8];
#pragma unroll
    for (int e = 0; e < 8; ++e) nw[e] = p.hg_norm_w[((8 * lane) & 127) + e];
    constexpr int RB = 4;
    for (int i = 0; i < 32; i += RB) {
        v4u uof[RB], uob[RB], uog[RB];
#pragma unroll
        for (int q = 0; q < RB; ++q) { const long row = (long)pm * 256 + wave * 32 + i + q;
            uof[q] = *(const v4u*)(O + row * 1024 + 8 * lane); uob[q] = *(const v4u*)(O + row * 1024 + 512 + 8 * lane); uog[q] = *(const v4u*)(Z + row * ZLD + ZOG + 8 * lane); }
#pragma unroll
        for (int q = 0; q < RB; ++q) { const long row = (long)pm * 256 + wave * 32 + i + q;
            float a[8], b[8], c[8], o[8];
            unpack8(uof[q], a); unpack8(uob[q], b); unpack8(uog[q], c);
            float ss = 0.f;
#pragma unroll
            for (int e = 0; e < 8; ++e) { o[e] = a[e] + b[e]; ss += o[e] * o[e]; }
            ss = sum16(ss);
            const float rs = 1.0f / sqrtf(ss * (1.0f / 128.0f) + 1e-5f);
            v4u wh;
            wh.x = pkbf(o[0] * rs * nw[0] * c[0], o[1] * rs * nw[1] * c[1]); wh.y = pkbf(o[2] * rs * nw[2] * c[2], o[3] * rs * nw[3] * c[3]);
            wh.z = pkbf(o[4] * rs * nw[4] * c[4], o[5] * rs * nw[5] * c[5]); wh.w = pkbf(o[6] * rs * nw[6] * c[6], o[7] * rs * nw[7] * c[7]);
            *(v4u*)(O + row * 1024 + 8 * lane) = wh; }
    }
}
__device__ __forceinline__ void combine_panel(const Params& p, int pm, int lane, int wave) {
    u16* YY = (u16*)(p.ws + WS_YY); const u16* VL = (const u16*)(p.ws + WS_VL); const u16* GG = (const u16*)(p.ws + WS_G);
    const float* SBv = (const float*)(p.ws + WS_SB);
    float lw_[8], lb_[8];
#pragma unroll
    for (int e = 0; e < 8; ++e) { lw_[e] = p.lnxw[8 * lane + e]; lb_[e] = p.lnxb[8 * lane + e]; }
    const int hh = lane >> 3;
    constexpr int RB = 4;
    for (int i = 0; i < 32; i += RB) {
        v4u uyf[RB], uyb[RB], uv[RB], ug[RB]; float sfb[RB];
#pragma unroll
        for (int q = 0; q < RB; ++q) { const long row = (long)pm * 256 + wave * 32 + i + q;
            uyf[q] = *(const v4u*)(YY + row * 1024 + 8 * lane); uyb[q] = *(const v4u*)(YY + row * 1024 + 512 + 8 * lane); uv[q] = *(const v4u*)(VL + row * 512 + 8 * lane); ug[q] = *(const v4u*)(GG + row * 512 + 8 * lane);
            sfb[q] = SBv[(size_t)row * 8 + hh] + SBv[((size_t)NTOK + row) * 8 + hh]; }
#pragma unroll
        for (int q = 0; q < RB; ++q) { const long row = (long)pm * 256 + wave * 32 + i + q;
            float yf[8], yb[8], vv[8], gg[8], y[8];
            unpack8(uyf[q], yf); unpack8(uyb[q], yb); unpack8(uv[q], vv); unpack8(ug[q], gg);
            float sm = 0.f;
#pragma unroll
            for (int e = 0; e < 8; ++e) { y[e] = yf[e] + yb[e]; sm += y[e]; }
            sm = sum8(sm);
            const float mean = sm * (1.0f / 64.0f); float sq = 0.f;
#pragma unroll
            for (int e = 0; e < 8; ++e) { y[e] -= mean; sq += y[e] * y[e]; }
            sq = sum8(sq);
            const float rstd = 1.0f / sqrtf(sq * (1.0f / 64.0f) + 64e-5f);
#pragma unroll
            for (int e = 0; e < 8; ++e) y[e] = (y[e] * rstd * lw_[e] + lb_[e] + sfb[q] * vv[e]) * gg[e];
            v4u wr; wr.x = pkbf(y[0], y[1]); wr.y = pkbf(y[2], y[3]); wr.z = pkbf(y[4], y[5]); wr.w = pkbf(y[6], y[7]);
            *(v4u*)(YY + row * 1024 + 512 + 8 * lane) = wr; }
    }
}
template <int RB> __device__ __forceinline__ void row_stats(f32x4 (&v)[RB][4], float (&mean)[RB], float (&rstd)[RB], float eps) {
    float s[RB];
#pragma unroll
    for (int q = 0; q < RB; ++q) { s[q] = 0.f;
#pragma unroll
        for (int j = 0; j < 4; ++j) s[q] += (v[q][j].x + v[q][j].y) + (v[q][j].z + v[q][j].w); }
#pragma unroll
    for (int q = 0; q < RB; ++q) mean[q] = wave_sum(s[q]) * (1.f / DM);
#pragma unroll
    for (int q = 0; q < RB; ++q) { s[q] = 0.f;
#pragma unroll
        for (int j = 0; j < 4; ++j) { v[q][j] = v[q][j] - mean[q]; s[q] += (v[q][j].x * v[q][j].x + v[q][j].y * v[q][j].y) + (v[q][j].z * v[q][j].z + v[q][j].w * v[q][j].w); } }
#pragma unroll
    for (int q = 0; q < RB; ++q) rstd[q] = 1.f / sqrtf(wave_sum(s[q]) * (1.f / DM) + eps);
}
__device__ __forceinline__ void ln1_panel(const Params& p, int pm, int lane, int wave) {
    const float* mod = (const float*)(p.ws + WS_MOD) + (size_t)((pm * 256) >> 13) * 6144; u16* U = (u16*)(p.ws + WS_U); const u16* F = (const u16*)(p.ws + WS_VL); u16* X1 = (u16*)(p.ws + WS_YY);
    constexpr int RB = 4;
    for (int i = 0; i < 32; i += RB) {
        const long row0 = (long)pm * 256 + wave * 32 + i;
        f32x4 v[RB][4]; float mean[RB], rstd[RB];
#pragma unroll
        for (int q = 0; q < RB; ++q)
#pragma unroll
            for (int j = 0; j < 4; ++j) { const f32x4 xv = ((const f32x4*)(p.x + (row0 + q) * DM))[lane + 64 * j]; const u32x2 fv = ((const u32x2*)(F + (row0 + q) * DM))[lane + 64 * j];
                v[q][j] = xv * ALPHA + (f32x4){bflo(fv.x), bfhi(fv.x), bflo(fv.y), bfhi(fv.y)}; }
        row_stats<RB>(v, mean, rstd, 1e-5f);
#pragma unroll
        for (int j = 0; j < 4; ++j) { const f32x4 g = ((const f32x4*)p.ln1g)[lane + 64 * j], bb = ((const f32x4*)p.ln1b)[lane + 64 * j];
#pragma unroll
            for (int q = 0; q < RB; ++q) { v[q][j] = v[q][j] * rstd[q] * g + bb; u32x2 w; w.x = pkbf(v[q][j].x, v[q][j].y); w.y = pkbf(v[q][j].z, v[q][j].w); ((u32x2*)(X1 + (row0 + q) * DM))[lane + 64 * j] = w; } }
        row_stats<RB>(v, mean, rstd, 1e-6f);
#pragma unroll
        for (int j = 0; j < 4; ++j) { const f32x4 sh = ((const f32x4*)(mod + 3072))[lane + 64 * j], sc = ((const f32x4*)(mod + 4096))[lane + 64 * j];
#pragma unroll
            for (int q = 0; q < RB; ++q) { const f32x4 r = v[q][j] * rstd[q] * (sc + 1.0f) + sh; u32x2 w; w.x = pkbf(r.x, r.y); w.y = pkbf(r.z, r.w); ((u32x2*)(U + (row0 + q) * DM))[lane + 64 * j] = w; } }
    }
}
__device__ __forceinline__ void ln2_panel(const Params& p, int pm, int lane, int wave) {
    const u16* F = (const u16*)(p.ws + WS_VL); const u16* X1 = (const u16*)(p.ws + WS_YY);
    constexpr int RB = 4;
    for (int i = 0; i < 32; i += RB) {
        const long row0 = (long)pm * 256 + wave * 32 + i;
        f32x4 v[RB][4]; float mean[RB], rstd[RB];
#pragma unroll
        for (int q = 0; q < RB; ++q)
#pragma unroll
            for (int j = 0; j < 4; ++j) { const u32x2 xb = ((const u32x2*)(X1 + (row0 + q) * DM))[lane + 64 * j]; const u32x2 fv = ((const u32x2*)(F + (row0 + q) * DM))[lane + 64 * j];
                v[q][j] = (f32x4){bflo(xb.x), bfhi(xb.x), bflo(xb.y), bfhi(xb.y)} * ALPHA + (f32x4){bflo(fv.x), bfhi(fv.x), bflo(fv.y), bfhi(fv.y)}; }
        row_stats<RB>(v, mean, rstd, 1e-5f);
#pragma unroll
        for (int j = 0; j < 4; ++j) { const f32x4 g = ((const f32x4*)p.ln2g)[lane + 64 * j], bb = ((const f32x4*)p.ln2b)[lane + 64 * j];
#pragma unroll
            for (int q = 0; q < RB; ++q) { f32x4 o = v[q][j] * rstd[q] * g + bb;
#ifdef DBG_SANITIZE
                for (int e2 = 0; e2 < 4; ++e2) if (!(fabsf(o[e2]) < 1e30f)) o[e2] = 0.f;
#endif
                __builtin_nontemporal_store(o, (f32x4*)(p.out + (row0 + q) * DM) + lane + 64 * j); } }
    }
}

#ifndef P1_ALIGN
#define P1_ALIGN true
#endif
#ifndef P1_WGM
#define P1_WGM 8
#endif
#ifndef REP_LN1
#define REP_LN1 1
#endif
#ifndef REP0
#define REP0 1
#endif
#ifndef REP_DOWN
#define REP_DOWN 1
#endif
#ifndef REP_OUT
#define REP_OUT 1
#endif
#ifndef REP_GU
#define REP_GU 1
#endif
#ifndef REP1
#define REP1 1
#endif
#ifndef REP2
#define REP2 1
#endif
#ifndef REP_RW
#define REP_RW 1
#endif
#ifndef REP_HG
#define REP_HG 1
#endif
#ifndef N_LAUNCHES
#define N_LAUNCHES 1
#endif
typedef const unsigned long long __attribute__((address_space(4))) KWord;
__device__ __forceinline__ Params load_params(KWord* k) { asm volatile("" : "+s"(k)); Params q; unsigned long long* d = (unsigned long long*)&q;
#pragma unroll
    for (int i = 0; i < (int)(sizeof(Params) / 8); ++i) d[i] = k[i];
    return q; }
#define PARAMS() const Params p = load_params(kp)
__global__ void __launch_bounds__(NWAVES * 64, 2) mega_fwd(Params p_arg, int ph_lo, int ph_hi) {
    KWord* kp = (KWord*)__builtin_amdgcn_kernarg_segment_ptr();
    extern __shared__ __attribute__((aligned(16))) unsigned char lds_raw[];
    LAS unsigned char* lds = (LAS unsigned char*)lds_raw;
    const int wave = __builtin_amdgcn_readfirstlane((int)threadIdx.x >> 6), bid = blockIdx.x, G = gridDim.x;
#define TID_LANE() int lane; asm volatile("v_mbcnt_lo_u32_b32 %0, -1, 0\n\tv_mbcnt_hi_u32_b32 %0, -1, %0" : "=v"(lane)); const int tid = wave * 64 + lane
    volatile LAS unsigned* MISC = (volatile LAS unsigned*)(lds + MISC_OFF);
    { TID_LANE(); if (tid < 32) MISC[tid] = 0u; }
    __syncthreads();
    XcdBarrier bar; { PARAMS(); bar.bar = (unsigned*)(p.ws + WS_CTL) + CW_BAR; bar.x = 0; bar.st = nullptr;
    if (N_LAUNCHES == 1) bar = xcd_barrier_post((unsigned*)(p.ws + WS_CTL) + CW_BAR, MISC + 8); }
#ifndef PHASE_MASK
#define PHASE_MASK 1023
#endif
#define IN(k) (((PHASE_MASK >> (k)) & 1) && ph_lo <= (k) && (k) < ph_hi)
#define SEAM(k) do { if (N_LAUNCHES == 1 && IN(k) && IN((k) + 1)) xcd_barrier(bar); } while (0)
    if (IN(0)) { PARAMS(); TID_LANE(); for (int rp = 0; rp < REP0; ++rp) phase0a(p, lds, tid, lane, wave, bid, G); } SEAM(0);
    if (IN(1)) { PARAMS(); TID_LANE(); for (int rp = 0; rp < REP1; ++rp) phase0b(p, lane, wave, bid, G); } SEAM(1);
    if (IN(2)) { PARAMS(); TID_LANE();
        pg8::Gemm g{(const u16*)(p.ws + WS_U), (const u16*)(p.ws + WS_WIN), MROWS, ZLD, DM, DM, DM}; pg8::StaticOrder S; S.init(MROWS, ZLD - 512, G, bid, P1_WGM); S.gap_at = 8; S.gap = 2;
        const LAS float* epl = (const LAS float*)(lds + EPI_OFF);
        { LAS float* w = (LAS float*)(lds + EPI_OFF); const float* lbg = (const float*)(p.ws + WS_LB); for (int i = tid; i < 1024; i += NWAVES * 64) w[i] = lbg[i]; __syncthreads(); }
        pg8::EpiZ E{(u16*)(p.ws + WS_Z), ZLD, (const float*)(p.ws + WS_LB), 0};
#ifdef P1_STAGGER
        { const int grp = (bid >> 3) & (P1_STAGGER - 1); if (grp) { const unsigned long long t0 = __builtin_amdgcn_s_memrealtime(); while (__builtin_amdgcn_s_memrealtime() - t0 < (unsigned long long)(2900 / P1_STAGGER) * grp) __builtin_amdgcn_s_sleep(8); } }
#endif
#ifdef PROBE_P1NULL_FIRST
        { pg8::EpiNull E0; pg8::gemm_phase<pg8::EpiNull, pg8::StaticOrder, true, true>(lds, g, S, E0, launder(tid)); }
#endif
#ifdef PROBE_P1RAW
        for (int rp = 0; rp < 2; ++rp) { pg8::EpiZ Er{(u16*)(p.ws + (rp == 0 ? WS_YY : WS_Z)), ZLD, (const float*)(p.ws + WS_LB), rp == 0 ? PROBE_P1RAW : 0}; pg8::gemm_phase<pg8::EpiZ, pg8::StaticOrder, P1_ALIGN, true>(lds, g, S, Er, launder(tid)); }
#else
        for (int rp = 0; rp < REP2; ++rp) pg8::gemm_phase<pg8::EpiZ, pg8::StaticOrder, P1_ALIGN, true>(lds, g, S, E, launder(tid));
#endif
#ifdef PROBE_P1NULL
        { pg8::EpiNull E0; pg8::StaticOrder S0; S0.init(PROBE_P1NULL == 2 ? NTOK : MROWS, ZLD, G, bid, P1_WGM); pg8::gemm_phase<pg8::EpiNull, pg8::StaticOrder, true, true>(lds, g, S0, E0, launder(tid)); }
#endif
    } SEAM(2);
    if (IN(3)) { PARAMS();
        constexpr int NGATE = 64;
        for (int task = bid; task < 192 + NGATE; task += G) {
            int lane2; asm volatile("v_mbcnt_lo_u32_b32 %0, -1, 0\n\tv_mbcnt_hi_u32_b32 %0, -1, %0" : "=v"(lane2)); const int tid2 = wave * 64 + lane2;
            if (task < 128) { for (int rp = 0; rp < REP_RW; ++rp) rwkv_chain(p, lds, tid2, lane2, wave, task >> 4, (task >> 1) & 7, task & 1); }
            else if (task < 192) { const int t = task - 128; for (int rp = 0; rp < REP_HG; ++rp) hgrn_chain(p, lds, tid2, lane2, wave, t >> 3, (t >> 1) & 3, t & 1);
                asm volatile("s_waitcnt vmcnt(0)" ::: "memory"); __syncthreads();
                if (threadIdx.x == 0) { __builtin_amdgcn_fence(__ATOMIC_RELEASE, "agent"); asm volatile("s_waitcnt vmcnt(0)" ::: "memory");
                    (void)xb_add((unsigned*)(p.ws + WS_CTL) + CW_HG + 16 * (t >> 3), 1u); } }
            else { const int oc = task - 192;
                for (int pm = oc; pm < NTOK / 256; pm += NGATE) gate_panel(p, lds, lane2, wave, pm);
                __syncthreads();
                { int lane3; asm volatile("v_mbcnt_lo_u32_b32 %0, -1, 0\n\tv_mbcnt_hi_u32_b32 %0, -1, %0" : "=v"(lane3)); const int tid3 = wave * 64 + lane3;
                  pg8::Gemm g{(const u16*)(p.ws + WS_U), (const u16*)(p.ws + WS_WIN), MROWS, ZLD, DM, DM, DM}; pg8::OgOrder S{oc, NGATE, NTOK / 256};
                  pg8::EpiZ E{(u16*)(p.ws + WS_Z), ZLD, (const float*)(p.ws + WS_LB), 0};
                  pg8::gemm_phase<pg8::EpiZ, pg8::OgOrder, true, true>(lds, g, S, E, tid3); }
                asm volatile("s_waitcnt vmcnt(0)" ::: "memory"); __syncthreads();
                for (int pm = oc; pm < NTOK / 256; pm += NGATE) {
                    if (threadIdx.x == 0) { unsigned* cnt = (unsigned*)(p.ws + WS_CTL) + CW_HG + 16 * (pm >> 5); unsigned* bar = (unsigned*)(p.ws + WS_CTL) + CW_BAR;
                        XB_SPIN(xb_ld(cnt) < 8u, bar);
                        __builtin_amdgcn_fence(__ATOMIC_ACQUIRE, "agent"); asm volatile("s_waitcnt vmcnt(0)" ::: "memory"); }
                    __syncthreads();
                    int lane3; asm volatile("v_mbcnt_lo_u32_b32 %0, -1, 0\n\tv_mbcnt_hi_u32_b32 %0, -1, %0" : "=v"(lane3));
                    hgrn_combine_panel(p, pm, lane3, wave);
                } }
            __syncthreads();
        }
    } SEAM(3);
    if (IN(4)) { PARAMS(); TID_LANE(); for (int pm = bid; pm < NTOK / 256; pm += G) combine_panel(p, pm, launder(lane), wave); } SEAM(4);
    if (IN(5)) { PARAMS(); TID_LANE();
        pg8::Gemm g{(const u16*)p.out, (const u16*)(p.ws + WS_WOUT), NTOK, DM, DM, DM, DM, (long)((const char*)(p.ws + WS_YY) - (const char*)p.out), 8};   pg8::StaticOrder S; S.init(NTOK, DM, G, bid);
        int bl = -1; bool same = true; { pg8::Unit u0; if (S.next(0, u0)) bl = u0.pm >> 5; for (int i = 1; S.next(i, u0); ++i) same = same && ((u0.pm >> 5) == bl); }
        { LAS float* w = (LAS float*)(lds + EPI_OFF); const float* gg = (const float*)(p.ws + WS_MOD) + 2048 + (size_t)(bl < 0 ? 0 : bl) * 6144; for (int i = tid; i < 1024; i += NWAVES * 64) w[i] = gg[i]; __syncthreads(); }
        if (same) { pg8::EpiGate<true> E{(u16*)(p.ws + WS_VL), DM, (const float*)(p.ws + WS_MOD) + 2048, (const LAS float*)(lds + EPI_OFF)};
            for (int rp = 0; rp < REP_OUT; ++rp) pg8::gemm_phase<pg8::EpiGate<true>, pg8::StaticOrder, true, true>(lds, g, S, E, launder(tid)); }
        else { pg8::EpiGate<false> E{(u16*)(p.ws + WS_VL), DM, (const float*)(p.ws + WS_MOD) + 2048, (const LAS float*)(lds + EPI_OFF)};
            pg8::gemm_phase<pg8::EpiGate<false>, pg8::StaticOrder, true, true>(lds, g, S, E, launder(tid)); }
    } SEAM(5);
    if (IN(6)) { PARAMS(); TID_LANE(); for (int rp = 0; rp < REP_LN1; ++rp) for (int pm = bid; pm < NTOK / 256; pm += G) ln1_panel(p, pm, launder(lane), wave); } SEAM(6);
    if (IN(7)) { PARAMS(); TID_LANE();
        pg8::Gemm g{(const u16*)(p.ws + WS_U), (const u16*)(p.ws + WS_WGU), NTOK, 2 * DFF, DM, DM, DM}; pg8::StaticOrder S; S.init(NTOK, 2 * DFF, G, bid);
        pg8::EpiGU E{(u16*)(p.ws + WS_Z), ZLD};
        for (int rp = 0; rp < REP_GU; ++rp) pg8::gemm_phase<pg8::EpiGU, pg8::StaticOrder, true, true>(lds, g, S, E, launder(tid));
#ifdef PROBE_GUNULL
        { pg8::EpiNull E0; pg8::gemm_phase<pg8::EpiNull, pg8::StaticOrder, true, true>(lds, g, S, E0, launder(tid)); }
#endif
#ifdef PROBE_XN
        { pg8::EpiNull E0; pg8::Gemm gx{(const u16*)(p.ws + WS_U), (const u16*)(p.ws + PROBE_XB), PROBE_XM, PROBE_XN, DM, DM, DM}; pg8::StaticOrder Sx; Sx.init(PROBE_XM, PROBE_XN, G, bid, PROBE_XW); pg8::gemm_phase<pg8::EpiNull, pg8::StaticOrder, true, true>(lds, gx, Sx, E0, launder(tid)); }
#endif
    } SEAM(7);
    if (IN(8)) { PARAMS(); TID_LANE();
        pg8::Gemm g{(const u16*)(p.ws + WS_Z), (const u16*)(p.ws + WS_WD), NTOK, DM, DFF, ZLD, DFF}; pg8::StaticOrder S; S.init(NTOK, DM, G, bid);
        int bl = -1; bool same = true; { pg8::Unit u0; if (S.next(0, u0)) bl = u0.pm >> 5; for (int i = 1; S.next(i, u0); ++i) same = same && ((u0.pm >> 5) == bl); }
        { LAS float* w = (LAS float*)(lds + EPI_OFF); const float* gg = (const float*)(p.ws + WS_MOD) + 5120 + (size_t)(bl < 0 ? 0 : bl) * 6144; for (int i = tid; i < 1024; i += NWAVES * 64) w[i] = gg[i]; __syncthreads(); }
        if (same) { pg8::EpiGate<true> E{(u16*)(p.ws + WS_VL), DM, (const float*)(p.ws + WS_MOD) + 5120, (const LAS float*)(lds + EPI_OFF)};
            for (int rp = 0; rp < REP_DOWN; ++rp) pg8::gemm_phase<pg8::EpiGate<true>, pg8::StaticOrder, true, true>(lds, g, S, E, launder(tid)); }
        else { pg8::EpiGate<false> E{(u16*)(p.ws + WS_VL), DM, (const float*)(p.ws + WS_MOD) + 5120, (const LAS float*)(lds + EPI_OFF)};
            pg8::gemm_phase<pg8::EpiGate<false>, pg8::StaticOrder, true, true>(lds, g, S, E, launder(tid)); }
    } SEAM(8);
    if (IN(9)) { PARAMS(); TID_LANE(); for (int pm = bid; pm < NTOK / 256; pm += G) ln2_panel(p, pm, launder(lane), wave);
#ifdef DBG_TSTAGE
        if (bid == 0 && tid == 0) { asm volatile("s_waitcnt vmcnt(0)" ::: "memory"); p.out[0] += ((const float*)(p.ws + WS_CTL))[8192]; }
#endif
    }
#undef IN
#undef SEAM
}

extern "C" void kernel_launch(void* const* d_in, const int* in_sizes, int n_in, void* d_out, int out_size, void* d_ws, size_t ws_size, hipStream_t stream) {
    static int grid = 0;
    if (grid == 0) {
        if (n_in != 28 || in_sizes[0] != NTOK * DM || out_size != NTOK * DM || ws_size < WS_END) { fprintf(stderr, "kernel_launch: unexpected shapes: n_in %d in0 %d out %d ws %zu (need %zu)\n", n_in, n_in > 0 ? in_sizes[0] : -1, out_size, ws_size, (size_t)WS_END); grid = -1; return; }
        int dev = 0, cus = 0, per_cu = 0;
        if (hipGetDevice(&dev) != hipSuccess || hipDeviceGetAttribute(&cus, hipDeviceAttributeMultiprocessorCount, dev) != hipSuccess) { grid = -1; return; }
        if (hipFuncSetAttribute((const void*)mega_fwd, hipFuncAttributeMaxDynamicSharedMemorySize, LDS_BYTES) != hipSuccess) { fprintf(stderr, "kernel_launch: hipFuncSetAttribute failed\n"); grid = -1; return; }
        if (hipOccupancyMaxActiveBlocksPerMultiprocessor(&per_cu, (const void*)mega_fwd, NWAVES * 64, LDS_BYTES) != hipSuccess || per_cu < 1) { fprintf(stderr, "kernel_launch: occupancy query says %d blocks per CU\n", per_cu); (void)hipGetLastError(); grid = -1; return; }
        grid = cus;
    }
    if (grid < 0) return;
    Params p{};
    const float** pp = (const float**)&p;
    for (int i = 0; i < 28; ++i) pp[i] = (const float*)d_in[i];
    p.out = (float*)d_out; p.ws = (unsigned char*)d_ws;
#if N_LAUNCHES == 1
    if (hipMemsetAsync((char*)d_ws + WS_CTL, 0, CTL_ZERO_BYTES, stream) != hipSuccess) { fprintf(stderr, "kernel_launch: memset failed\n"); return; }
    hipLaunchKernelGGL(mega_fwd, dim3(grid), dim3(NWAVES * 64), LDS_BYTES, stream, p, 0, 10);
#else
    for (int ph = 0; ph < 10; ++ph) hipLaunchKernelGGL(mega_fwd, dim3(grid), dim3(NWAVES * 64), LDS_BYTES, stream, p, ph, ph + 1);
#endif
}
```

```cpp
#include <hip/hip_runtime.h>
#include <cstdio>
#include <cstdint>

namespace pg8 {
#define PG8_LAS __attribute__((address_space(3)))
#define PG8_GAS __attribute__((address_space(1)))
typedef unsigned short bf16_t;
typedef short bf16x8 __attribute__((ext_vector_type(8)));
typedef float f32x4 __attribute__((ext_vector_type(4)));
typedef unsigned u32x4 __attribute__((ext_vector_type(4)));
constexpr int BM = 256, BK = 64, HALF = 128, HTB = HALF * BK * 2, STAGE_BYTES = 8 * HTB, NXCD = 8, WGM = 8;

__host__ __device__ __forceinline__ int lds_byte(int r, int c) { const int st = (r >> 4) * 2 + (c >> 5), rr = r & 15, cc = c & 31, ob = rr * 64 + cc * 2; return st * 1024 + (ob ^ (((ob >> 9) & 1) << 5)); }
__host__ __device__ __forceinline__ void stage_rc(int b, int& R, int& C) { const int st = b / 1024, sb = b % 1024, swz = sb ^ (((sb >> 9) & 1) << 5); R = (st >> 1) * 16 + swz / 64; C = (st & 1) * 32 + (swz % 64) / 2; }
__host__ __device__ __forceinline__ int perm32(int rho) { const int n = rho >> 4, i = rho & 15; return 8 * (i >> 2) + 4 * n + (i & 3); }

struct Unit { int pm, pn; };
struct Gemm { const bf16_t* A; const bf16_t* Bt; int M, N, K, lda, ldb; long adelta; int ksplit; };

struct StaticOrder {
    int nM, nN, nwg, G, c, wgm, gap_at, gap;
    __host__ __device__ void init(int M, int N, int G_, int c_, int wgm_ = WGM) { nM = M / BM; nN = N / BM; nwg = nM * nN; G = G_; c = c_; wgm = wgm_; gap_at = 1 << 30; gap = 0; }
    __host__ __device__ bool next(int i, Unit& u) const {
        const long L = (long)i * G + c; if (L >= nwg) return false;
        int wgid = (int)L; { const int q = nwg / NXCD, r = nwg % NXCD, xcd = wgid % NXCD, off = wgid / NXCD; wgid = (xcd < r ? xcd * (q + 1) : r * (q + 1) + (xcd - r) * q) + off; }
        const int nig = wgm * nN, gid = wgid / nig, fm = gid * wgm, gsz = (nM - fm) < wgm ? (nM - fm) : wgm;
        u.pm = fm + ((wgid % nig) % gsz); u.pn = (wgid % nig) / gsz; if (u.pn >= gap_at) u.pn += gap; return true;
    }
    __device__ __forceinline__ void a_ready(const Unit&) const {}
    __device__ __forceinline__ void done(const Unit&) const {}
};
struct OgOrder {
    int c, G, nM;
    __device__ __forceinline__ bool next(int i, Unit& u) const { const int pm = c + G * (i >> 1); if (pm >= nM) return false; u.pm = pm; u.pn = 8 + (i & 1); return true; }
    __device__ __forceinline__ void a_ready(const Unit&) const {}
    __device__ __forceinline__ void done(const Unit&) const {}
};
struct InProjOrder {
    int c, G, nx, nN, nctx;
    __device__ __forceinline__ bool next(int i, Unit& u) const {
        const int npan = c < nx ? (nx - c + G - 1) / G : 0;
        if (i < nN * npan) { u.pm = c + G * (i / nN); u.pn = i % nN; return true; }
        const int j = c + G * (i - nN * npan); if (j >= nctx) return false;
        u.pm = nx + j / nN; u.pn = j % nN; return true;
    }
    __device__ __forceinline__ void a_ready(const Unit&) const {}
    __device__ __forceinline__ void done(const Unit&) const {}
};
struct PanelOrder {
    int pm, n;
    __device__ __forceinline__ bool next(int i, Unit& u) const { if (i >= n) return false; u.pm = pm; u.pn = i; return true; }
    __device__ __forceinline__ void a_ready(const Unit&) const {}
    __device__ __forceinline__ void done(const Unit&) const {}
};
typedef float f32x2_t __attribute__((ext_vector_type(2))); typedef __bf16 bf16x2_t __attribute__((ext_vector_type(2)));
__device__ __forceinline__ unsigned cvt_pk_bf16(float lo, float hi) { const f32x2_t v = {lo, hi}; const bf16x2_t b = __builtin_convertvector(v, bf16x2_t); return __builtin_bit_cast(unsigned, b); }
__device__ __forceinline__ float sigm(float x) { return __builtin_amdgcn_rcpf(1.0f + __expf(-x)); }
__device__ __forceinline__ unsigned pk_f16(float lo, float hi) { const _Float16 a = (_Float16)lo, b = (_Float16)hi; return (unsigned)__builtin_bit_cast(unsigned short, a) | ((unsigned)__builtin_bit_cast(unsigned short, b) << 16); }

struct EpiZ {
    static constexpr bool PERM = true, AFTER_DRAIN = false; static constexpr int NVM = 16;
    bf16_t* Z; int ldz; const float* lb; int force_raw;
    __device__ __forceinline__ void operator()(const f32x4 (&acc)[2][2][4][2], const Unit& u, int wr, int wc, int fr, int fq) const {
        const int row0 = u.pm * BM + wr * 64 + fr, col0 = u.pn * BM + wc * 32 + 8 * fq;
        const int mode = force_raw ? 0 : ((u.pn < 2 || u.pn == 8 || u.pn == 9) ? 1 : ((u.pn >= 2 && u.pn < 6) ? 2 : 0));
#ifdef PROBE_P1RAW
        if (force_raw == 5) {
#pragma unroll
            for (int ai = 0; ai < 2; ++ai)
#pragma unroll
                for (int m = 0; m < 4; ++m)
#pragma unroll
                    for (int bj = 0; bj < 2; ++bj) { const f32x4 v0 = acc[ai][bj][m][0], v1 = acc[ai][bj][m][1]; u32x4 w;
                        w.x = cvt_pk_bf16(v0[0], v0[1]); w.y = cvt_pk_bf16(v0[2], v0[3]); w.z = cvt_pk_bf16(v1[0], v1[1]); w.w = cvt_pk_bf16(v1[2], v1[3]);
                        *(u32x4*)(Z + (size_t)(row0 + ai * HALF + m * 16) * 1792 + (u.pn % 7) * 256 + wc * 64 + bj * 32 + 8 * fq) = w; }
            return;
        }
#endif
#pragma unroll
        for (int bj = 0; bj < 2; ++bj) {
#pragma unroll
            for (int ai = 0; ai < 2; ++ai)
#pragma unroll
                for (int m = 0; m < 4; ++m) {
                    f32x4 v0 = acc[ai][bj][m][0], v1 = acc[ai][bj][m][1]; u32x4 w;
                    if (mode == 1) {
#pragma unroll
                        for (int e = 0; e < 4; ++e) { v0[e] = v0[e] * sigm(v0[e]); v1[e] = v1[e] * sigm(v1[e]); }
                    }
                    if (mode == 2) { w.x = pk_f16(v0[0], v0[1]); w.y = pk_f16(v0[2], v0[3]); w.z = pk_f16(v1[0], v1[1]); w.w = pk_f16(v1[2], v1[3]); }
                    else { w.x = cvt_pk_bf16(v0[0], v0[1]); w.y = cvt_pk_bf16(v0[2], v0[3]); w.z = cvt_pk_bf16(v1[0], v1[1]); w.w = cvt_pk_bf16(v1[2], v1[3]); }
#ifdef PROBE_P1RAW
                    if (force_raw == 3) *(u32x4*)(Z + (size_t)(u.pn % 7) * (67584 * 256) + (size_t)(row0 + ai * HALF + m * 16) * 256 + wc * 32 + 8 * fq + bj * HALF) = w;
                    else if (force_raw == 4) *(u32x4*)(Z + (size_t)(row0 + ai * HALF + m * 16) * 1792 + (u.pn % 7) * 256 + wc * 32 + 8 * fq + bj * HALF) = w;
                    else
#endif
                    __builtin_nontemporal_store(w, (u32x4*)(Z + (size_t)(row0 + ai * HALF + m * 16) * ldz + col0 + bj * HALF));
                }
        }
    }
};
struct EpiNull {
    static constexpr bool PERM = true, AFTER_DRAIN = false; static constexpr int NVM = 0;
    __device__ __forceinline__ void operator()(const f32x4 (&acc)[2][2][4][2], const Unit& u, int wr, int wc, int fr, int fq) const {
#pragma unroll
        for (int ai = 0; ai < 2; ++ai)
#pragma unroll
            for (int bj = 0; bj < 2; ++bj)
#pragma unroll
                for (int m = 0; m < 4; ++m)
#pragma unroll
                    for (int n = 0; n < 2; ++n) asm volatile("" :: "v"(acc[ai][bj][m][n]));
    }
};
struct EpiGU {
    static constexpr bool PERM = true, AFTER_DRAIN = false; static constexpr int NVM = 8;
    bf16_t* H; int ldh;
    __device__ __forceinline__ void operator()(const f32x4 (&acc)[2][2][4][2], const Unit& u, int wr, int wc, int fr, int fq) const {
        const int row0 = u.pm * BM + wr * 64 + fr, col0 = u.pn * HALF + wc * 32 + 8 * fq;
#pragma unroll
        for (int ai = 0; ai < 2; ++ai)
#pragma unroll
            for (int m = 0; m < 4; ++m) {
                f32x4 g0 = acc[ai][0][m][0], g1 = acc[ai][0][m][1]; const f32x4 u0 = acc[ai][1][m][0], u1 = acc[ai][1][m][1];
#pragma unroll
                for (int e = 0; e < 4; ++e) { g0[e] = g0[e] * sigm(g0[e]) * u0[e]; g1[e] = g1[e] * sigm(g1[e]) * u1[e]; }
                u32x4 w; w.x = cvt_pk_bf16(g0[0], g0[1]); w.y = cvt_pk_bf16(g0[2], g0[3]); w.z = cvt_pk_bf16(g1[0], g1[1]); w.w = cvt_pk_bf16(g1[2], g1[3]);
                *(PG8_GAS u32x4*)(H + (size_t)(row0 + ai * HALF + m * 16) * ldh + col0) = w;
            }
    }
};
template <bool LOC>
struct EpiGate {
    static constexpr bool PERM = true, AFTER_DRAIN = false; static constexpr int NVM = 16;
    bf16_t* F; int ldf; const float* gate0;
    const PG8_LAS float* gl;
    __device__ __forceinline__ void operator()(const f32x4 (&acc)[2][2][4][2], const Unit& u, int wr, int wc, int fr, int fq) const {
        const int row0 = u.pm * BM + wr * 64 + fr, col0 = u.pn * BM + wc * 32 + 8 * fq;
        const float* gate = gate0 + (size_t)(u.pm >> 5) * 6144;
#pragma unroll
        for (int bj = 0; bj < 2; ++bj) {
            f32x4 g0, g1;
            if (LOC) { g0 = *(const PG8_LAS f32x4*)(gl + col0 + bj * HALF); g1 = *(const PG8_LAS f32x4*)(gl + col0 + bj * HALF + 4); }
            else { g0 = *(const PG8_GAS f32x4*)(gate + col0 + bj * HALF); g1 = *(const PG8_GAS f32x4*)(gate + col0 + bj * HALF + 4); }
#pragma unroll
            for (int ai = 0; ai < 2; ++ai)
#pragma unroll
                for (int m = 0; m < 4; ++m) { const f32x4 v0 = acc[ai][bj][m][0] * g0, v1 = acc[ai][bj][m][1] * g1;
                    u32x4 w; w.x = cvt_pk_bf16(v0[0], v0[1]); w.y = cvt_pk_bf16(v0[2], v0[3]); w.z = cvt_pk_bf16(v1[0], v1[1]); w.w = cvt_pk_bf16(v1[2], v1[3]);
                    *(PG8_GAS u32x4*)(F + (size_t)(row0 + ai * HALF + m * 16) * ldf + col0 + bj * HALF) = w; } }
    }
};

template <class Epi, class Sched, bool ALIGN_EPI = false, bool SP2 = false>
__device__ __forceinline__ void gemm_phase(PG8_LAS unsigned char* lds, const Gemm g, const Sched& S, const Epi& E, const int tid) {
    const int wid = __builtin_amdgcn_readfirstlane(tid >> 6), lane = tid & 63, wr = wid >> 2, wc = wid & 3, fr = lane & 15, fq = lane >> 4;
    const int K = g.K, nt = K / BK;
    unsigned voffA[2], voffB[2];
#pragma unroll
    for (int i = 0; i < 2; ++i) { int R, C; stage_rc(tid * 16 + i * 8192, R, C); const int Rb = Epi::PERM ? ((R & ~31) + perm32(R & 31)) : R;
        voffA[i] = (unsigned)(R * g.lda + C) * 2u; voffB[i] = (unsigned)(Rb * g.ldb + C) * 2u; }
    const size_t kstep = (size_t)(BK * 2);
    const size_t hstepA = (size_t)HALF * g.lda * 2, hstepB = (size_t)HALF * g.ldb * 2;
    const size_t tstepA = 2 * hstepA, tstepB = 2 * hstepB;
    const unsigned ldsw = (unsigned)wid * 1024u;
    const int aoff = lds_byte(wr * 64 + fr, fq * 8), boff = lds_byte(wc * 32 + fr, fq * 8);
#define PG8_SA(b, h) (((b) * 2 + (h)) * HTB)
#define PG8_SB(b, h) ((4 + (b) * 2 + (h)) * HTB)
#define PG8_STAGE(bufoff, gbase, voff) do { _Pragma("unroll") for (int _i = 0; _i < 2; ++_i) \
        __builtin_amdgcn_global_load_lds((const unsigned*)((const char*)(gbase) + (voff)[_i]), (PG8_LAS unsigned*)(lds + (bufoff) + ldsw + _i * 8192), 16, 0, 0); } while (0)
#define PG8_LDA(dst, b, h) do { _Pragma("unroll") for (int m = 0; m < 4; ++m) _Pragma("unroll") for (int k = 0; k < 2; ++k) dst[m][k] = *(const PG8_LAS bf16x8*)(lds + PG8_SA(b, h) + aoff + m * 2048 + k * 1024); } while (0)
#define PG8_LDB(dst, b, h) do { _Pragma("unroll") for (int n = 0; n < 2; ++n) _Pragma("unroll") for (int k = 0; k < 2; ++k) dst[n][k] = *(const PG8_LAS bf16x8*)(lds + PG8_SB(b, h) + boff + n * 2048 + k * 1024); } while (0)
#define PG8_MMA(ai, bj, At, Bt) do { __builtin_amdgcn_s_setprio(1); _Pragma("unroll") for (int m = 0; m < 4; ++m) _Pragma("unroll") for (int n = 0; n < 2; ++n) _Pragma("unroll") for (int k = 0; k < 2; ++k) \
        acc[ai][bj][m][n] = __builtin_amdgcn_mfma_f32_16x16x32_bf16(Bt[n][k], At[m][k], acc[ai][bj][m][n], 0, 0, 0); __builtin_amdgcn_s_setprio(0); } while (0)
#define PG8_WAIT_V(n) asm volatile("s_waitcnt vmcnt(" #n ")" ::: "memory")
#define PG8_WAIT_L(n) asm volatile("s_waitcnt lgkmcnt(" #n ")" ::: "memory")
#define PG8_BAR __builtin_amdgcn_s_barrier()
#define PG8_SCHED __builtin_amdgcn_sched_barrier(0)
    Unit cur, nxt; int ui = 0;
    bool pe = false;
#define PG8_WAIT_VN(n) asm volatile("s_waitcnt vmcnt(%0)" :: "n"(n) : "memory")
    if (!S.next(0, cur)) return;
    f32x4 acc[2][2][4][2];
#pragma unroll
    for (int a = 0; a < 2; ++a)
#pragma unroll
        for (int b = 0; b < 2; ++b)
#pragma unroll
            for (int m = 0; m < 4; ++m)
#pragma unroll
                for (int n = 0; n < 2; ++n) acc[a][b][m][n] = (f32x4){0.f, 0.f, 0.f, 0.f};
    bf16x8 At[4][2], B0[2][2], B1[2][2];
    const char* cA = (const char*)g.A + (size_t)cur.pm * tstepA; const char* cB = (const char*)g.Bt + (size_t)cur.pn * tstepB;
    S.a_ready(cur);
    if constexpr (SP2) {
        PG8_STAGE(PG8_SB(0, 0), cB, voffB); PG8_STAGE(PG8_SB(0, 1), cB + hstepB, voffB); PG8_STAGE(PG8_SA(0, 0), cA, voffA); PG8_STAGE(PG8_SA(0, 1), cA + hstepA, voffA);
        if (wr == 1) PG8_BAR;
        PG8_WAIT_V(2); PG8_BAR;
        PG8_STAGE(PG8_SB(1, 0), cB + kstep, voffB); PG8_STAGE(PG8_SA(1, 0), cA + kstep, voffA); PG8_STAGE(PG8_SB(1, 1), cB + hstepB + kstep, voffB);
        PG8_WAIT_V(6); PG8_BAR;
    } else {
        PG8_STAGE(PG8_SB(0, 0), cB, voffB); PG8_STAGE(PG8_SA(0, 0), cA, voffA); PG8_STAGE(PG8_SB(0, 1), cB + hstepB, voffB); PG8_STAGE(PG8_SA(0, 1), cA + hstepA, voffA);
        if (wr == 1) PG8_BAR;
        PG8_WAIT_V(4); PG8_BAR;
        PG8_STAGE(PG8_SB(1, 0), cB + kstep, voffB); PG8_STAGE(PG8_SA(1, 0), cA + kstep, voffA); PG8_STAGE(PG8_SB(1, 1), cB + hstepB + kstep, voffB);
        PG8_WAIT_V(6); PG8_BAR;
    }
    for (;;) {
        const bool has_next = S.next(ui + 1, nxt);
        const char* nA = has_next ? (const char*)g.A + (size_t)nxt.pm * tstepA : cA; const char* nB = has_next ? (const char*)g.Bt + (size_t)nxt.pn * tstepB : cB;
        for (int t = 0; t < nt; t += 2) {
            const bool last = (t == nt - 2);
            const long ad1 = t >= g.ksplit ? g.adelta : 0, ad2 = t + 2 >= g.ksplit ? g.adelta : 0;
            const char* a1 = cA + (size_t)(t + 1) * kstep + ad1;
            const char* a2 = last ? nA : cA + (size_t)(t + 2) * kstep + ad2; const char* b2 = last ? nB : cB + (size_t)(t + 2) * kstep;
            const char* a3 = a2 + kstep; const char* b3 = b2 + kstep;
            if (last && has_next) S.a_ready(nxt);
            if constexpr (SP2) {
            int pef = __builtin_amdgcn_readfirstlane((pe && t == 0) ? 1 : 0); asm volatile("" : "+s"(pef)); const bool pe0 = pef != 0;
            PG8_LDB(B0, 0, 0); PG8_LDB(B1, 0, 1); PG8_SCHED; PG8_LDA(At, 0, 0); if (!pe0) PG8_STAGE(PG8_SA(1, 1), a1 + hstepA, voffA);
            if (pe0) PG8_WAIT_VN(8 + Epi::NVM); else PG8_WAIT_V(8);
            PG8_WAIT_L(0); PG8_BAR; PG8_MMA(0, 0, At, B0); PG8_MMA(0, 1, At, B1); PG8_BAR; PG8_SCHED;
            PG8_LDA(At, 0, 1); PG8_STAGE(PG8_SB(0, 0), b2, voffB); PG8_STAGE(PG8_SB(0, 1), b2 + hstepB, voffB); PG8_STAGE(PG8_SA(0, 0), a2, voffA);
            if (pe0) PG8_WAIT_VN(8 + Epi::NVM); else PG8_WAIT_V(8);
            PG8_WAIT_L(0); PG8_BAR; PG8_MMA(1, 0, At, B0); PG8_MMA(1, 1, At, B1); PG8_BAR; PG8_SCHED;
            PG8_LDB(B0, 1, 0); PG8_LDB(B1, 1, 1); PG8_SCHED; PG8_LDA(At, 1, 0); PG8_STAGE(PG8_SA(0, 1), a2 + hstepA, voffA);
            if (pe0) PG8_WAIT_VN(8 + Epi::NVM); else PG8_WAIT_V(8);
            PG8_WAIT_L(0); PG8_BAR; PG8_MMA(0, 0, At, B0); PG8_MMA(0, 1, At, B1); PG8_BAR; PG8_SCHED;
            PG8_LDA(At, 1, 1); PG8_STAGE(PG8_SB(1, 0), b3, voffB); PG8_STAGE(PG8_SB(1, 1), b3 + hstepB, voffB); PG8_STAGE(PG8_SA(1, 0), a3, voffA);
            PG8_WAIT_V(8); PG8_WAIT_L(0); PG8_BAR; PG8_MMA(1, 0, At, B0); PG8_MMA(1, 1, At, B1); PG8_BAR; PG8_SCHED;
            } else {
            PG8_LDB(B0, 0, 0); PG8_SCHED; PG8_LDA(At, 0, 0); PG8_STAGE(PG8_SA(1, 1), a1 + hstepA, voffA);
            PG8_WAIT_L(8); PG8_BAR; PG8_WAIT_L(0); PG8_MMA(0, 0, At, B0); PG8_BAR; PG8_SCHED;
            PG8_LDB(B1, 0, 1); PG8_STAGE(PG8_SB(0, 0), b2, voffB);
            PG8_BAR; PG8_WAIT_L(0); PG8_MMA(0, 1, At, B1); PG8_BAR;
            PG8_LDA(At, 0, 1); PG8_STAGE(PG8_SA(0, 0), a2, voffA);
            PG8_BAR; PG8_WAIT_L(0); PG8_MMA(1, 0, At, B0); PG8_BAR; PG8_SCHED;
            PG8_STAGE(PG8_SB(0, 1), b2 + hstepB, voffB);
            PG8_WAIT_V(6); PG8_BAR; PG8_MMA(1, 1, At, B1); PG8_BAR;
            PG8_LDB(B0, 1, 0); PG8_SCHED; PG8_LDA(At, 1, 0); PG8_STAGE(PG8_SA(0, 1), a2 + hstepA, voffA);
            PG8_WAIT_L(8); PG8_BAR; PG8_WAIT_L(0); PG8_MMA(0, 0, At, B0); PG8_BAR; PG8_SCHED;
            PG8_LDB(B1, 1, 1); PG8_STAGE(PG8_SB(1, 0), b3, voffB);
            PG8_BAR; PG8_WAIT_L(0); PG8_MMA(0, 1, At, B1); PG8_BAR;
            PG8_LDA(At, 1, 1); PG8_STAGE(PG8_SA(1, 0), a3, voffA);
            PG8_BAR; PG8_WAIT_L(0); PG8_MMA(1, 0, At, B0); PG8_BAR; PG8_SCHED;
            PG8_STAGE(PG8_SB(1, 1), b3 + hstepB, voffB);
            PG8_WAIT_V(6); PG8_BAR; PG8_MMA(1, 1, At, B1); PG8_BAR;
            }
        }
        if constexpr (SP2) { if (has_next) { PG8_STAGE(PG8_SA(1, 1), nA + kstep + hstepA, voffA); pe = true; } }
        if constexpr (ALIGN_EPI) { if (wr == 0) PG8_BAR; }
        if constexpr (!Epi::AFTER_DRAIN) { E(acc, cur, wr, wc, fr, fq); S.done(cur); }
        if (!has_next) break;
#pragma unroll
        for (int a = 0; a < 2; ++a)
#pragma unroll
            for (int b = 0; b < 2; ++b)
#pragma unroll
                for (int m = 0; m < 4; ++m)
#pragma unroll
                    for (int n = 0; n < 2; ++n) acc[a][b][m][n] = (f32x4){0.f, 0.f, 0.f, 0.f};
        cur = nxt; cA = nA; cB = nB; ++ui;
        if constexpr (ALIGN_EPI) { if (wr == 1) PG8_BAR; }
    }
    PG8_WAIT_V(0);
    if constexpr (!ALIGN_EPI) { if (wr == 0) PG8_BAR; }
    PG8_BAR;
    if constexpr (Epi::AFTER_DRAIN) { E.fused(acc, cur, wr, wc, fr, fq, lds, wid, lane); S.done(cur); }
#undef PG8_SA
#undef PG8_SB
#undef PG8_STAGE
#undef PG8_LDA
#undef PG8_LDB
#undef PG8_MMA
#undef PG8_WAIT_V
#undef PG8_WAIT_VN
#undef PG8_WAIT_L
#undef PG8_BAR
#undef PG8_SCHED
}
}

#define GAS __attribute__((address_space(1)))
#define LAS __attribute__((address_space(3)))
typedef unsigned short bf16;
typedef unsigned v4u __attribute__((ext_vector_type(4)));
typedef float f32x4 __attribute__((ext_vector_type(4)));
typedef short bf16x8 __attribute__((ext_vector_type(8)));
typedef GAS unsigned gu32;
typedef GAS unsigned long long gu64;
#define RLX_AGENT __ATOMIC_RELAXED, __HIP_MEMORY_SCOPE_AGENT
#define LDS_WAIT() asm volatile("s_waitcnt lgkmcnt(0)" ::: "memory")
#define VM_WAIT() asm volatile("s_waitcnt vmcnt(0)" ::: "memory")
__device__ __forceinline__ unsigned long long rt() { return __builtin_amdgcn_s_memrealtime(); }
__device__ __forceinline__ unsigned f2bf(float f) { unsigned u = __builtin_bit_cast(unsigned, f); return (u + 0x7fffu + ((u >> 16) & 1u)) >> 16; }
__device__ __forceinline__ unsigned pk2(float lo, float hi) { return f2bf(lo) | (f2bf(hi) << 16); }
#define XB_TMO      128
#define XB_XCNT(j)  (256  + 64 * (j))
#define XB_XSUB(j)  (1280 + 64 * (j))
#define XB_XGEN(j)  (2304 + 64 * (j))
#define XB_TOP      3328
#define XB_TOPGEN   3392
#define XCD_BAR_WORDS 3456
#define XB_SPIN_CAP (1u << 18)

__device__ __forceinline__ unsigned xb_ld(unsigned* p)              { return __hip_atomic_load(p, __ATOMIC_RELAXED, __HIP_MEMORY_SCOPE_AGENT); }
__device__ __forceinline__ unsigned xb_add(unsigned* p, unsigned v) { return __hip_atomic_fetch_add(p, v, __ATOMIC_RELAXED, __HIP_MEMORY_SCOPE_AGENT); }
__device__ __forceinline__ unsigned xb_xcc_id() { return (unsigned)__builtin_amdgcn_s_getreg((3 << 11) | 20) & 0xFu; }
#define XB_SPIN(cond, bar) do { unsigned _sp = 0; while (cond) { __builtin_amdgcn_s_sleep(1); \
    if ((++_sp & 255u) == 0u) { if (xb_ld(&(bar)[XB_TMO])) break; if (_sp > XB_SPIN_CAP) { atomicAdd(&(bar)[XB_TMO], 1u); break; } } } } while (0)

struct XcdBarrier {
    unsigned* bar; unsigned x;
    volatile LAS unsigned* st;
};

__device__ __forceinline__ XcdBarrier xcd_barrier_post(unsigned* bar, volatile LAS unsigned* st) {
    XcdBarrier b; b.bar = bar; b.x = xb_xcc_id(); b.st = st;
    if (threadIdx.x == 0) (void)xb_add(&bar[XB_XCNT(b.x)], 1u);
    return b;
}
__device__ __forceinline__ void xcd_barrier_complete(unsigned* bar, unsigned x, unsigned& nloc, unsigned& nx) {
    const unsigned G = gridDim.x * gridDim.y * gridDim.z;
    unsigned sum, cnt, mine, sp = 0u;
    for (;;) {
        sum = 0u; cnt = 0u; mine = 0u;
#pragma unroll
        for (unsigned j = 0; j < 16; ++j) { const unsigned c = xb_ld(&bar[XB_XCNT(j)]); sum += c; cnt += (c > 0u) ? 1u : 0u; mine = (j == x) ? c : mine; }
        if (sum == G) break;
        __builtin_amdgcn_s_sleep(1);
        if ((++sp & 255u) == 0u) { if (xb_ld(&bar[XB_TMO])) break; if (sp > XB_SPIN_CAP) { atomicAdd(&bar[XB_TMO], 1u); break; } }
    }
    nloc = mine > 0u ? mine : 1u; nx = cnt > 0u ? cnt : 1u;
}

__device__ __forceinline__ void xcd_barrier(const XcdBarrier& b) {
    asm volatile("s_waitcnt vmcnt(0)" ::: "memory");
    __syncthreads();
    if (threadIdx.x == 0) {
        unsigned* bar = b.bar;
        __builtin_amdgcn_s_waitcnt(0);
        unsigned nloc = b.st[0], nx = b.st[1];
        if (nloc == 0u) { xcd_barrier_complete(bar, b.x, nloc, nx); b.st[0] = nloc; b.st[1] = nx; }
        const unsigned old = xb_add(&bar[XB_XSUB(b.x)], 1u);
        const unsigned gen = old / nloc;
        if (old + 1u == (gen + 1u) * nloc) {
            __builtin_amdgcn_fence(__ATOMIC_RELEASE, "agent");
            asm volatile("s_waitcnt vmcnt(0)" ::: "memory");
            const unsigned og = xb_add(&bar[XB_TOP], 1u);
            const unsigned tg = og / nx;
            if (og + 1u == (tg + 1u) * nx) xb_add(&bar[XB_TOPGEN], 1u);
            else XB_SPIN(xb_ld(&bar[XB_TOPGEN]) == tg, bar);
            __builtin_amdgcn_fence(__ATOMIC_ACQUIRE, "agent");
            xb_add(&bar[XB_XGEN(b.x)], 1u);
            asm volatile("s_waitcnt vmcnt(0)" ::: "memory");
        } else {
            XB_SPIN(xb_ld(&bar[XB_XGEN(b.x)]) == gen, bar);
            __builtin_amdgcn_fence(__ATOMIC_ACQUIRE, "agent");
            asm volatile("s_waitcnt vmcnt(0)" ::: "memory");
        }
    }
    __syncthreads();
}
constexpr int NWAVES = 8;
constexpr int NB = 8, SEQ = 8192, DM = 1024, CTXL = 256;
constexpr int NTOK = NB * SEQ, NCTX = NB * CTXL, MROWS = NTOK + NCTX;
constexpr int ZLD = 4352, INCOLS = 4320, DFF = 2816;
constexpr int ZQ = 0, ZF = 512, ZI = 1536, ZOG = 2048, ZR = 2560;
constexpr float ALPHA = 1.189207115f;
constexpr size_t MiB = 1u << 20;
constexpr size_t WS_CTL = 0, CTL_ZERO_BYTES = 64 * 1024;
constexpr size_t WS_MOD = 1 * MiB, WS_LB = 1 * MiB + 256 * 1024, WS_W2T = 1 * MiB + 512 * 1024, WS_A2T = WS_W2T + 64 * 1024, WS_G2T = WS_A2T + 64 * 1024;
constexpr size_t WS_WIN = 2 * MiB, WS_WOUT = 11 * MiB, WS_WGU = 13 * MiB, WS_WD = 24 * MiB, WS_SB = 30 * MiB;
constexpr size_t WS_U = 34 * MiB, WS_Z = 166 * MiB, WS_YY = 727 * MiB, WS_VL = 855 * MiB, WS_G = 919 * MiB, WS_END = 983 * MiB;
constexpr int CW_HG = 8448;
constexpr int CW_BAR = 1024;
constexpr int LDS_BYTES = 159744, MISC_OFF = 157696, EPI_OFF = 131072;
static_assert(CW_BAR * 4 + 3456 * 4 <= (int)CTL_ZERO_BYTES, "ctl");

typedef unsigned short u16;
typedef float f32x16 __attribute__((ext_vector_type(16)));
typedef float f32x2 __attribute__((ext_vector_type(2)));
typedef short s16x4 __attribute__((ext_vector_type(4)));
typedef unsigned u32x2 __attribute__((ext_vector_type(2)));
#define MFMA32(a, b, c) __builtin_amdgcn_mfma_f32_32x32x16_bf16(a, b, c, 0, 0, 0)
#define BAR() __syncthreads()
#define LBAR() do { asm volatile("s_waitcnt lgkmcnt(0)" ::: "memory"); __builtin_amdgcn_s_barrier(); asm volatile("" ::: "memory"); } while (0)
__device__ __forceinline__ int launder(int v) { asm volatile("" : "+v"(v)); return v; }
__device__ __forceinline__ int fresh_tid(int wave) { int l; asm volatile("v_mbcnt_lo_u32_b32 %0, -1, 0\n\tv_mbcnt_hi_u32_b32 %0, -1, %0" : "=v"(l)); return wave * 64 + l; }
__device__ __forceinline__ unsigned char* launder_sp(unsigned char* q) { asm volatile("" : "+s"(q)); return q; }
__device__ __forceinline__ float sigm(float x) { return __builtin_amdgcn_rcpf(1.0f + __expf(-x)); }
__device__ __forceinline__ float dppf(float x, const int ctrl) { return x; }
#define DPP_ADD(x, ctrl) x += __builtin_bit_cast(float, __builtin_amdgcn_update_dpp(0, __builtin_bit_cast(int, x), ctrl, 0xF, 0xF, true))
__device__ __forceinline__ float sum8(float x) { DPP_ADD(x, 0xB1); DPP_ADD(x, 0x4E); DPP_ADD(x, 0x141); return x; }
__device__ __forceinline__ float sum16(float x) { DPP_ADD(x, 0xB1); DPP_ADD(x, 0x4E); DPP_ADD(x, 0x141); DPP_ADD(x, 0x140); return x; }
__device__ __forceinline__ float sum32(float x) { x = sum16(x); x += __builtin_bit_cast(float, __builtin_amdgcn_ds_swizzle(__builtin_bit_cast(int, x), 0x401F)); return x; }
__device__ __forceinline__ float bflo(unsigned u) { return __builtin_bit_cast(float, u << 16); }
__device__ __forceinline__ float bfhi(unsigned u) { return __builtin_bit_cast(float, u & 0xffff0000u); }
__device__ __forceinline__ unsigned pkbf(float lo, float hi) { return pg8::cvt_pk_bf16(lo, hi); }
__device__ __forceinline__ float h2f(unsigned short h) { return (float)__builtin_bit_cast(_Float16, h); }
__device__ __forceinline__ void unpack8(const v4u u, float (&f)[8]) { f[0] = bflo(u.x); f[1] = bfhi(u.x); f[2] = bflo(u.y); f[3] = bfhi(u.y); f[4] = bflo(u.z); f[5] = bfhi(u.z); f[6] = bflo(u.w); f[7] = bfhi(u.w); }
__device__ __forceinline__ int arow(int i, int h5) { return (i & 3) + 8 * (i >> 2) + 4 * h5; }
__device__ __forceinline__ bf16x8 frag_kc(const LAS u16* X, int ld, int idx0, int k0, int lane) {
    return *(const LAS bf16x8*)(X + (idx0 + (lane & 31)) * ld + k0 + 8 * (lane >> 5));
}
__device__ __forceinline__ bf16x8 frag_tr(const LAS u16* X, int ld, int idx0, int k0, int lane) {
    const int g = lane >> 4, q = (lane >> 2) & 3, p = lane & 3;
    const LAS u16* a = X + (k0 + 8 * (g >> 1) + q) * ld + idx0 + 16 * (g & 1) + 4 * p;
    const s16x4 lo = __builtin_bit_cast(s16x4, __builtin_amdgcn_ds_read_tr16_b64_v4i16((LAS s16x4*)a));
    const s16x4 hi = __builtin_bit_cast(s16x4, __builtin_amdgcn_ds_read_tr16_b64_v4i16((LAS s16x4*)(a + 4 * ld)));
    return (bf16x8){lo[0], lo[1], lo[2], lo[3], hi[0], hi[1], hi[2], hi[3]};
}
__device__ __forceinline__ void st_tile_T(LAS u16* D, int ld, int row0, int col0, const f32x16& a, int lane) {
    LAS u16* p = D + (col0 + (lane & 31)) * ld + row0 + 4 * (lane >> 5);
#pragma unroll
    for (int g = 0; g < 4; ++g) { u32x2 w; w.x = pkbf(a[4 * g], a[4 * g + 1]); w.y = pkbf(a[4 * g + 2], a[4 * g + 3]); *(LAS u32x2*)(p + 8 * g) = w; }
}
__device__ __forceinline__ f32x16 zero16() { f32x16 z;
#pragma unroll
    for (int i = 0; i < 16; ++i) z[i] = 0.f; return z; }

__device__ __forceinline__ void transpose_item(const float* W, int N, u16* WT, int ldw, int k0, int n0, int drow0, LAS float* scr, int lane) {
    float t[32];
#pragma unroll
    for (int i = 0; i < 32; ++i) { const int kk = 2 * i + (lane >> 5); t[i] = W[(size_t)(k0 + kk) * N + n0 + (lane & 31)]; }
#pragma unroll
    for (int i = 0; i < 32; ++i) { const int kk = 2 * i + (lane >> 5); scr[kk * 33 + (lane & 31)] = t[i]; }
    LDS_WAIT(); asm volatile("" ::: "memory");
    const int c = lane & 7;
#pragma unroll
    for (int j = 0; j < 4; ++j) { const int n = (lane >> 3) + 8 * j; const LAS float* s = scr + (8 * c) * 33 + n;
        v4u o; o.x = pkbf(s[0 * 33], s[1 * 33]); o.y = pkbf(s[2 * 33], s[3 * 33]); o.z = pkbf(s[4 * 33], s[5 * 33]); o.w = pkbf(s[6 * 33], s[7 * 33]);
        *(v4u*)(WT + (size_t)(drow0 + n) * ldw + k0 + 8 * c) = o; }
    LDS_WAIT(); asm volatile("" ::: "memory");
}
struct Params {
    const float *x, *c, *ctx, *c_ctx, *w_ada, *b_ada, *w_in, *lb_logits, *hg_norm_w, *mu, *w0, *w2, *a0, *a2, *g2, *kkw, *kaw, *rkw, *lnxw, *lnxb, *w_out, *ln1g, *ln1b, *wg, *wu, *wd, *ln2g, *ln2b;
    float* out; unsigned char* ws;
};
constexpr int WI_IN = 16 * 135, WI_OUT = 16 * 32, WI_G = 16 * 88, WI_D = 44 * 32, WI_ALL = WI_IN + WI_OUT + 2 * WI_G + WI_D;
__device__ __forceinline__ void weight_items(const Params& p, LAS unsigned char* lds, int lane, int wave, int gw, int NGW, int first, int last) {
    LAS float* scr = (LAS float*)(lds + 65536 + wave * 8704);
    u16* wint = (u16*)(p.ws + WS_WIN); u16* woutt = (u16*)(p.ws + WS_WOUT); u16* wgut = (u16*)(p.ws + WS_WGU); u16* wdt = (u16*)(p.ws + WS_WD);
    for (int it = first + gw; it < last; it += NGW) {
        int r = it;
        if (r < WI_IN) { const int kb = r / 135, nb = r % 135; transpose_item(p.w_in, INCOLS, wint, 1024, 64 * kb, 32 * nb, 32 * nb, scr, lane); continue; } r -= WI_IN;
        if (r < WI_OUT) { const int kb = r / 32, nb = r % 32; transpose_item(p.w_out, 1024, woutt, 1024, 64 * kb, 32 * nb, 32 * nb, scr, lane); continue; } r -= WI_OUT;
        if (r < WI_G) { const int kb = r / 88, nb = r % 88, n0 = 32 * nb; transpose_item(p.wg, DFF, wgut, 1024, 64 * kb, n0, 256 * (n0 >> 7) + (n0 & 127), scr, lane); continue; } r -= WI_G;
        if (r < WI_G) { const int kb = r / 88, nb = r % 88, n0 = 32 * nb; transpose_item(p.wu, DFF, wgut, 1024, 64 * kb, n0, 256 * (n0 >> 7) + 128 + (n0 & 127), scr, lane); continue; } r -= WI_G;
        { const int kb = r / 32, nb = r % 32; transpose_item(p.wd, 1024, wdt, DFF, 64 * kb, 32 * nb, 32 * nb, scr, lane); }
    }
}
__device__ __forceinline__ void phase0a(const Params& p, LAS unsigned char* lds, int tid, int lane, int wave, int bid, int G) {
    float* mod = (float*)(p.ws + WS_MOD);
    for (int cb = bid; cb < 192; cb += G) {
        LAS float* sc = (LAS float*)lds; LAS float* red = sc + 9 * 1024;
        for (int i = tid; i < 9 * 1024; i += 512) { const int b = i >> 10, d = i & 1023; const float xv = b < 8 ? p.c[b * 1024 + d] : p.c_ctx[d]; sc[i] = xv * sigm(xv); }
        BAR();
        const int cl = tid & 31, dq = tid >> 5, col = cb * 32 + cl;
        float acc[9];
#pragma unroll
        for (int b = 0; b < 9; ++b) acc[b] = 0.f;
#pragma unroll
        for (int hb = 0; hb < 2; ++hb) { float w[32];
#pragma unroll
            for (int j = 0; j < 32; ++j) w[j] = p.w_ada[(size_t)(dq * 64 + hb * 32 + j) * 6144 + col];
#pragma unroll
            for (int j = 0; j < 32; ++j) {
#pragma unroll
                for (int b = 0; b < 9; ++b) acc[b] += sc[b * 1024 + dq * 64 + hb * 32 + j] * w[j]; } }
#pragma unroll
        for (int b = 0; b < 9; ++b) red[(dq * 9 + b) * 32 + cl] = acc[b];
        BAR();
        if (tid < 288) { const int b = tid >> 5; float s = 0.f;
#pragma unroll
            for (int q = 0; q < 16; ++q) s += red[(q * 9 + b) * 32 + cl];
            mod[b * 6144 + col] = s + p.b_ada[col]; }
        BAR();
    }
    {
        float* lb = (float*)(p.ws + WS_LB); u16* w2t = (u16*)(p.ws + WS_W2T); u16* a2t = (u16*)(p.ws + WS_A2T); u16* g2t = (u16*)(p.ws + WS_G2T); u16* wint = (u16*)(p.ws + WS_WIN);
        const int gt = bid * 512 + tid, GT = G * 512;
        for (int i = gt; i < 1024; i += GT) lb[i] = sigm(p.lb_logits[i] - p.lb_logits[1024 + i]);
        for (int i = gt; i < 2 * 512 * 32; i += GT) { const int l = i & 31, c = (i >> 5) & 511, d = i >> 14; const float a = p.w2[(d * 32 + l) * 512 + c], b = p.a2[(d * 32 + l) * 512 + c];
            w2t[i] = (u16)(pkbf(a, 0.f) & 0xffffu); a2t[i] = (u16)(pkbf(b, 0.f) & 0xffffu); }
        for (int i = gt; i < 512 * 96; i += GT) { const int l = i % 96, c = i / 96; g2t[i] = (u16)(pkbf(p.g2[l * 512 + c], 0.f) & 0xffffu); }
        for (int i = gt; i < 32 * 1024 / 2; i += GT) ((unsigned*)(wint + (size_t)INCOLS * 1024))[i] = 0u;
    }
    {   const int NGW = G * NWAVES, gw = G == 256 ? (bid >= 192 ? (bid - 192) * NWAVES + wave : 512 + bid * NWAVES + wave) : bid * NWAVES + wave;
        weight_items(p, lds, lane, wave, gw, NGW, 0, WI_ALL); }
}
__device__ __forceinline__ float wave_sum(float v) { v = sum32(v); v += __shfl_xor(v, 32); return v; }
__device__ __forceinline__ void phase0b(const Params& p, int lane, int wave, int bid, int G) {
    const float* mod = (const float*)(p.ws + WS_MOD); u16* U = (u16*)(p.ws + WS_U);
    const int gw = bid * NWAVES + wave, NGW = G * NWAVES;
    constexpr int RB = 4;
    for (int mg = gw; mg < MROWS / RB; mg += NGW) {
        const int m0 = mg * RB;
        const float* xrow = m0 < NTOK ? p.x + (size_t)m0 * DM : p.ctx + (size_t)(m0 - NTOK) * DM;
        const int mb = m0 < NTOK ? (m0 >> 13) : 8;
        f32x4 v[RB][4]; float s[RB], mean[RB], rstd[RB];
#pragma unroll
        for (int q = 0; q < RB; ++q)
#pragma unroll
            for (int j = 0; j < 4; ++j) v[q][j] = __builtin_nontemporal_load((const f32x4*)(xrow + (size_t)q * DM) + lane + 64 * j);
#pragma unroll
        for (int q = 0; q < RB; ++q) { s[q] = 0.f;
#pragma unroll
            for (int j = 0; j < 4; ++j) s[q] += (v[q][j].x + v[q][j].y) + (v[q][j].z + v[q][j].w); }
#pragma unroll
        for (int q = 0; q < RB; ++q) mean[q] = wave_sum(s[q]) * (1.f / DM);
#pragma unroll
        for (int q = 0; q < RB; ++q) { s[q] = 0.f;
#pragma unroll
            for (int j = 0; j < 4; ++j) { v[q][j] = v[q][j] - mean[q]; s[q] += (v[q][j].x * v[q][j].x + v[q][j].y * v[q][j].y) + (v[q][j].z * v[q][j].z + v[q][j].w * v[q][j].w); } }
#pragma unroll
        for (int q = 0; q < RB; ++q) rstd[q] = 1.f / sqrtf(wave_sum(s[q]) * (1.f / DM) + 1e-6f);
#pragma unroll
        for (int j = 0; j < 4; ++j) { const f32x4 a = ((const f32x4*)(mod + mb * 6144))[lane + 64 * j], b = ((const f32x4*)(mod + mb * 6144 + 1024))[lane + 64 * j];
#pragma unroll
            for (int q = 0; q < RB; ++q) { const f32x4 r = v[q][j] * rstd[q] * (b + 1.0f) + a; u32x2 w; w.x = pkbf(r.x, r.y); w.y = pkbf(r.z, r.w); ((u32x2*)(U + (size_t)(m0 + q) * DM))[lane + 64 * j] = w; } }
    }
}
__device__ __forceinline__ void chain_chunk(int n, int dir, int b, bool& isctx, int& tbase, long& rowbase) {
    isctx = n < 4;
    if (isctx) { const int cc = dir ? 3 - n : n; tbase = cc * 64; rowbase = (long)NTOK + b * CTXL + tbase; }
    else { const int xc = dir ? 127 - (n - 4) : n - 4; tbase = xc * 64; rowbase = (long)b * SEQ + tbase; }
}
constexpr int HG_LD = 136;
constexpr int HG_QT = 0, HG_KT = 17408, HG_VV = 34816, HG_ST = 52224, HG_PT = 87040, HG_TOT = 96256, HG_EM = 100352, HG_EE = 100864, HG_DD = 101376;
__device__ __forceinline__ void hgrn_chain(const Params& p, LAS unsigned char* lds, int tid, int lane_in, int wave, int b, int h, int dir) {
    LAS u16* QT = (LAS u16*)(lds + HG_QT); LAS u16* KT = (LAS u16*)(lds + HG_KT); LAS u16* VV = (LAS u16*)(lds + HG_VV); LAS u16* ST = (LAS u16*)(lds + HG_ST); LAS u16* PT = (LAS u16*)(lds + HG_PT);
    LAS float* TOT = (LAS float*)(lds + HG_TOT); LAS float* EM = (LAS float*)(lds + HG_EM); LAS float* EE = (LAS float*)(lds + HG_EE); LAS float* DD = (LAS float*)(lds + HG_DD);
    const int kb = wave >> 1, vb0 = 2 * (wave & 1);
    const int oti = wave >> 2, ovi = wave & 3;
    f32x16 S0 = zero16(), S1 = zero16();
    unsigned pq_[8], pf_[8], pv_[8];
#define HG_LOAD(nn) do { bool ic_; int tb_; long rb_; chain_chunk((nn), dir, b, ic_, tb_, rb_); const int ln_ = fresh_tid(wave) & 63; \
        const char* zb_ = (const char*)(Z + rb_ * ZLD); \
        _Pragma("unroll") for (int i = 0; i < 8; ++i) { const int j = 8 * wave + i; const int off = (dir ? 63 - j : j) * (ZLD * 2) + (h * 128 + 2 * ln_) * 2; \
            pq_[i] = *(const unsigned*)(zb_ + (long)(off + ZQ * 2)); pf_[i] = *(const unsigned*)(zb_ + (long)(off + (ZF + 512 * dir) * 2)); pv_[i] = *(const unsigned*)(zb_ + (long)(off + ZI * 2)); } } while (0)
    { const u16* Z = (const u16*)(p.ws + WS_Z); HG_LOAD(0); }
    for (int n = 0; n < 132; ++n) {
        bool isctx; int tbase; long rowbase; chain_chunk(n, dir, b, isctx, tbase, rowbase);
        unsigned char* wsl = launder_sp(p.ws); const u16* Z = (const u16*)(wsl + WS_Z); u16* O = (u16*)launder_sp((unsigned char*)p.out);
        const int lane = fresh_tid(wave) & 63, h5 = lane >> 5, r = lane & 31;
        float bb[8][2], om[8][2]; float cum0 = 0.f, cum1 = 0.f;
        const f32x2 lbv = *(const f32x2*)((const float*)(wsl + WS_LB) + 512 * dir + h * 128 + 2 * lane);
#pragma unroll
        for (int i = 0; i < 8; ++i) {
            const int j = 8 * wave + i;
            *(LAS unsigned*)(VV + j * HG_LD + 2 * lane) = pv_[i];
            const float f0 = lbv.x + (1.0f - lbv.x) * pg8::sigm(h2f((unsigned short)(pf_[i] & 0xffffu))), f1 = lbv.y + (1.0f - lbv.y) * pg8::sigm(h2f((unsigned short)(pf_[i] >> 16)));
            om[i][0] = 1.0f - f0; om[i][1] = 1.0f - f1;
            cum0 += __logf(f0); cum1 += __logf(f1); bb[i][0] = cum0; bb[i][1] = cum1;
        }
        *(LAS f32x2*)(TOT + wave * 128 + 2 * lane) = (f32x2){cum0, cum1};
        LBAR();
        float base0 = 0.f, base1 = 0.f, m0 = 0.f, m1 = 0.f, t0 = 0.f, t1 = 0.f;
#pragma unroll
        for (int w = 0; w < 8; ++w) { const f32x2 t = *(const LAS f32x2*)(TOT + w * 128 + 2 * lane);
            if (w < wave) { base0 += t.x; base1 += t.y; } if (w < 4) { m0 += t.x; m1 += t.y; } t0 += t.x; t1 += t.y; }
#pragma unroll
        for (int i = 0; i < 8; ++i) {
            const int j = 8 * wave + i;
            const float e0 = __expf(base0 + bb[i][0] - m0), e1 = __expf(base1 + bb[i][1] - m1);
            *(LAS unsigned*)(QT + j * HG_LD + 2 * lane) = pkbf(bflo(pq_[i]) * e0, bfhi(pq_[i]) * e1);
            *(LAS unsigned*)(KT + j * HG_LD + 2 * lane) = pkbf(om[i][0] * __builtin_amdgcn_rcpf(e0), om[i][1] * __builtin_amdgcn_rcpf(e1));
        }
        if (wave == 0) { *(LAS f32x2*)(EM + 2 * lane) = (f32x2){__expf(m0), __expf(m1)}; *(LAS f32x2*)(EE + 2 * lane) = (f32x2){__expf(t0 - m0), __expf(t1 - m1)}; *(LAS f32x2*)(DD + 2 * lane) = (f32x2){__expf(t0), __expf(t1)}; }
        if (n + 1 < 132) { HG_LOAD(n + 1); }
        LBAR();
#pragma unroll
        for (int tt = 0; tt < 2; ++tt) {
            f32x16 sc = tt ? S1 : S0;
#pragma unroll
            for (int g = 0; g < 4; ++g) { const f32x4 em = *(const LAS f32x4*)(EM + 32 * kb + 8 * g + 4 * h5);
#pragma unroll
                for (int e = 0; e < 4; ++e) sc[4 * g + e] *= em[e]; }
            st_tile_T(ST, HG_LD, 32 * kb, 32 * (vb0 + tt), sc, lane);
        }
        if (wave < 3) {
            const int ti = wave >= 1 ? 1 : 0, si = wave == 2 ? 1 : 0;
            f32x16 a = zero16();
#pragma unroll
            for (int ks = 0; ks < 8; ++ks) a = MFMA32(frag_kc(QT, HG_LD, 32 * ti, 16 * ks, lane), frag_kc(KT, HG_LD, 32 * si, 16 * ks, lane), a);
#pragma unroll
            for (int i = 0; i < 16; ++i) { const int t = 32 * ti + arow(i, h5), s = 32 * si + r; if (s > t) a[i] = 0.f; }
            st_tile_T(PT, 72, 32 * ti, 32 * si, a, lane);
        }
        LBAR();
        f32x16 o = zero16();
#pragma unroll
        for (int ks = 0; ks < 8; ++ks) o = MFMA32(frag_kc(QT, HG_LD, 32 * oti, 16 * ks, lane), frag_kc(ST, HG_LD, 32 * ovi, 16 * ks, lane), o);
#pragma unroll
        for (int ks = 0; ks < 4; ++ks) if (ks < 2 * (oti + 1)) o = MFMA32(frag_tr(PT, 72, 32 * oti, 16 * ks, lane), frag_tr(VV, HG_LD, 32 * ovi, 16 * ks, lane), o);
        if (!isctx) {
#pragma unroll
            for (int i = 0; i < 16; ++i) { const int j = 32 * oti + arow(i, h5); const long row = rowbase + (dir ? 63 - j : j);
                O[row * 1024 + dir * 512 + h * 128 + 32 * ovi + r] = (u16)(pkbf(o[i], 0.f) & 0xffffu); }
        }
#pragma unroll
        for (int tt = 0; tt < 2; ++tt) {
            f32x16 g = zero16();
#pragma unroll
            for (int ks = 0; ks < 4; ++ks) g = MFMA32(frag_tr(KT, HG_LD, 32 * kb, 16 * ks, lane), frag_tr(VV, HG_LD, 32 * (vb0 + tt), 16 * ks, lane), g);
#pragma unroll
            for (int gq = 0; gq < 4; ++gq) { const f32x4 dd = *(const LAS f32x4*)(DD + 32 * kb + 8 * gq + 4 * h5), ee = *(const LAS f32x4*)(EE + 32 * kb + 8 * gq + 4 * h5);
#pragma unroll
                for (int e = 0; e < 4; ++e) { if (tt) S1[4 * gq + e] = dd[e] * S1[4 * gq + e] + ee[e] * g[4 * gq + e]; else S0[4 * gq + e] = dd[e] * S0[4 * gq + e] + ee[e] * g[4 * gq + e]; } }
        }
        LBAR();
    }
}
#ifndef RQ_E1
#define RQ_E1 1
#endif
#ifndef RQ_INV
#define RQ_INV 1
#endif
#ifndef RQ_M1
#define RQ_M1 1
#endif
#ifndef RQ_E2A
#define RQ_E2A 1
#endif
#ifndef RQ_E2B
#define RQ_E2B 1
#endif
#ifndef RQ_M2
#define RQ_M2 1
#endif
constexpr int RW_WD = 0, RW_AD = 5120, RW_W2 = 10240, RW_A2 = 15360, RW_TOT = 0;
constexpr int RW_LW = 23552, RW_AG = 32768;
constexpr int RW_AT = 41984, RW_BT = 51200, RW_KT = 60416, RW_RT = 69632, RW_VV = 78848;
constexpr int RW_LF = 88064, RW_TB = 93184, RW_LB = 102400, RW_AAK = 111616, RW_ARB = 120832, RW_ARK = 130048;
constexpr int RW_TMP = 139264, RW_SBT = 144384, RW_PC = 153600;
static_assert(RW_PC + 256 <= MISC_OFF, "rwkv lds map");
__device__ __forceinline__ bf16x8 frag_trp(const LAS u16* X, int ld, int idx0, int k0, int lane) {
    const int g = lane >> 4, q = (lane >> 2) & 3, p = lane & 3;
    const LAS u16* a = X + (k0 + 4 * (g >> 1) + q) * ld + idx0 + 16 * (g & 1) + 4 * p;
    const s16x4 lo = __builtin_bit_cast(s16x4, __builtin_amdgcn_ds_read_tr16_b64_v4i16((LAS s16x4*)a));
    const s16x4 hi = __builtin_bit_cast(s16x4, __builtin_amdgcn_ds_read_tr16_b64_v4i16((LAS s16x4*)(a + 8 * ld)));
    return (bf16x8){lo[0], lo[1], lo[2], lo[3], hi[0], hi[1], hi[2], hi[3]};
}
__device__ __forceinline__ bf16x8 acc_frag(const f32x16& x, const int s) {
    const v4u w = (v4u){pkbf(x[8 * s], x[8 * s + 1]), pkbf(x[8 * s + 2], x[8 * s + 3]), pkbf(x[8 * s + 4], x[8 * s + 5]), pkbf(x[8 * s + 6], x[8 * s + 7])};
    return __builtin_bit_cast(bf16x8, w);
}
#define WAVE_LDS_SYNC() asm volatile("s_waitcnt lgkmcnt(0)" ::: "memory")
__device__ __forceinline__ void rwkv_chain(const Params& p, LAS unsigned char* lds, int tid, int lane_in, int wave, int b, int h, int dir) {
    LAS u16* WDs = (LAS u16*)(lds + RW_WD); LAS u16* ADs = (LAS u16*)(lds + RW_AD); LAS u16* W2s = (LAS u16*)(lds + RW_W2); LAS u16* A2s = (LAS u16*)(lds + RW_A2); LAS float* TOT = (LAS float*)(lds + RW_TOT);
    LAS u16* LWh = (LAS u16*)(lds + RW_LW); LAS u16* AGb = (LAS u16*)(lds + RW_AG); LAS float* PC = (LAS float*)(lds + RW_PC);
    LAS float* LF = (LAS float*)(lds + RW_LF); LAS u16* TB = (LAS u16*)(lds + RW_TB); LAS u16* LB = (LAS u16*)(lds + RW_LB);
    LAS u16* AAK = (LAS u16*)(lds + RW_AAK); LAS u16* ARB = (LAS u16*)(lds + RW_ARB); LAS u16* ARK = (LAS u16*)(lds + RW_ARK);
    LAS u16* ATs = (LAS u16*)(lds + RW_AT); LAS u16* BTs = (LAS u16*)(lds + RW_BT); LAS u16* KTs = (LAS u16*)(lds + RW_KT); LAS u16* RTs = (LAS u16*)(lds + RW_RT);
    LAS u16* VVs = (LAS u16*)(lds + RW_VV); LAS u16* TMP = (LAS u16*)(lds + RW_TMP); LAS u16* SBT = (LAS u16*)(lds + RW_SBT);
    const int t2 = (wave & 3) >> 1, c2 = wave & 1;
    unsigned pc_[4][3], pn_[4][3]; u32x2 pw_[4];
#define RW_LOAD(nn) do { bool ic_; int tb_; long rb_; chain_chunk((nn), dir, b, ic_, tb_, rb_); \
        const int lt_ = fresh_tid(wave), tg_ = lt_ >> 5, hc_ = h * 64 + 2 * (lt_ & 31), tok_ = lt_ >> 3, cg_ = lt_ & 7; \
        const int qr = hc_ / 440, qk = (512 + hc_) / 440, qv = (1024 + hc_) / 440; \
        const char* zb_ = (const char*)(Z + rb_ * ZLD + ZR);                         \
        const bool e0_ = ic_ ? (tb_ == 0) : true, e1_ = ic_ ? (tb_ == CTXL - 64) : true, vu_ = tb_ >= 64, vdn_ = tb_ < SEQ - 64; \
          \
        const int kr_ = ic_ ? (qr < 2 ? 0 : 1) : qr, kk_ = ic_ ? (qk < 2 ? 0 : 1) : qk, kv_ = ic_ ? (qv < 2 ? 0 : 1) : qv, kd_ = ic_ ? 1 : 3; \
        const int RB_ = ZLD * 2; \
        const int dr_ = kr_ == 0 ? -RB_ : kr_ == 1 ? RB_ : kr_ == 2 ? -64 * RB_ : 64 * RB_, dk_ = kk_ == 0 ? -RB_ : kk_ == 1 ? RB_ : kk_ == 2 ? -64 * RB_ : 64 * RB_, dv_ = kv_ == 0 ? -RB_ : kv_ == 1 ? RB_ : kv_ == 2 ? -64 * RB_ : 64 * RB_, dd_ = kd_ == 1 ? RB_ : 64 * RB_; \
        _Pragma("unroll") for (int i = 0; i < 4; ++i) { const int j = 4 * tg_ + i, tl = dir ? 63 - j : j; \
            const bool a0 = !(e0_ && tl == 0), a1 = !(e1_ && tl == 63); \
            const bool v0 = kr_ == 0 ? a0 : kr_ == 1 ? a1 : kr_ == 2 ? vu_ : vdn_, v1 = kk_ == 0 ? a0 : kk_ == 1 ? a1 : kk_ == 2 ? vu_ : vdn_, v2 = kv_ == 0 ? a0 : kv_ == 1 ? a1 : kv_ == 2 ? vu_ : vdn_; \
            const int off = tl * RB_ + hc_ * 2; \
            pc_[i][0] = *(const unsigned*)(zb_ + (long)off); pc_[i][1] = *(const unsigned*)(zb_ + (long)(off + 1024)); pc_[i][2] = *(const unsigned*)(zb_ + (long)(off + 2048)); \
            const unsigned x0 = *(const unsigned*)(zb_ + (long)(off + (v0 ? dr_ : 0))), x1 = *(const unsigned*)(zb_ + (long)(off + 1024 + (v1 ? dk_ : 0))), x2 = *(const unsigned*)(zb_ + (long)(off + 2048 + (v2 ? dv_ : 0))); \
            pn_[i][0] = v0 ? x0 : 0u; pn_[i][1] = v1 ? x1 : 0u; pn_[i][2] = v2 ? x2 : 0u; } \
        { const int j = tok_, tl = dir ? 63 - j : j; const bool vd = kd_ == 1 ? !(e1_ && tl == 63) : vdn_; \
            const int offw = tl * RB_ + (1536 + dir * 32 + 4 * cg_) * 2, offn = offw + (vd ? dd_ : 0); \
            pw_[0] = *(const u32x2*)(zb_ + (long)offw); pw_[1] = *(const u32x2*)(zb_ + (long)(offw + 128)); \
            const u32x2 yw = *(const u32x2*)(zb_ + (long)offn), ya = *(const u32x2*)(zb_ + (long)(offn + 128)); \
            pw_[2] = vd ? yw : (u32x2){0u, 0u}; pw_[3] = vd ? ya : (u32x2){0u, 0u}; \
 } \
    } while (0)
    { const u16* Z = (const u16*)(p.ws + WS_Z); RW_LOAD(0); }
#define LOAD_CA() do { const int l_ = fresh_tid(wave), hc_ = h * 64 + 2 * (l_ & 31), cg_ = l_ & 7; cA_mur = *(const f32x2*)(p.mu + hc_); cA_muk = *(const f32x2*)(p.mu + 512 + hc_); cA_muv = *(const f32x2*)(p.mu + 1024 + hc_); \
        cA_muw = *(const f32x4*)(p.mu + 1536 + dir * 32 + 4 * cg_); cA_mua = *(const f32x4*)(p.mu + 1600 + dir * 32 + 4 * cg_); } while (0)
#define LOAD_CC() do { const int hc_ = h * 64 + 2 * (fresh_tid(wave) & 31); cC_kk = *(const f32x2*)(p.kkw + hc_); cC_ka = *(const f32x2*)(p.kaw + hc_); cC_rk = *(const f32x2*)(p.rkw + hc_); } while (0)
    f32x16 Sa = zero16();
    f32x2 cA_mur, cA_muk, cA_muv, cC_kk, cC_ka, cC_rk; f32x4 cA_muw, cA_mua;
    {   const u16* w2t = (const u16*)(p.ws + WS_W2T) + (size_t)(dir * 512 + h * 64) * 32; const u16* a2t = (const u16*)(p.ws + WS_A2T) + (size_t)(dir * 512 + h * 64) * 32;
        for (int i = tid; i < 64 * 32; i += 512) { const int c = i >> 5, l = i & 31; W2s[c * 40 + l] = w2t[i]; A2s[c * 40 + l] = a2t[i]; } }
    float rv[4][2], kv[4][2], vv[4][2];
    float lw[4][2], av[4][2], bv[4][2], kd[4][2], cl[4][2];
    if (wave < 4) st_tile_T(SBT, 72, 32 * (wave >> 1), 32 * (wave & 1), Sa, lane_in);
    LOAD_CA();
    LBAR();
#ifdef DBG_TSTAGE
    unsigned tacc = 0, tprev = 0;
#define TNOW(v) do { unsigned long long t64_; asm volatile("s_memtime %0\n\ts_waitcnt lgkmcnt(0)" : "=s"(t64_)); v = (unsigned)t64_; } while (0)
#define TSTB(k) do { if ((k) == DBG_TSTAGE && DBG_BUSY) { unsigned tn_; TNOW(tn_); tacc += tn_ - tprev; } } while (0)
#define TST(k) do { unsigned tn_; TNOW(tn_); if ((k) == DBG_TSTAGE && !DBG_BUSY) tacc += tn_ - tprev; tprev = tn_; } while (0)
#else
#define TSTB(k) do { } while (0)
#define TST(k) do { } while (0)
#endif
    for (int n = -1; n < 132; ++n) {
        const bool e_on = n + 1 < 132, s_on = n >= 0;
        unsigned char* wsl = launder_sp(p.ws);
        const u16* Z = (const u16*)(wsl + WS_Z); u16* YY = (u16*)(wsl + WS_YY); u16* VL = (u16*)(wsl + WS_VL); u16* GG = (u16*)(wsl + WS_G); float* SBv = (float*)(wsl + WS_SB);
        bool isctxE = false, isctxS = false; int tbaseE = 0, tbaseS = 0; long rowbaseE = 0, rowbaseS = 0;
        if (e_on) chain_chunk(n + 1, dir, b, isctxE, tbaseE, rowbaseE);
        if (s_on) chain_chunk(n, dir, b, isctxS, tbaseS, rowbaseS);
        const bool do_g = e_on && (!isctxE) && (dir == 0), wr_sb = e_on && !isctxE, wr_y = s_on && !isctxS;
        const int ltid = fresh_tid(wave), lane = ltid & 63, h5 = lane >> 5, r = lane & 31;
        const int tg = ltid >> 5, c0 = 2 * r, hc = h * 64 + c0, tok8 = ltid >> 3, cg = ltid & 7;
        for (int rq = 0; rq < RQ_E1; ++rq) if (e_on) {
            const f32x2 mur = cA_mur, muk = cA_muk, muv = cA_muv;
            const float mur0 = mur.x, mur1 = mur.y, muk0 = muk.x, muk1 = muk.y, muv0 = muv.x, muv1 = muv.y;
            const f32x4 muw = cA_muw, mua = cA_mua;
#pragma unroll
            for (int i = 0; i < 4; ++i) {
                const unsigned ur = pc_[i][0], uk = pc_[i][1], uv = pc_[i][2], nr = pn_[i][0], nk = pn_[i][1], nv = pn_[i][2];
                rv[i][0] = bflo(ur) + mur0 * (bflo(nr) - bflo(ur)); rv[i][1] = bfhi(ur) + mur1 * (bfhi(nr) - bfhi(ur));
                kv[i][0] = bflo(uk) + muk0 * (bflo(nk) - bflo(uk)); kv[i][1] = bfhi(uk) + muk1 * (bfhi(nk) - bfhi(uk));
                vv[i][0] = bflo(uv) + muv0 * (bflo(nv) - bflo(uv)); vv[i][1] = bfhi(uv) + muv1 * (bfhi(nv) - bfhi(uv));
            }
            if (do_g) {
#pragma unroll
                for (int i = 0; i < 4; ++i) { const int j = 4 * tg + i, tl = dir ? 63 - j : j; *(unsigned*)(VL + (rowbaseE + tl) * 512 + hc) = pkbf(vv[i][0], vv[i][1]); }
            }
            {
                const int j = tok8;
                const u32x2 cw = pw_[0], ca = pw_[1], nw = pw_[2], na = pw_[3];
                float wl[4], al[4];
                wl[0] = bflo(cw.x) + muw[0] * (bflo(nw.x) - bflo(cw.x)); wl[1] = bfhi(cw.x) + muw[1] * (bfhi(nw.x) - bfhi(cw.x)); wl[2] = bflo(cw.y) + muw[2] * (bflo(nw.y) - bflo(cw.y)); wl[3] = bfhi(cw.y) + muw[3] * (bfhi(nw.y) - bfhi(cw.y));
                al[0] = bflo(ca.x) + mua[0] * (bflo(na.x) - bflo(ca.x)); al[1] = bfhi(ca.x) + mua[1] * (bfhi(na.x) - bfhi(ca.x)); al[2] = bflo(ca.y) + mua[2] * (bflo(na.y) - bflo(ca.y)); al[3] = bfhi(ca.y) + mua[3] * (bfhi(na.y) - bfhi(ca.y));
#pragma unroll
                for (int e = 0; e < 4; ++e) wl[e] = 1.0f - 2.0f * __builtin_amdgcn_rcpf(1.0f + __expf(2.0f * wl[e]));
                *(LAS u32x2*)(WDs + j * 40 + 4 * cg) = (u32x2){pkbf(wl[0], wl[1]), pkbf(wl[2], wl[3])};
                *(LAS u32x2*)(ADs + j * 40 + 4 * cg) = (u32x2){pkbf(al[0], al[1]), pkbf(al[2], al[3])};
            }
        }
        for (int rq = 0; rq < RQ_INV; ++rq) if (s_on && wave < 2) {
            const int bi = 2 * wave + ((lane >> 4) & 1), jj = lane & 15; float Td[16];
            int lfo = bi * 320;
#pragma unroll
            for (int i = 0; i < 16; ++i) {
                float s = (i == jj) ? 1.0f : 0.0f;
                const LAS float* Lr = LF + lfo + i * 20;
#pragma unroll
                for (int k4 = 0; k4 < 4; ++k4) if (4 * k4 < i) { const f32x4 lv = *(const LAS f32x4*)(Lr + 4 * k4);
#pragma unroll
                    for (int e = 0; e < 4; ++e) if (4 * k4 + e < i) s += lv[e] * Td[4 * k4 + e]; }
                Td[i] = s;
                if (i == 5 || i == 9 || i == 12) asm volatile("" : "+v"(lfo) : "v"(Td[i - 2]));
            }
            LAS u16* tp = TB + (16 * bi + jj) * 72 + 16 * bi;
            *(LAS v4u*)tp = (v4u){pkbf(Td[0], Td[1]), pkbf(Td[2], Td[3]), pkbf(Td[4], Td[5]), pkbf(Td[6], Td[7])};
            *(LAS v4u*)(tp + 8) = (v4u){pkbf(Td[8], Td[9]), pkbf(Td[10], Td[11]), pkbf(Td[12], Td[13]), pkbf(Td[14], Td[15])};
            LAS u16* zp = TB + (16 * bi + jj) * 72 + 16 * (bi ^ 1);
            *(LAS v4u*)zp = (v4u){0u, 0u, 0u, 0u}; *(LAS v4u*)(zp + 8) = (v4u){0u, 0u, 0u, 0u};
            WAVE_LDS_SYNC();
            const int o = 32 * wave; f32x16 a = zero16();
#pragma unroll
            for (int ks = 0; ks < 2; ++ks) a = MFMA32(frag_tr(LB, 72, o, o + 16 * ks, lane), frag_kc(TB, 72, o, o + 16 * ks, lane), a);
            st_tile_T(TMP + wave * 1280, 40, 0, 0, a, lane);
            WAVE_LDS_SYNC();
            a = zero16();
#pragma unroll
            for (int ks = 0; ks < 2; ++ks) a = MFMA32(frag_tr(TB, 72, o, o + 16 * ks, lane), frag_kc(TMP + wave * 1280, 40, 0, 16 * ks, lane), a);
            if (r < 16) { LAS u16* q = TB + (o + r) * 72 + o + 4 * h5;
#pragma unroll
                for (int g = 2; g < 4; ++g) *(LAS u32x2*)(q + 8 * g) = (u32x2){pkbf(a[4 * g], a[4 * g + 1]), pkbf(a[4 * g + 2], a[4 * g + 3])}; }
        }
        TSTB(0);
        LBAR();
        TST(0);
        for (int rq = 0; rq < RQ_M1; ++rq) if (e_on && wave >= 4) {
#pragma unroll
            for (int q = 0; q < 2; ++q) {
                const int tile = 2 * (wave - 4) + q;
                const int isa = tile >> 2, tt2 = (tile >> 1) & 1, cc2 = tile & 1;
                const LAS u16* Xs = isa ? ADs : WDs; const LAS u16* Ws = isa ? A2s : W2s;
                const float mbias = isa ? p.a0[dir * 512 + h * 64 + 32 * cc2 + r] : p.w0[dir * 512 + h * 64 + 32 * cc2 + r];
                f32x16 a = zero16();
#pragma unroll
                for (int ks = 0; ks < 2; ++ks) a = MFMA32(frag_kc(Xs, 40, 32 * tt2, 16 * ks, lane), frag_kc(Ws, 40, 32 * cc2, 16 * ks, lane), a);
                if (!isa) {
#pragma unroll
                    for (int i = 0; i < 16; ++i) { const _Float16 hv = (_Float16)(-0.6065306597f * sigm(a[i] + mbias)); LWh[(32 * tt2 + arow(i, h5)) * 72 + 32 * cc2 + r] = __builtin_bit_cast(unsigned short, hv); }
                } else {
#pragma unroll
                    for (int i = 0; i < 16; ++i) AGb[(32 * tt2 + arow(i, h5)) * 72 + 32 * cc2 + r] = (u16)(pkbf(sigm(a[i] + mbias), 0.f) & 0xffffu);
                }
            }
        }
        if (s_on && wave < 4) {
            const int v0 = 32 * (wave >> 1), ci = wave & 1, cs = 32 * ci;
            bf16x8 vf[4], sf[4];
#pragma unroll
            for (int ks = 0; ks < 4; ++ks) { vf[ks] = frag_tr(VVs, 72, v0, 16 * ks, lane); sf[ks] = frag_tr(SBT, 72, v0, 16 * ks, lane); }
            f32x16 A0 = zero16();
            { bf16x8 fa[6];
#pragma unroll
              for (int ks = 0; ks < 2; ++ks) fa[ks] = frag_tr(AAK, 72, 0, 16 * ks, lane);
#pragma unroll
              for (int ks = 0; ks < 4; ++ks) fa[2 + ks] = frag_kc(ATs, 72, 0, 16 * ks, lane);
#pragma unroll
              for (int ks = 0; ks < 2; ++ks) A0 = MFMA32(fa[ks], vf[ks], A0);
#pragma unroll
              for (int ks = 0; ks < 4; ++ks) A0 = MFMA32(fa[2 + ks], sf[ks], A0); }
            bf16x8 ut0, ut1;
            { const bf16x8 t0 = frag_trp(TB, 72, 0, 0, lane), t1 = frag_trp(TB, 72, 0, 16, lane); f32x16 Ut = zero16();
              Ut = MFMA32(t0, acc_frag(A0, 0), Ut); Ut = MFMA32(t1, acc_frag(A0, 1), Ut);
              ut0 = acc_frag(Ut, 0); ut1 = acc_frag(Ut, 1); }
            if (ci == 0) {
                A0 = zero16();
                bf16x8 fa[8];
#pragma unroll
                for (int ks = 0; ks < 2; ++ks) { fa[ks] = frag_tr(ARK, 72, 0, 16 * ks, lane); fa[6 + ks] = frag_trp(ARB, 72, 0, 16 * ks, lane); }
#pragma unroll
                for (int ks = 0; ks < 4; ++ks) fa[2 + ks] = frag_kc(RTs, 72, 0, 16 * ks, lane);
#pragma unroll
                for (int ks = 0; ks < 2; ++ks) A0 = MFMA32(fa[ks], vf[ks], A0);
#pragma unroll
                for (int ks = 0; ks < 4; ++ks) A0 = MFMA32(fa[2 + ks], sf[ks], A0);
                A0 = MFMA32(fa[6], ut0, A0); A0 = MFMA32(fa[7], ut1, A0);
                if (wr_y) {
#pragma unroll
                    for (int i = 0; i < 16; ++i) { const int j0 = arow(i, h5); const long r0 = rowbaseS + (dir ? 63 - j0 : j0); YY[r0 * 1024 + dir * 512 + h * 64 + v0 + r] = (u16)(pkbf(A0[i], 0.f) & 0xffffu); }
                }
            }
            { const bf16x8 b0 = frag_trp(BTs, 72, cs, 0, lane), b1 = frag_trp(BTs, 72, cs, 16, lane);
              Sa = MFMA32(ut0, b0, Sa); Sa = MFMA32(ut1, b1, Sa); }
            A0 = zero16();
            { bf16x8 fa[10];
#pragma unroll
              for (int ks = 0; ks < 4; ++ks) { fa[ks] = frag_tr(AAK, 72, 32, 16 * ks, lane); fa[4 + ks] = frag_kc(ATs, 72, 32, 16 * ks, lane); }
              fa[8] = frag_trp(LB, 72, 32, 0, lane); fa[9] = frag_trp(LB, 72, 32, 16, lane);
#pragma unroll
              for (int ks = 0; ks < 4; ++ks) A0 = MFMA32(fa[ks], vf[ks], A0);
#pragma unroll
              for (int ks = 0; ks < 4; ++ks) A0 = MFMA32(fa[4 + ks], sf[ks], A0);
              A0 = MFMA32(fa[8], ut0, A0); A0 = MFMA32(fa[9], ut1, A0); }
            bf16x8 ub0, ub1;
            { const bf16x8 t0 = frag_trp(TB, 72, 32, 32, lane), t1 = frag_trp(TB, 72, 32, 48, lane); f32x16 Ub = zero16();
              Ub = MFMA32(t0, acc_frag(A0, 0), Ub); Ub = MFMA32(t1, acc_frag(A0, 1), Ub);
              ub0 = acc_frag(Ub, 0); ub1 = acc_frag(Ub, 1); }
            if (ci == 1) {
                A0 = zero16();
                bf16x8 fa[12];
#pragma unroll
                for (int ks = 0; ks < 4; ++ks) { fa[ks] = frag_tr(ARK, 72, 32, 16 * ks, lane); fa[4 + ks] = frag_kc(RTs, 72, 32, 16 * ks, lane); fa[8 + ks] = frag_trp(ARB, 72, 32, 16 * ks, lane); }
#pragma unroll
                for (int ks = 0; ks < 4; ++ks) A0 = MFMA32(fa[ks], vf[ks], A0);
#pragma unroll
                for (int ks = 0; ks < 4; ++ks) A0 = MFMA32(fa[4 + ks], sf[ks], A0);
                A0 = MFMA32(fa[8], ut0, A0); A0 = MFMA32(fa[9], ut1, A0); A0 = MFMA32(fa[10], ub0, A0); A0 = MFMA32(fa[11], ub1, A0);
                if (wr_y) {
#pragma unroll
                    for (int i = 0; i < 16; ++i) { const int j1 = 32 + arow(i, h5); const long r1 = rowbaseS + (dir ? 63 - j1 : j1); YY[r1 * 1024 + dir * 512 + h * 64 + v0 + r] = (u16)(pkbf(A0[i], 0.f) & 0xffffu); }
                }
            }
            { bf16x8 fb[6];
              fb[0] = frag_trp(BTs, 72, cs, 32, lane); fb[1] = frag_trp(BTs, 72, cs, 48, lane);
#pragma unroll
              for (int ks = 0; ks < 4; ++ks) fb[2 + ks] = frag_tr(KTs, 72, cs, 16 * ks, lane);
              Sa = MFMA32(ub0, fb[0], Sa); Sa = MFMA32(ub1, fb[1], Sa);
#pragma unroll
              for (int ks = 0; ks < 4; ++ks) Sa = MFMA32(vf[ks], fb[2 + ks], Sa); }
            { const float pca = PC[cs + r];
#pragma unroll
              for (int i = 0; i < 16; ++i) Sa[i] *= pca; }
        }
        if (e_on) { LOAD_CC(); }
        TSTB(1);
        LBAR();
        TST(1);
        if (s_on && wave < 4) st_tile_T(SBT, 72, 32 * (wave >> 1), 32 * (wave & 1), Sa, lane);
        float cum0 = 0.f, cum1 = 0.f; float sbv[4];
        for (int rq = 0; rq < RQ_E2A; ++rq) if (e_on) {
            cum0 = 0.f; cum1 = 0.f;
            const f32x2 kkp = cC_kk, kap = cC_ka, rkp = cC_rk;
            const float kk0 = kkp.x, kk1 = kkp.y, ka0 = kap.x, ka1 = kap.y, rk0 = rkp.x, rk1 = rkp.y;
            unsigned lwu[4], agu[4];
#pragma unroll
            for (int i = 0; i < 4; ++i) { const int j = 4 * tg + i; lwu[i] = *(const LAS unsigned*)(LWh + j * 72 + c0); agu[i] = *(const LAS unsigned*)(AGb + j * 72 + c0); }
#pragma unroll
            for (int i = 0; i < 4; ++i) {
                lw[i][0] = h2f((unsigned short)(lwu[i] & 0xffffu)); lw[i][1] = h2f((unsigned short)(lwu[i] >> 16));
                const float ag0 = bflo(agu[i]), ag1 = bfhi(agu[i]);
                float k0 = kv[i][0] * kk0, k1 = kv[i][1] * kk1; float ss = k0 * k0 + k1 * k1;
                kd[i][0] = kv[i][0] * (1.0f + (ag0 - 1.0f) * ka0); kd[i][1] = kv[i][1] * (1.0f + (ag1 - 1.0f) * ka1);
                float sb = rv[i][0] * kd[i][0] * rk0 + rv[i][1] * kd[i][1] * rk1;
                ss = sum32(ss); sb = sum32(sb); sbv[i] = sb;
                const float inv = 1.0f / fmaxf(sqrtf(ss), 1e-12f); k0 *= inv; k1 *= inv;
                av[i][0] = -k0; av[i][1] = -k1; bv[i][0] = k0 * ag0; bv[i][1] = k1 * ag1;
                cum0 += lw[i][0]; cum1 += lw[i][1]; cl[i][0] = cum0; cl[i][1] = cum1;
            }
            if (wr_sb && r == 0) {
#pragma unroll
                for (int i = 0; i < 4; ++i) { const int j = 4 * tg + i, tl = dir ? 63 - j : j; SBv[((size_t)dir * NTOK + rowbaseE + tl) * 8 + h] = sbv[i]; }
            }
            *(LAS f32x2*)(TOT + tg * 64 + c0) = (f32x2){cum0, cum1};
#pragma unroll
            for (int i = 0; i < 4; ++i) *(LAS unsigned*)(VVs + (4 * tg + i) * 72 + c0) = pkbf(vv[i][0], vv[i][1]);
            if (n + 2 < 132) { RW_LOAD(n + 2); }
        }
        TSTB(2);
        LBAR();
        TST(2);
        for (int rq = 0; rq < RQ_E2B; ++rq) if (e_on) {
            float base0 = 0.f, base1 = 0.f, tt0 = 0.f, tt1 = 0.f;
#pragma unroll
            for (int g = 0; g < 16; ++g) { const f32x2 t = *(const LAS f32x2*)(TOT + g * 64 + c0); if (g < tg) { base0 += t.x; base1 += t.y; } tt0 += t.x; tt1 += t.y; }
            float Xp0 = __expf(base0), Xp1 = __expf(base1);
#pragma unroll
            for (int i = 0; i < 4; ++i) {
                const int j = 4 * tg + i;
                const float E0 = __expf(base0 + cl[i][0]), E1 = __expf(base1 + cl[i][1]), I0 = __builtin_amdgcn_rcpf(E0), I1 = __builtin_amdgcn_rcpf(E1);
                *(LAS unsigned*)(ATs + j * 72 + c0) = pkbf(av[i][0] * Xp0, av[i][1] * Xp1);
                *(LAS unsigned*)(BTs + j * 72 + c0) = pkbf(bv[i][0] * I0, bv[i][1] * I1);
                *(LAS unsigned*)(KTs + j * 72 + c0) = pkbf(kd[i][0] * I0, kd[i][1] * I1);
                *(LAS unsigned*)(RTs + j * 72 + c0) = pkbf(rv[i][0] * E0, rv[i][1] * E1);
                Xp0 = E0; Xp1 = E1;
            }
            if (tg == 0) *(LAS f32x2*)(PC + c0) = (f32x2){__expf(tt0), __expf(tt1)};
        }
        TSTB(3);
        LBAR();
        TST(3);
        for (int rq = 0; rq < RQ_M2; ++rq) if (e_on) {
            const int mtx = wave & 3; const LAS u16* Am = mtx < 2 ? ATs : RTs; const LAS u16* Bm = (mtx & 1) ? KTs : BTs; LAS u16* Dm = (LAS u16*)(lds + RW_LB + 9216 * mtx);
            const int ntile = wave < 4 ? 2 : 1;
#pragma unroll
            for (int q = 0; q < 2; ++q) if (q < ntile) {
                const int ti = wave < 4 ? 1 - q : 1, ii = wave < 4 ? 0 : 1;
                f32x16 a = zero16();
#pragma unroll
                for (int ks = 0; ks < 4; ++ks) a = MFMA32(frag_kc(Am, 72, 32 * ti, 16 * ks, lane), frag_kc(Bm, 72, 32 * ii, 16 * ks, lane), a);
#pragma unroll
                for (int i = 0; i < 16; ++i) { const int lim = (ti != ii) ? 64 : (arow(i, h5) + (mtx < 2 ? 0 : 1)); a[i] = (r < lim) ? a[i] : 0.f; }
                st_tile_T(Dm, 72, 32 * ti, 32 * ii, a, lane);
                if (mtx == 0 && ti == ii) {
#pragma unroll
                    for (int i = 0; i < 16; ++i) { const int t = arow(i, h5); if ((t >> 4) == (r >> 4)) LF[(2 * ti + (t >> 4)) * 320 + (t & 15) * 20 + (r & 15)] = a[i]; }
                }
            }
        }
        if (n + 2 < 132) { LOAD_CA(); }
        TSTB(4);
        LBAR();
        TST(4);
    }
#ifdef DBG_TSTAGE
    if (b == 0 && h == 0 && dir == 0 && wave == DBG_TWAVE && (lane_in == 0)) ((float*)(p.ws + WS_CTL))[8192] = __expf(floorf(__logf((float)tacc / 133.0f) * 20.0f + 0.5f) * 0.05f);
#endif
#undef RW_LOAD
}

__device__ __forceinline__ void gate_panel(const Params& p, LAS unsigned char* lds, int lane, int wave, int pm) {
    const u16* Z = (const u16*)(p.ws + WS_Z); u16* GG = (u16*)(p.ws + WS_G); const u16* G2T = (const u16*)(p.ws + WS_G2T);
    LAS u16* Gs = (LAS u16*)(lds + wave * 6656);
    const int r = lane & 31, h5 = lane >> 5;
    {   const int rr = lane >> 1, half = lane & 1; const long row = (long)pm * 256 + wave * 32 + rr; const bool vd = (row & (SEQ - 1)) < SEQ - 64;
        const u16* zc = Z + row * ZLD + ZR + 1664 + 48 * half; const u16* zn = zc + (vd ? 64 * ZLD : 0);
#pragma unroll
        for (int q = 0; q < 6; ++q) { const v4u c = *(const v4u*)(zc + 8 * q); v4u nb = *(const v4u*)(zn + 8 * q); if (!vd) nb = (v4u){0u, 0u, 0u, 0u};
            const f32x4 m0 = *(const f32x4*)(p.mu + 1664 + 48 * half + 8 * q), m1 = *(const f32x4*)(p.mu + 1664 + 48 * half + 8 * q + 4);
            float cv[8], nv[8]; unpack8(c, cv); unpack8(nb, nv);
            float g[8];
#pragma unroll
            for (int e = 0; e < 8; ++e) { const float mu = e < 4 ? m0[e] : m1[e - 4]; g[e] = sigm(cv[e] + mu * (nv[e] - cv[e])); }
            *(LAS v4u*)(Gs + rr * 104 + 48 * half + 8 * q) = (v4u){pkbf(g[0], g[1]), pkbf(g[2], g[3]), pkbf(g[4], g[5]), pkbf(g[6], g[7])}; } }
    asm volatile("s_waitcnt lgkmcnt(0)" ::: "memory");
    bf16x8 af[6];
#pragma unroll
    for (int ks = 0; ks < 6; ++ks) af[ks] = frag_kc(Gs, 104, 0, 16 * ks, lane);
    for (int ct = 0; ct < 16; ++ct) {
        f32x16 a = zero16();
        const u16* bp = G2T + (size_t)(32 * ct + r) * 96 + 8 * h5;
#pragma unroll
        for (int ks = 0; ks < 6; ++ks) a = MFMA32(af[ks], *(const bf16x8*)(bp + 16 * ks), a);
#pragma unroll
        for (int i = 0; i < 16; ++i) { const long row = (long)pm * 256 + wave * 32 + arow(i, h5); GG[row * 512 + 32 * ct + r] = (u16)(pkbf(a[i], 0.f) & 0xffffu); }
    }
    asm volatile("s_waitcnt lgkmcnt(0)" ::: "memory");
}
#define CU_SYNC() do { asm volatile("s_waitcnt vmcnt(0)" ::: "memory"); __syncthreads(); __builtin_amdgcn_fence(__ATOMIC_ACQUIRE, "agent"); asm volatile("s_waitcnt vmcnt(0)" ::: "memory"); __syncthreads(); } while (0)
__device__ __forceinline__ void hgrn_combine_panel(const Params& p, int pm, int lane, int wave) {
    const u16* Z = (const u16*)(p.ws + WS_Z); u16* O = (u16*)p.out;
    float nw[8];
#pragma unroll
    for (int e = 0; e < 8; ++e) nw[e] = p.hg_norm_w[((8 * lane) & 127) + e];
    constexpr int RB = 4;
    for (int i = 0; i < 32; i += RB) {
        v4u uof[RB], uob[RB], uog[RB];
#pragma unroll
        for (int q = 0; q < RB; ++q) { const long row = (long)pm * 256 + wave * 32 + i + q;
            uof[q] = *(const v4u*)(O + row * 1024 + 8 * lane); uob[q] = *(const v4u*)(O + row * 1024 + 512 + 8 * lane); uog[q] = *(const v4u*)(Z + row * ZLD + ZOG + 8 * lane); }
#pragma unroll
        for (int q = 0; q < RB; ++q) { const long row = (long)pm * 256 + wave * 32 + i + q;
            float a[8], b[8], c[8], o[8];
            unpack8(uof[q], a); unpack8(uob[q], b); unpack8(uog[q], c);
            float ss = 0.f;
#pragma unroll
            for (int e = 0; e < 8; ++e) { o[e] = a[e] + b[e]; ss += o[e] * o[e]; }
            ss = sum16(ss);
            const float rs = 1.0f / sqrtf(ss * (1.0f / 128.0f) + 1e-5f);
            v4u wh;
            wh.x = pkbf(o[0] * rs * nw[0] * c[0], o[1] * rs * nw[1] * c[1]); wh.y = pkbf(o[2] * rs * nw[2] * c[2], o[3] * rs * nw[3] * c[3]);
            wh.z = pkbf(o[4] * rs * nw[4] * c[4], o[5] * rs * nw[5] * c[5]); wh.w = pkbf(o[6] * rs * nw[6] * c[6], o[7] * rs * nw[7] * c[7]);
            *(v4u*)(O + row * 1024 + 8 * lane) = wh; }
    }
}
__device__ __forceinline__ void combine_panel(const Params& p, int pm, int lane, int wave) {
    u16* YY = (u16*)(p.ws + WS_YY); const u16* VL = (const u16*)(p.ws + WS_VL); const u16* GG = (const u16*)(p.ws + WS_G);
    const float* SBv = (const float*)(p.ws + WS_SB);
    float lw_[8], lb_[8];
#pragma unroll
    for (int e = 0; e < 8; ++e) { lw_[e] = p.lnxw[8 * lane + e]; lb_[e] = p.lnxb[8 * lane + e]; }
    const int hh = lane >> 3;
    constexpr int RB = 4;
    for (int i = 0; i < 32; i += RB) {
        v4u uyf[RB], uyb[RB], uv[RB], ug[RB]; float sfb[RB];
#pragma unroll
        for (int q = 0; q < RB; ++q) { const long row = (long)pm * 256 + wave * 32 + i + q;
            uyf[q] = *(const v4u*)(YY + row * 1024 + 8 * lane); uyb[q] = *(const v4u*)(YY + row * 1024 + 512 + 8 * lane); uv[q] = *(const v4u*)(VL + row * 512 + 8 * lane); ug[q] = *(const v4u*)(GG + row * 512 + 8 * lane);
            sfb[q] = SBv[(size_t)row * 8 + hh] + SBv[((size_t)NTOK + row) * 8 + hh]; }
#pragma unroll
        for (int q = 0; q < RB; ++q) { const long row = (long)pm * 256 + wave * 32 + i + q;
            float yf[8], yb[8], vv[8], gg[8], y[8];
            unpack8(uyf[q], yf); unpack8(uyb[q], yb); unpack8(uv[q], vv); unpack8(ug[q], gg);
            float sm = 0.f;
#pragma unroll
            for (int e = 0; e < 8; ++e) { y[e] = yf[e] + yb[e]; sm += y[e]; }
            sm = sum8(sm);
            const float mean = sm * (1.0f / 64.0f); float sq = 0.f;
#pragma unroll
            for (int e = 0; e < 8; ++e) { y[e] -= mean; sq += y[e] * y[e]; }
            sq = sum8(sq);
            const float rstd = 1.0f / sqrtf(sq * (1.0f / 64.0f) + 64e-5f);
#pragma unroll
            for (int e = 0; e < 8; ++e) y[e] = (y[e] * rstd * lw_[e] + lb_[e] + sfb[q] * vv[e]) * gg[e];
            v4u wr; wr.x = pkbf(y[0], y[1]); wr.y = pkbf(y[2], y[3]); wr.z = pkbf(y[4], y[5]); wr.w = pkbf(y[6], y[7]);
            *(v4u*)(YY + row * 1024 + 512 + 8 * lane) = wr; }
    }
}
template <int RB> __device__ __forceinline__ void row_stats(f32x4 (&v)[RB][4], float (&mean)[RB], float (&rstd)[RB], float eps) {
    float s[RB];
#pragma unroll
    for (int q = 0; q < RB; ++q) { s[q] = 0.f;
#pragma unroll
        for (int j = 0; j < 4; ++j) s[q] += (v[q][j].x + v[q][j].y) + (v[q][j].z + v[q][j].w); }
#pragma unroll
    for (int q = 0; q < RB; ++q) mean[q] = wave_sum(s[q]) * (1.f / DM);
#pragma unroll
    for (int q = 0; q < RB; ++q) { s[q] = 0.f;
#pragma unroll
        for (int j = 0; j < 4; ++j) { v[q][j] = v[q][j] - mean[q]; s[q] += (v[q][j].x * v[q][j].x + v[q][j].y * v[q][j].y) + (v[q][j].z * v[q][j].z + v[q][j].w * v[q][j].w); } }
#pragma unroll
    for (int q = 0; q < RB; ++q) rstd[q] = 1.f / sqrtf(wave_sum(s[q]) * (1.f / DM) + eps);
}
__device__ __forceinline__ void ln1_panel(const Params& p, int pm, int lane, int wave) {
    const float* mod = (const float*)(p.ws + WS_MOD) + (size_t)((pm * 256) >> 13) * 6144; u16* U = (u16*)(p.ws + WS_U); const u16* F = (const u16*)(p.ws + WS_VL); u16* X1 = (u16*)(p.ws + WS_YY);
    constexpr int RB = 4;
    for (int i = 0; i < 32; i += RB) {
        const long row0 = (long)pm * 256 + wave * 32 + i;
        f32x4 v[RB][4]; float mean[RB], rstd[RB];
#pragma unroll
        for (int q = 0; q < RB; ++q)
#pragma unroll
            for (int j = 0; j < 4; ++j) { const f32x4 xv = __builtin_nontemporal_load((const f32x4*)(p.x + (row0 + q) * DM) + lane + 64 * j); const u32x2 fv = __builtin_nontemporal_load((const u32x2*)(F + (row0 + q) * DM) + lane + 64 * j);
                v[q][j] = xv * ALPHA + (f32x4){bflo(fv.x), bfhi(fv.x), bflo(fv.y), bfhi(fv.y)}; }
        row_stats<RB>(v, mean, rstd, 1e-5f);
#pragma unroll
        for (int j = 0; j < 4; ++j) { const f32x4 g = ((const f32x4*)p.ln1g)[lane + 64 * j], bb = ((const f32x4*)p.ln1b)[lane + 64 * j];
#pragma unroll
            for (int q = 0; q < RB; ++q) { v[q][j] = v[q][j] * rstd[q] * g + bb; u32x2 w; w.x = pkbf(v[q][j].x, v[q][j].y); w.y = pkbf(v[q][j].z, v[q][j].w); ((u32x2*)(X1 + (row0 + q) * DM))[lane + 64 * j] = w; } }
        row_stats<RB>(v, mean, rstd, 1e-6f);
#pragma unroll
        for (int j = 0; j < 4; ++j) { const f32x4 sh = ((const f32x4*)(mod + 3072))[lane + 64 * j], sc = ((const f32x4*)(mod + 4096))[lane + 64 * j];
#pragma unroll
            for (int q = 0; q < RB; ++q) { const f32x4 r = v[q][j] * rstd[q] * (sc + 1.0f) + sh; u32x2 w; w.x = pkbf(r.x, r.y); w.y = pkbf(r.z, r.w); ((u32x2*)(U + (row0 + q) * DM))[lane + 64 * j] = w; } }
    }
}
__device__ __forceinline__ void ln2_panel(const Params& p, int pm, int lane, int wave) {
    const u16* F = (const u16*)(p.ws + WS_VL); const u16* X1 = (const u16*)(p.ws + WS_YY);
    constexpr int RB = 4;
    for (int i = 0; i < 32; i += RB) {
        const long row0 = (long)pm * 256 + wave * 32 + i;
        f32x4 v[RB][4]; float mean[RB], rstd[RB];
#pragma unroll
        for (int q = 0; q < RB; ++q)
#pragma unroll
            for (int j = 0; j < 4; ++j) { const u32x2 xb = __builtin_nontemporal_load((const u32x2*)(X1 + (row0 + q) * DM) + lane + 64 * j); const u32x2 fv = __builtin_nontemporal_load((const u32x2*)(F + (row0 + q) * DM) + lane + 64 * j);
                v[q][j] = (f32x4){bflo(xb.x), bfhi(xb.x), bflo(xb.y), bfhi(xb.y)} * ALPHA + (f32x4){bflo(fv.x), bfhi(fv.x), bflo(fv.y), bfhi(fv.y)}; }
        row_stats<RB>(v, mean, rstd, 1e-5f);
#pragma unroll
        for (int j = 0; j < 4; ++j) { const f32x4 g = ((const f32x4*)p.ln2g)[lane + 64 * j], bb = ((const f32x4*)p.ln2b)[lane + 64 * j];
#pragma unroll
            for (int q = 0; q < RB; ++q) { f32x4 o = v[q][j] * rstd[q] * g + bb;
#ifdef DBG_SANITIZE
                for (int e2 = 0; e2 < 4; ++e2) if (!(fabsf(o[e2]) < 1e30f)) o[e2] = 0.f;
#endif
                ((f32x4*)(p.out + (row0 + q) * DM))[lane + 64 * j] = o; } }
    }
}

#ifndef P1_ALIGN
#define P1_ALIGN true
#endif
#ifndef P1_WGM
#define P1_WGM 8
#endif
#ifndef REP_LN1
#define REP_LN1 1
#endif
#ifndef REP0
#define REP0 1
#endif
#ifndef REP_DOWN
#define REP_DOWN 1
#endif
#ifndef REP_OUT
#define REP_OUT 1
#endif
#ifndef REP_GU
#define REP_GU 1
#endif
#ifndef REP1
#define REP1 1
#endif
#ifndef REP2
#define REP2 1
#endif
#ifndef REP_RW
#define REP_RW 1
#endif
#ifndef REP_HG
#define REP_HG 1
#endif
#ifndef N_LAUNCHES
#define N_LAUNCHES 1
#endif
typedef const unsigned long long __attribute__((address_space(4))) KWord;
__device__ __forceinline__ Params load_params(KWord* k) { asm volatile("" : "+s"(k)); Params q; unsigned long long* d = (unsigned long long*)&q;
#pragma unroll
    for (int i = 0; i < (int)(sizeof(Params) / 8); ++i) d[i] = k[i];
    return q; }
#define PARAMS() const Params p = load_params(kp)
__global__ void __launch_bounds__(NWAVES * 64, 2) mega_fwd(Params p_arg, int ph_lo, int ph_hi) {
    KWord* kp = (KWord*)__builtin_amdgcn_kernarg_segment_ptr();
    extern __shared__ __attribute__((aligned(16))) unsigned char lds_raw[];
    LAS unsigned char* lds = (LAS unsigned char*)lds_raw;
    const int wave = __builtin_amdgcn_readfirstlane((int)threadIdx.x >> 6), bid = blockIdx.x, G = gridDim.x;
#define TID_LANE() int lane; asm volatile("v_mbcnt_lo_u32_b32 %0, -1, 0\n\tv_mbcnt_hi_u32_b32 %0, -1, %0" : "=v"(lane)); const int tid = wave * 64 + lane
    volatile LAS unsigned* MISC = (volatile LAS unsigned*)(lds + MISC_OFF);
    { TID_LANE(); if (tid < 32) MISC[tid] = 0u; }
    __syncthreads();
    XcdBarrier bar; { PARAMS(); bar.bar = (unsigned*)(p.ws + WS_CTL) + CW_BAR; bar.x = 0; bar.st = nullptr;
    if (N_LAUNCHES == 1) bar = xcd_barrier_post((unsigned*)(p.ws + WS_CTL) + CW_BAR, MISC + 8); }
#ifndef PHASE_MASK
#define PHASE_MASK 1023
#endif
#define IN(k) (((PHASE_MASK >> (k)) & 1) && ph_lo <= (k) && (k) < ph_hi)
#define SEAM(k) do { if (N_LAUNCHES == 1 && IN(k) && IN((k) + 1)) xcd_barrier(bar); } while (0)
    if (IN(0)) { PARAMS(); TID_LANE(); for (int rp = 0; rp < REP0; ++rp) phase0a(p, lds, tid, lane, wave, bid, G); } SEAM(0);
    if (IN(1)) { PARAMS(); TID_LANE(); for (int rp = 0; rp < REP1; ++rp) phase0b(p, lane, wave, bid, G); } SEAM(1);
    if (IN(2)) { PARAMS(); TID_LANE();
        pg8::Gemm g{(const u16*)(p.ws + WS_U), (const u16*)(p.ws + WS_WIN), MROWS, ZLD, DM, DM, DM}; pg8::StaticOrder S; S.init(MROWS, ZLD - 512, G, bid, P1_WGM); S.gap_at = 8; S.gap = 2;
        const LAS float* epl = (const LAS float*)(lds + EPI_OFF);
        { LAS float* w = (LAS float*)(lds + EPI_OFF); const float* lbg = (const float*)(p.ws + WS_LB); for (int i = tid; i < 1024; i += NWAVES * 64) w[i] = lbg[i]; __syncthreads(); }
        pg8::EpiZ E{(u16*)(p.ws + WS_Z), ZLD, (const float*)(p.ws + WS_LB), 0};
#ifdef P1_STAGGER
        { const int grp = (bid >> 3) & (P1_STAGGER - 1); if (grp) { const unsigned long long t0 = __builtin_amdgcn_s_memrealtime(); while (__builtin_amdgcn_s_memrealtime() - t0 < (unsigned long long)(2900 / P1_STAGGER) * grp) __builtin_amdgcn_s_sleep(8); } }
#endif
#ifdef PROBE_P1NULL_FIRST
        { pg8::EpiNull E0; pg8::gemm_phase<pg8::EpiNull, pg8::StaticOrder, true, true>(lds, g, S, E0, launder(tid)); }
#endif
#ifdef PROBE_P1RAW
        for (int rp = 0; rp < 2; ++rp) { pg8::EpiZ Er{(u16*)(p.ws + (rp == 0 ? WS_YY : WS_Z)), ZLD, (const float*)(p.ws + WS_LB), rp == 0 ? PROBE_P1RAW : 0}; pg8::gemm_phase<pg8::EpiZ, pg8::StaticOrder, P1_ALIGN, true>(lds, g, S, Er, launder(tid)); }
#else
        for (int rp = 0; rp < REP2; ++rp) pg8::gemm_phase<pg8::EpiZ, pg8::StaticOrder, P1_ALIGN, true>(lds, g, S, E, launder(tid));
#endif
#ifdef PROBE_P1NULL
        { pg8::EpiNull E0; pg8::StaticOrder S0; S0.init(PROBE_P1NULL == 2 ? NTOK : MROWS, ZLD, G, bid, P1_WGM); pg8::gemm_phase<pg8::EpiNull, pg8::StaticOrder, true, true>(lds, g, S0, E0, launder(tid)); }
#endif
    } SEAM(2);
    if (IN(3)) { PARAMS();
        constexpr int NGATE = 64;
        for (int task = bid; task < 192 + NGATE; task += G) {
            int lane2; asm volatile("v_mbcnt_lo_u32_b32 %0, -1, 0\n\tv_mbcnt_hi_u32_b32 %0, -1, %0" : "=v"(lane2)); const int tid2 = wave * 64 + lane2;
            if (task < 128) { for (int rp = 0; rp < REP_RW; ++rp) rwkv_chain(p, lds, tid2, lane2, wave, task >> 4, (task >> 1) & 7, task & 1); }
            else if (task < 192) { const int t = task - 128; for (int rp = 0; rp < REP_HG; ++rp) hgrn_chain(p, lds, tid2, lane2, wave, t >> 3, (t >> 1) & 3, t & 1);
                asm volatile("s_waitcnt vmcnt(0)" ::: "memory"); __syncthreads();
                if (threadIdx.x == 0) { __builtin_amdgcn_fence(__ATOMIC_RELEASE, "agent"); asm volatile("s_waitcnt vmcnt(0)" ::: "memory");
                    (void)xb_add((unsigned*)(p.ws + WS_CTL) + CW_HG + 16 * (t >> 3), 1u); } }
            else { const int oc = task - 192;
                for (int pm = oc; pm < NTOK / 256; pm += NGATE) gate_panel(p, lds, lane2, wave, pm);
                __syncthreads();
                { int lane3; asm volatile("v_mbcnt_lo_u32_b32 %0, -1, 0\n\tv_mbcnt_hi_u32_b32 %0, -1, %0" : "=v"(lane3)); const int tid3 = wave * 64 + lane3;
                  pg8::Gemm g{(const u16*)(p.ws + WS_U), (const u16*)(p.ws + WS_WIN), MROWS, ZLD, DM, DM, DM}; pg8::OgOrder S{oc, NGATE, NTOK / 256};
                  pg8::EpiZ E{(u16*)(p.ws + WS_Z), ZLD, (const float*)(p.ws + WS_LB), 0};
                  pg8::gemm_phase<pg8::EpiZ, pg8::OgOrder, true, true>(lds, g, S, E, tid3); }
                asm volatile("s_waitcnt vmcnt(0)" ::: "memory"); __syncthreads();
                for (int pm = oc; pm < NTOK / 256; pm += NGATE) {
                    if (threadIdx.x == 0) { unsigned* cnt = (unsigned*)(p.ws + WS_CTL) + CW_HG + 16 * (pm >> 5); unsigned* bar = (unsigned*)(p.ws + WS_CTL) + CW_BAR;
                        XB_SPIN(xb_ld(cnt) < 8u, bar);
                        __builtin_amdgcn_fence(__ATOMIC_ACQUIRE, "agent"); asm volatile("s_waitcnt vmcnt(0)" ::: "memory"); }
                    __syncthreads();
                    int lane3; asm volatile("v_mbcnt_lo_u32_b32 %0, -1, 0\n\tv_mbcnt_hi_u32_b32 %0, -1, %0" : "=v"(lane3));
                    hgrn_combine_panel(p, pm, lane3, wave);
                } }
            __syncthreads();
        }
    } SEAM(3);
    if (IN(4)) { PARAMS(); TID_LANE(); for (int pm = bid; pm < NTOK / 256; pm += G) combine_panel(p, pm, launder(lane), wave); } SEAM(4);
    if (IN(5)) { PARAMS(); TID_LANE();
        pg8::Gemm g{(const u16*)p.out, (const u16*)(p.ws + WS_WOUT), NTOK, DM, DM, DM, DM, (long)((const char*)(p.ws + WS_YY) - (const char*)p.out), 8};   pg8::StaticOrder S; S.init(NTOK, DM, G, bid);
        int bl = -1; bool same = true; { pg8::Unit u0; if (S.next(0, u0)) bl = u0.pm >> 5; for (int i = 1; S.next(i, u0); ++i) same = same && ((u0.pm >> 5) == bl); }
        { LAS float* w = (LAS float*)(lds + EPI_OFF); const float* gg = (const float*)(p.ws + WS_MOD) + 2048 + (size_t)(bl < 0 ? 0 : bl) * 6144; for (int i = tid; i < 1024; i += NWAVES * 64) w[i] = gg[i]; __syncthreads(); }
        if (same) { pg8::EpiGate<true> E{(u16*)(p.ws + WS_VL), DM, (const float*)(p.ws + WS_MOD) + 2048, (const LAS float*)(lds + EPI_OFF)};
            for (int rp = 0; rp < REP_OUT; ++rp) pg8::gemm_phase<pg8::EpiGate<true>, pg8::StaticOrder, true, true>(lds, g, S, E, launder(tid)); }
        else { pg8::EpiGate<false> E{(u16*)(p.ws + WS_VL), DM, (const float*)(p.ws + WS_MOD) + 2048, (const LAS float*)(lds + EPI_OFF)};
            pg8::gemm_phase<pg8::EpiGate<false>, pg8::StaticOrder, true, true>(lds, g, S, E, launder(tid)); }
    } SEAM(5);
    if (IN(6)) { PARAMS(); TID_LANE(); for (int rp = 0; rp < REP_LN1; ++rp) for (int pm = bid; pm < NTOK / 256; pm += G) ln1_panel(p, pm, launder(lane), wave); } SEAM(6);
    if (IN(7)) { PARAMS(); TID_LANE();
        pg8::Gemm g{(const u16*)(p.ws + WS_U), (const u16*)(p.ws + WS_WGU), NTOK, 2 * DFF, DM, DM, DM}; pg8::StaticOrder S; S.init(NTOK, 2 * DFF, G, bid);
        pg8::EpiGU E{(u16*)(p.ws + WS_Z), ZLD};
        for (int rp = 0; rp < REP_GU; ++rp) pg8::gemm_phase<pg8::EpiGU, pg8::StaticOrder, true, true>(lds, g, S, E, launder(tid));
#ifdef PROBE_GUNULL
        { pg8::EpiNull E0; pg8::gemm_phase<pg8::EpiNull, pg8::StaticOrder, true, true>(lds, g, S, E0, launder(tid)); }
#endif
#ifdef PROBE_XN
        { pg8::EpiNull E0; pg8::Gemm gx{(const u16*)(p.ws + WS_U), (const u16*)(p.ws + PROBE_XB), PROBE_XM, PROBE_XN, DM, DM, DM}; pg8::StaticOrder Sx; Sx.init(PROBE_XM, PROBE_XN, G, bid, PROBE_XW); pg8::gemm_phase<pg8::EpiNull, pg8::StaticOrder, true, true>(lds, gx, Sx, E0, launder(tid)); }
#endif
    } SEAM(7);
    if (IN(8)) { PARAMS(); TID_LANE();
        pg8::Gemm g{(const u16*)(p.ws + WS_Z), (const u16*)(p.ws + WS_WD), NTOK, DM, DFF, ZLD, DFF}; pg8::StaticOrder S; S.init(NTOK, DM, G, bid);
        int bl = -1; bool same = true; { pg8::Unit u0; if (S.next(0, u0)) bl = u0.pm >> 5; for (int i = 1; S.next(i, u0); ++i) same = same && ((u0.pm >> 5) == bl); }
        { LAS float* w = (LAS float*)(lds + EPI_OFF); const float* gg = (const float*)(p.ws + WS_MOD) + 5120 + (size_t)(bl < 0 ? 0 : bl) * 6144; for (int i = tid; i < 1024; i += NWAVES * 64) w[i] = gg[i]; __syncthreads(); }
        if (same) { pg8::EpiGate<true> E{(u16*)(p.ws + WS_VL), DM, (const float*)(p.ws + WS_MOD) + 5120, (const LAS float*)(lds + EPI_OFF)};
            for (int rp = 0; rp < REP_DOWN; ++rp) pg8::gemm_phase<pg8::EpiGate<true>, pg8::StaticOrder, true, true>(lds, g, S, E, launder(tid)); }
        else { pg8::EpiGate<false> E{(u16*)(p.ws + WS_VL), DM, (const float*)(p.ws + WS_MOD) + 5120, (const LAS float*)(lds + EPI_OFF)};
            pg8::gemm_phase<pg8::EpiGate<false>, pg8::StaticOrder, true, true>(lds, g, S, E, launder(tid)); }
    } SEAM(8);
    if (IN(9)) { PARAMS(); TID_LANE(); for (int pm = bid; pm < NTOK / 256; pm += G) ln2_panel(p, pm, launder(lane), wave);
#ifdef DBG_TSTAGE
        if (bid == 0 && tid == 0) { asm volatile("s_waitcnt vmcnt(0)" ::: "memory"); p.out[0] += ((const float*)(p.ws + WS_CTL))[8192]; }
#endif
    }
#undef IN
#undef SEAM
}

extern "C" void kernel_launch(void* const* d_in, const int* in_sizes, int n_in, void* d_out, int out_size, void* d_ws, size_t ws_size, hipStream_t stream) {
    static int grid = 0;
    if (grid == 0) {
        if (n_in != 28 || in_sizes[0] != NTOK * DM || out_size != NTOK * DM || ws_size < WS_END) { fprintf(stderr, "kernel_launch: unexpected shapes: n_in %d in0 %d out %d ws %zu (need %zu)\n", n_in, n_in > 0 ? in_sizes[0] : -1, out_size, ws_size, (size_t)WS_END); grid = -1; return; }
        int dev = 0, cus = 0, per_cu = 0;
        if (hipGetDevice(&dev) != hipSuccess || hipDeviceGetAttribute(&cus, hipDeviceAttributeMultiprocessorCount, dev) != hipSuccess) { grid = -1; return; }
        if (hipFuncSetAttribute((const void*)mega_fwd, hipFuncAttributeMaxDynamicSharedMemorySize, LDS_BYTES) != hipSuccess) { fprintf(stderr, "kernel_launch: hipFuncSetAttribute failed\n"); grid = -1; return; }
        if (hipOccupancyMaxActiveBlocksPerMultiprocessor(&per_cu, (const void*)mega_fwd, NWAVES * 64, LDS_BYTES) != hipSuccess || per_cu < 1) { fprintf(stderr, "kernel_launch: occupancy query says %d blocks per CU\n", per_cu); (void)hipGetLastError(); grid = -1; return; }
        grid = cus;
    }
    if (grid < 0) return;
    Params p{};
    const float** pp = (const float**)&p;
    for (int i = 0; i < 28; ++i) pp[i] = (const float*)d_in[i];
    p.out = (float*)d_out; p.ws = (unsigned char*)d_ws;
#if N_LAUNCHES == 1
    if (hipMemsetAsync((char*)d_ws + WS_CTL, 0, CTL_ZERO_BYTES, stream) != hipSuccess) { fprintf(stderr, "kernel_launch: memset failed\n"); return; }
    hipLaunchKernelGGL(mega_fwd, dim3(grid), dim3(NWAVES * 64), LDS_BYTES, stream, p, 0, 10);
#else
    for (int ph = 0; ph < 10; ++ph) hipLaunchKernelGGL(mega_fwd, dim3(grid), dim3(NWAVES * 64), LDS_BYTES, stream, p, ph, ph + 1);
#endif
}
```

```cpp
#include <hip/hip_runtime.h>
#include <cstdio>
#include <cstdint>

namespace pg8 {
#define PG8_LAS __attribute__((address_space(3)))
#define PG8_GAS __attribute__((address_space(1)))
typedef unsigned short bf16_t;
typedef short bf16x8 __attribute__((ext_vector_type(8)));
typedef float f32x4 __attribute__((ext_vector_type(4)));
typedef unsigned u32x4 __attribute__((ext_vector_type(4)));
constexpr int BM = 256, BK = 64, HALF = 128, HTB = HALF * BK * 2, STAGE_BYTES = 8 * HTB, NXCD = 8, WGM = 8;

__host__ __device__ __forceinline__ int lds_byte(int r, int c) { const int st = (r >> 4) * 2 + (c >> 5), rr = r & 15, cc = c & 31, ob = rr * 64 + cc * 2; return st * 1024 + (ob ^ (((ob >> 9) & 1) << 5)); }
__host__ __device__ __forceinline__ void stage_rc(int b, int& R, int& C) { const int st = b / 1024, sb = b % 1024, swz = sb ^ (((sb >> 9) & 1) << 5); R = (st >> 1) * 16 + swz / 64; C = (st & 1) * 32 + (swz % 64) / 2; }
__host__ __device__ __forceinline__ int perm32(int rho) { const int n = rho >> 4, i = rho & 15; return 8 * (i >> 2) + 4 * n + (i & 3); }

struct Unit { int pm, pn; };
struct Gemm { const bf16_t* A; const bf16_t* Bt; int M, N, K, lda, ldb; long adelta; int ksplit; };

struct StaticOrder {
    int nM, nN, nwg, G, c, wgm, gap_at, gap;
    __host__ __device__ void init(int M, int N, int G_, int c_, int wgm_ = WGM) { nM = M / BM; nN = N / BM; nwg = nM * nN; G = G_; c = c_; wgm = wgm_; gap_at = 1 << 30; gap = 0; }
    __host__ __device__ bool next(int i, Unit& u) const {
        const long L = (long)i * G + c; if (L >= nwg) return false;
        int wgid = (int)L; { const int q = nwg / NXCD, r = nwg % NXCD, xcd = wgid % NXCD, off = wgid / NXCD; wgid = (xcd < r ? xcd * (q + 1) : r * (q + 1) + (xcd - r) * q) + off; }
        const int nig = wgm * nN, gid = wgid / nig, fm = gid * wgm, gsz = (nM - fm) < wgm ? (nM - fm) : wgm;
        u.pm = fm + ((wgid % nig) % gsz); u.pn = (wgid % nig) / gsz; if (u.pn >= gap_at) u.pn += gap; return true;
    }
    __device__ __forceinline__ void a_ready(const Unit&) const {}
    __device__ __forceinline__ void done(const Unit&) const {}
};
struct OgOrder {
    int c, G, nM;
    __device__ __forceinline__ bool next(int i, Unit& u) const { const int pm = c + G * (i >> 1); if (pm >= nM) return false; u.pm = pm; u.pn = 8 + (i & 1); return true; }
    __device__ __forceinline__ void a_ready(const Unit&) const {}
    __device__ __forceinline__ void done(const Unit&) const {}
};
struct InProjOrder {
    int c, G, nx, nN, nctx;
    __device__ __forceinline__ bool next(int i, Unit& u) const {
        const int npan = c < nx ? (nx - c + G - 1) / G : 0;
        if (i < nN * npan) { u.pm = c + G * (i / nN); u.pn = i % nN; return true; }
        const int j = c + G * (i - nN * npan); if (j >= nctx) return false;
        u.pm = nx + j / nN; u.pn = j % nN; return true;
    }
    __device__ __forceinline__ void a_ready(const Unit&) const {}
    __device__ __forceinline__ void done(const Unit&) const {}
};
struct PanelOrder {
    int pm, n;
    __device__ __forceinline__ bool next(int i, Unit& u) const { if (i >= n) return false; u.pm = pm; u.pn = i; return true; }
    __device__ __forceinline__ void a_ready(const Unit&) const {}
    __device__ __forceinline__ void done(const Unit&) const {}
};
typedef float f32x2_t __attribute__((ext_vector_type(2))); typedef __bf16 bf16x2_t __attribute__((ext_vector_type(2)));
__device__ __forceinline__ unsigned cvt_pk_bf16(float lo, float hi) { const f32x2_t v = {lo, hi}; const bf16x2_t b = __builtin_convertvector(v, bf16x2_t); return __builtin_bit_cast(unsigned, b); }
__device__ __forceinline__ float sigm(float x) { return __builtin_amdgcn_rcpf(1.0f + __expf(-x)); }
__device__ __forceinline__ unsigned pk_f16(float lo, float hi) { const _Float16 a = (_Float16)lo, b = (_Float16)hi; return (unsigned)__builtin_bit_cast(unsigned short, a) | ((unsigned)__builtin_bit_cast(unsigned short, b) << 16); }

struct EpiZ {
    static constexpr bool PERM = true, AFTER_DRAIN = false; static constexpr int NVM = 16;
    bf16_t* Z; int ldz; const float* lb; int force_raw;
    __device__ __forceinline__ void operator()(const f32x4 (&acc)[2][2][4][2], const Unit& u, int wr, int wc, int fr, int fq) const {
        const int row0 = u.pm * BM + wr * 64 + fr, col0 = u.pn * BM + wc * 32 + 8 * fq;
        const int mode = force_raw ? 0 : ((u.pn < 2 || u.pn == 8 || u.pn == 9) ? 1 : ((u.pn >= 2 && u.pn < 6) ? 2 : 0));
#ifdef PROBE_P1RAW
        if (force_raw == 5) {
#pragma unroll
            for (int ai = 0; ai < 2; ++ai)
#pragma unroll
                for (int m = 0; m < 4; ++m)
#pragma unroll
                    for (int bj = 0; bj < 2; ++bj) { const f32x4 v0 = acc[ai][bj][m][0], v1 = acc[ai][bj][m][1]; u32x4 w;
                        w.x = cvt_pk_bf16(v0[0], v0[1]); w.y = cvt_pk_bf16(v0[2], v0[3]); w.z = cvt_pk_bf16(v1[0], v1[1]); w.w = cvt_pk_bf16(v1[2], v1[3]);
                        *(u32x4*)(Z + (size_t)(row0 + ai * HALF + m * 16) * 1792 + (u.pn % 7) * 256 + wc * 64 + bj * 32 + 8 * fq) = w; }
            return;
        }
#endif
#pragma unroll
        for (int bj = 0; bj < 2; ++bj) {
#pragma unroll
            for (int ai = 0; ai < 2; ++ai)
#pragma unroll
                for (int m = 0; m < 4; ++m) {
                    f32x4 v0 = acc[ai][bj][m][0], v1 = acc[ai][bj][m][1]; u32x4 w;
                    if (mode == 1) {
#pragma unroll
                        for (int e = 0; e < 4; ++e) { v0[e] = v0[e] * sigm(v0[e]); v1[e] = v1[e] * sigm(v1[e]); }
                    }
                    if (mode == 2) { w.x = pk_f16(v0[0], v0[1]); w.y = pk_f16(v0[2], v0[3]); w.z = pk_f16(v1[0], v1[1]); w.w = pk_f16(v1[2], v1[3]); }
                    else { w.x = cvt_pk_bf16(v0[0], v0[1]); w.y = cvt_pk_bf16(v0[2], v0[3]); w.z = cvt_pk_bf16(v1[0], v1[1]); w.w = cvt_pk_bf16(v1[2], v1[3]); }
#ifdef PROBE_P1RAW
                    if (force_raw == 3) *(u32x4*)(Z + (size_t)(u.pn % 7) * (67584 * 256) + (size_t)(row0 + ai * HALF + m * 16) * 256 + wc * 32 + 8 * fq + bj * HALF) = w;
                    else if (force_raw == 4) *(u32x4*)(Z + (size_t)(row0 + ai * HALF + m * 16) * 1792 + (u.pn % 7) * 256 + wc * 32 + 8 * fq + bj * HALF) = w;
                    else
#endif
                    __builtin_nontemporal_store(w, (u32x4*)(Z + (size_t)(row0 + ai * HALF + m * 16) * ldz + col0 + bj * HALF));
                }
        }
    }
};
struct EpiNull {
    static constexpr bool PERM = true, AFTER_DRAIN = false; static constexpr int NVM = 0;
    __device__ __forceinline__ void operator()(const f32x4 (&acc)[2][2][4][2], const Unit& u, int wr, int wc, int fr, int fq) const {
#pragma unroll
        for (int ai = 0; ai < 2; ++ai)
#pragma unroll
            for (int bj = 0; bj < 2; ++bj)
#pragma unroll
                for (int m = 0; m < 4; ++m)
#pragma unroll
                    for (int n = 0; n < 2; ++n) asm volatile("" :: "v"(acc[ai][bj][m][n]));
    }
};
struct EpiGU {
    static constexpr bool PERM = true, AFTER_DRAIN = false; static constexpr int NVM = 8;
    bf16_t* H; int ldh;
    __device__ __forceinline__ void operator()(const f32x4 (&acc)[2][2][4][2], const Unit& u, int wr, int wc, int fr, int fq) const {
        const int row0 = u.pm * BM + wr * 64 + fr, col0 = u.pn * HALF + wc * 32 + 8 * fq;
#pragma unroll
        for (int ai = 0; ai < 2; ++ai)
#pragma unroll
            for (int m = 0; m < 4; ++m) {
                f32x4 g0 = acc[ai][0][m][0], g1 = acc[ai][0][m][1]; const f32x4 u0 = acc[ai][1][m][0], u1 = acc[ai][1][m][1];
#pragma unroll
                for (int e = 0; e < 4; ++e) { g0[e] = g0[e] * sigm(g0[e]) * u0[e]; g1[e] = g1[e] * sigm(g1[e]) * u1[e]; }
                u32x4 w; w.x = cvt_pk_bf16(g0[0], g0[1]); w.y = cvt_pk_bf16(g0[2], g0[3]); w.z = cvt_pk_bf16(g1[0], g1[1]); w.w = cvt_pk_bf16(g1[2], g1[3]);
                *(PG8_GAS u32x4*)(H + (size_t)(row0 + ai * HALF + m * 16) * ldh + col0) = w;
            }
    }
};
template <bool LOC>
struct EpiGate {
    static constexpr bool PERM = true, AFTER_DRAIN = false; static constexpr int NVM = 16;
    bf16_t* F; int ldf; const float* gate0;
    const PG8_LAS float* gl;
    __device__ __forceinline__ void operator()(const f32x4 (&acc)[2][2][4][2], const Unit& u, int wr, int wc, int fr, int fq) const {
        const int row0 = u.pm * BM + wr * 64 + fr, col0 = u.pn * BM + wc * 32 + 8 * fq;
        const float* gate = gate0 + (size_t)(u.pm >> 5) * 6144;
#pragma unroll
        for (int bj = 0; bj < 2; ++bj) {
            f32x4 g0, g1;
            if (LOC) { g0 = *(const PG8_LAS f32x4*)(gl + col0 + bj * HALF); g1 = *(const PG8_LAS f32x4*)(gl + col0 + bj * HALF + 4); }
            else { g0 = *(const PG8_GAS f32x4*)(gate + col0 + bj * HALF); g1 = *(const PG8_GAS f32x4*)(gate + col0 + bj * HALF + 4); }
#pragma unroll
            for (int ai = 0; ai < 2; ++ai)
#pragma unroll
                for (int m = 0; m < 4; ++m) { const f32x4 v0 = acc[ai][bj][m][0] * g0, v1 = acc[ai][bj][m][1] * g1;
                    u32x4 w; w.x = cvt_pk_bf16(v0[0], v0[1]); w.y = cvt_pk_bf16(v0[2], v0[3]); w.z = cvt_pk_bf16(v1[0], v1[1]); w.w = cvt_pk_bf16(v1[2], v1[3]);
                    *(PG8_GAS u32x4*)(F + (size_t)(row0 + ai * HALF + m * 16) * ldf + col0 + bj * HALF) = w; } }
    }
};

template <class Epi, class Sched, bool ALIGN_EPI = false, bool SP2 = false>
__device__ __forceinline__ void gemm_phase(PG8_LAS unsigned char* lds, const Gemm g, const Sched& S, const Epi& E, const int tid) {
    const int wid = __builtin_amdgcn_readfirstlane(tid >> 6), lane = tid & 63, wr = wid >> 2, wc = wid & 3, fr = lane & 15, fq = lane >> 4;
    const int K = g.K, nt = K / BK;
    unsigned voffA[2], voffB[2];
#pragma unroll
    for (int i = 0; i < 2; ++i) { int R, C; stage_rc(tid * 16 + i * 8192, R, C); const int Rb = Epi::PERM ? ((R & ~31) + perm32(R & 31)) : R;
        voffA[i] = (unsigned)(R * g.lda + C) * 2u; voffB[i] = (unsigned)(Rb * g.ldb + C) * 2u; }
    const size_t kstep = (size_t)(BK * 2);
    const size_t hstepA = (size_t)HALF * g.lda * 2, hstepB = (size_t)HALF * g.ldb * 2;
    const size_t tstepA = 2 * hstepA, tstepB = 2 * hstepB;
    const unsigned ldsw = (unsigned)wid * 1024u;
    const int aoff = lds_byte(wr * 64 + fr, fq * 8), boff = lds_byte(wc * 32 + fr, fq * 8);
#define PG8_SA(b, h) (((b) * 2 + (h)) * HTB)
#define PG8_SB(b, h) ((4 + (b) * 2 + (h)) * HTB)
#define PG8_STAGE(bufoff, gbase, voff) do { _Pragma("unroll") for (int _i = 0; _i < 2; ++_i) \
        __builtin_amdgcn_global_load_lds((const unsigned*)((const char*)(gbase) + (voff)[_i]), (PG8_LAS unsigned*)(lds + (bufoff) + ldsw + _i * 8192), 16, 0, 0); } while (0)
#define PG8_LDA(dst, b, h) do { _Pragma("unroll") for (int m = 0; m < 4; ++m) _Pragma("unroll") for (int k = 0; k < 2; ++k) dst[m][k] = *(const PG8_LAS bf16x8*)(lds + PG8_SA(b, h) + aoff + m * 2048 + k * 1024); } while (0)
#define PG8_LDB(dst, b, h) do { _Pragma("unroll") for (int n = 0; n < 2; ++n) _Pragma("unroll") for (int k = 0; k < 2; ++k) dst[n][k] = *(const PG8_LAS bf16x8*)(lds + PG8_SB(b, h) + boff + n * 2048 + k * 1024); } while (0)
#define PG8_MMA(ai, bj, At, Bt) do { __builtin_amdgcn_s_setprio(1); _Pragma("unroll") for (int m = 0; m < 4; ++m) _Pragma("unroll") for (int n = 0; n < 2; ++n) _Pragma("unroll") for (int k = 0; k < 2; ++k) \
        acc[ai][bj][m][n] = __builtin_amdgcn_mfma_f32_16x16x32_bf16(Bt[n][k], At[m][k], acc[ai][bj][m][n], 0, 0, 0); __builtin_amdgcn_s_setprio(0); } while (0)
#define PG8_WAIT_V(n) asm volatile("s_waitcnt vmcnt(" #n ")" ::: "memory")
#define PG8_WAIT_L(n) asm volatile("s_waitcnt lgkmcnt(" #n ")" ::: "memory")
#define PG8_BAR __builtin_amdgcn_s_barrier()
#define PG8_SCHED __builtin_amdgcn_sched_barrier(0)
    Unit cur, nxt; int ui = 0;
    bool pe = false;
#define PG8_WAIT_VN(n) asm volatile("s_waitcnt vmcnt(%0)" :: "n"(n) : "memory")
    if (!S.next(0, cur)) return;
    f32x4 acc[2][2][4][2];
#pragma unroll
    for (int a = 0; a < 2; ++a)
#pragma unroll
        for (int b = 0; b < 2; ++b)
#pragma unroll
            for (int m = 0; m < 4; ++m)
#pragma unroll
                for (int n = 0; n < 2; ++n) acc[a][b][m][n] = (f32x4){0.f, 0.f, 0.f, 0.f};
    bf16x8 At[4][2], B0[2][2], B1[2][2];
    const char* cA = (const char*)g.A + (size_t)cur.pm * tstepA; const char* cB = (const char*)g.Bt + (size_t)cur.pn * tstepB;
    S.a_ready(cur);
    if constexpr (SP2) {
        PG8_STAGE(PG8_SB(0, 0), cB, voffB); PG8_STAGE(PG8_SB(0, 1), cB + hstepB, voffB); PG8_STAGE(PG8_SA(0, 0), cA, voffA); PG8_STAGE(PG8_SA(0, 1), cA + hstepA, voffA);
        if (wr == 1) PG8_BAR;
        PG8_WAIT_V(2); PG8_BAR;
        PG8_STAGE(PG8_SB(1, 0), cB + kstep, voffB); PG8_STAGE(PG8_SA(1, 0), cA + kstep, voffA); PG8_STAGE(PG8_SB(1, 1), cB + hstepB + kstep, voffB);
        PG8_WAIT_V(6); PG8_BAR;
    } else {
        PG8_STAGE(PG8_SB(0, 0), cB, voffB); PG8_STAGE(PG8_SA(0, 0), cA, voffA); PG8_STAGE(PG8_SB(0, 1), cB + hstepB, voffB); PG8_STAGE(PG8_SA(0, 1), cA + hstepA, voffA);
        if (wr == 1) PG8_BAR;
        PG8_WAIT_V(4); PG8_BAR;
        PG8_STAGE(PG8_SB(1, 0), cB + kstep, voffB); PG8_STAGE(PG8_SA(1, 0), cA + kstep, voffA); PG8_STAGE(PG8_SB(1, 1), cB + hstepB + kstep, voffB);
        PG8_WAIT_V(6); PG8_BAR;
    }
    for (;;) {
        const bool has_next = S.next(ui + 1, nxt);
        const char* nA = has_next ? (const char*)g.A + (size_t)nxt.pm * tstepA : cA; const char* nB = has_next ? (const char*)g.Bt + (size_t)nxt.pn * tstepB : cB;
        for (int t = 0; t < nt; t += 2) {
            const bool last = (t == nt - 2);
            const long ad1 = t >= g.ksplit ? g.adelta : 0, ad2 = t + 2 >= g.ksplit ? g.adelta : 0;
            const char* a1 = cA + (size_t)(t + 1) * kstep + ad1;
            const char* a2 = last ? nA : cA + (size_t)(t + 2) * kstep + ad2; const char* b2 = last ? nB : cB + (size_t)(t + 2) * kstep;
            const char* a3 = a2 + kstep; const char* b3 = b2 + kstep;
            if (last && has_next) S.a_ready(nxt);
            if constexpr (SP2) {
            int pef = __builtin_amdgcn_readfirstlane((pe && t == 0) ? 1 : 0); asm volatile("" : "+s"(pef)); const bool pe0 = pef != 0;
            PG8_LDB(B0, 0, 0); PG8_LDB(B1, 0, 1); PG8_SCHED; PG8_LDA(At, 0, 0); if (!pe0) PG8_STAGE(PG8_SA(1, 1), a1 + hstepA, voffA);
            if (pe0) PG8_WAIT_VN(8 + Epi::NVM); else PG8_WAIT_V(8);
            PG8_WAIT_L(0); PG8_BAR; PG8_MMA(0, 0, At, B0); PG8_MMA(0, 1, At, B1); PG8_BAR; PG8_SCHED;
            PG8_LDA(At, 0, 1); PG8_STAGE(PG8_SB(0, 0), b2, voffB); PG8_STAGE(PG8_SB(0, 1), b2 + hstepB, voffB); PG8_STAGE(PG8_SA(0, 0), a2, voffA);
            if (pe0) PG8_WAIT_VN(8 + Epi::NVM); else PG8_WAIT_V(8);
            PG8_WAIT_L(0); PG8_BAR; PG8_MMA(1, 0, At, B0); PG8_MMA(1, 1, At, B1); PG8_BAR; PG8_SCHED;
            PG8_LDB(B0, 1, 0); PG8_LDB(B1, 1, 1); PG8_SCHED; PG8_LDA(At, 1, 0); PG8_STAGE(PG8_SA(0, 1), a2 + hstepA, voffA);
            if (pe0) PG8_WAIT_VN(8 + Epi::NVM); else PG8_WAIT_V(8);
            PG8_WAIT_L(0); PG8_BAR; PG8_MMA(0, 0, At, B0); PG8_MMA(0, 1, At, B1); PG8_BAR; PG8_SCHED;
            PG8_LDA(At, 1, 1); PG8_STAGE(PG8_SB(1, 0), b3, voffB); PG8_STAGE(PG8_SB(1, 1), b3 + hstepB, voffB); PG8_STAGE(PG8_SA(1, 0), a3, voffA);
            PG8_WAIT_V(8); PG8_WAIT_L(0); PG8_BAR; PG8_MMA(1, 0, At, B0); PG8_MMA(1, 1, At, B1); PG8_BAR; PG8_SCHED;
            } else {
            PG8_LDB(B0, 0, 0); PG8_SCHED; PG8_LDA(At, 0, 0); PG8_STAGE(PG8_SA(1, 1), a1 + hstepA, voffA);
            PG8_WAIT_L(8); PG8_BAR; PG8_WAIT_L(0); PG8_MMA(0, 0, At, B0); PG8_BAR; PG8_SCHED;
            PG8_LDB(B1, 0, 1); PG8_STAGE(PG8_SB(0, 0), b2, voffB);
            PG8_BAR; PG8_WAIT_L(0); PG8_MMA(0, 1, At, B1); PG8_BAR;
            PG8_LDA(At, 0, 1); PG8_STAGE(PG8_SA(0, 0), a2, voffA);
            PG8_BAR; PG8_WAIT_L(0); PG8_MMA(1, 0, At, B0); PG8_BAR; PG8_SCHED;
            PG8_STAGE(PG8_SB(0, 1), b2 + hstepB, voffB);
            PG8_WAIT_V(6); PG8_BAR; PG8_MMA(1, 1, At, B1); PG8_BAR;
            PG8_LDB(B0, 1, 0); PG8_SCHED; PG8_LDA(At, 1, 0); PG8_STAGE(PG8_SA(0, 1), a2 + hstepA, voffA);
            PG8_WAIT_L(8); PG8_BAR; PG8_WAIT_L(0); PG8_MMA(0, 0, At, B0); PG8_BAR; PG8_SCHED;
            PG8_LDB(B1, 1, 1); PG8_STAGE(PG8_SB(1, 0), b3, voffB);
            PG8_BAR; PG8_WAIT_L(0); PG8_MMA(0, 1, At, B1); PG8_BAR;
            PG8_LDA(At, 1, 1); PG8_STAGE(PG8_SA(1, 0), a3, voffA);
            PG8_BAR; PG8_WAIT_L(0); PG8_MMA(1, 0, At, B0); PG8_BAR; PG8_SCHED;
            PG8_STAGE(PG8_SB(1, 1), b3 + hstepB, voffB);
            PG8_WAIT_V(6); PG8_BAR; PG8_MMA(1, 1, At, B1); PG8_BAR;
            }
        }
        if constexpr (SP2) { if (has_next) { PG8_STAGE(PG8_SA(1, 1), nA + kstep + hstepA, voffA); pe = true; } }
        if constexpr (ALIGN_EPI) { if (wr == 0) PG8_BAR; }
        if constexpr (!Epi::AFTER_DRAIN) { E(acc, cur, wr, wc, fr, fq); S.done(cur); }
        if (!has_next) break;
#pragma unroll
        for (int a = 0; a < 2; ++a)
#pragma unroll
            for (int b = 0; b < 2; ++b)
#pragma unroll
                for (int m = 0; m < 4; ++m)
#pragma unroll
                    for (int n = 0; n < 2; ++n) acc[a][b][m][n] = (f32x4){0.f, 0.f, 0.f, 0.f};
        cur = nxt; cA = nA; cB = nB; ++ui;
        if constexpr (ALIGN_EPI) { if (wr == 1) PG8_BAR; }
    }
    PG8_WAIT_V(0);
    if constexpr (!ALIGN_EPI) { if (wr == 0) PG8_BAR; }
    PG8_BAR;
    if constexpr (Epi::AFTER_DRAIN) { E.fused(acc, cur, wr, wc, fr, fq, lds, wid, lane); S.done(cur); }
#undef PG8_SA
#undef PG8_SB
#undef PG8_STAGE
#undef PG8_LDA
#undef PG8_LDB
#undef PG8_MMA
#undef PG8_WAIT_V
#undef PG8_WAIT_VN
#undef PG8_WAIT_L
#undef PG8_BAR
#undef PG8_SCHED
}
}

#define GAS __attribute__((address_space(1)))
#define LAS __attribute__((address_space(3)))
typedef unsigned short bf16;
typedef unsigned v4u __attribute__((ext_vector_type(4)));
typedef float f32x4 __attribute__((ext_vector_type(4)));
typedef short bf16x8 __attribute__((ext_vector_type(8)));
typedef GAS unsigned gu32;
typedef GAS unsigned long long gu64;
#define RLX_AGENT __ATOMIC_RELAXED, __HIP_MEMORY_SCOPE_AGENT
#define LDS_WAIT() asm volatile("s_waitcnt lgkmcnt(0)" ::: "memory")
#define VM_WAIT() asm volatile("s_waitcnt vmcnt(0)" ::: "memory")
__device__ __forceinline__ unsigned long long rt() { return __builtin_amdgcn_s_memrealtime(); }
__device__ __forceinline__ unsigned f2bf(float f) { unsigned u = __builtin_bit_cast(unsigned, f); return (u + 0x7fffu + ((u >> 16) & 1u)) >> 16; }
__device__ __forceinline__ unsigned pk2(float lo, float hi) { return f2bf(lo) | (f2bf(hi) << 16); }
#define XB_TMO      128
#define XB_XCNT(j)  (256  + 64 * (j))
#define XB_XSUB(j)  (1280 + 64 * (j))
#define XB_XGEN(j)  (2304 + 64 * (j))
#define XB_TOP      3328
#define XB_TOPGEN   3392
#define XCD_BAR_WORDS 3456
#define XB_SPIN_CAP (1u << 18)

__device__ __forceinline__ unsigned xb_ld(unsigned* p)              { return __hip_atomic_load(p, __ATOMIC_RELAXED, __HIP_MEMORY_SCOPE_AGENT); }
__device__ __forceinline__ unsigned xb_add(unsigned* p, unsigned v) { return __hip_atomic_fetch_add(p, v, __ATOMIC_RELAXED, __HIP_MEMORY_SCOPE_AGENT); }
__device__ __forceinline__ unsigned xb_xcc_id() { return (unsigned)__builtin_amdgcn_s_getreg((3 << 11) | 20) & 0xFu; }
#define XB_SPIN(cond, bar) do { unsigned _sp = 0; while (cond) { __builtin_amdgcn_s_sleep(1); \
    if ((++_sp & 255u) == 0u) { if (xb_ld(&(bar)[XB_TMO])) break; if (_sp > XB_SPIN_CAP) { atomicAdd(&(bar)[XB_TMO], 1u); break; } } } } while (0)

struct XcdBarrier {
    unsigned* bar; unsigned x;
    volatile LAS unsigned* st;
};

__device__ __forceinline__ XcdBarrier xcd_barrier_post(unsigned* bar, volatile LAS unsigned* st) {
    XcdBarrier b; b.bar = bar; b.x = xb_xcc_id(); b.st = st;
    if (threadIdx.x == 0) (void)xb_add(&bar[XB_XCNT(b.x)], 1u);
    return b;
}
__device__ __forceinline__ void xcd_barrier_complete(unsigned* bar, unsigned x, unsigned& nloc, unsigned& nx) {
    const unsigned G = gridDim.x * gridDim.y * gridDim.z;
    unsigned sum, cnt, mine, sp = 0u;
    for (;;) {
        sum = 0u; cnt = 0u; mine = 0u;
#pragma unroll
        for (unsigned j = 0; j < 16; ++j) { const unsigned c = xb_ld(&bar[XB_XCNT(j)]); sum += c; cnt += (c > 0u) ? 1u : 0u; mine = (j == x) ? c : mine; }
        if (sum == G) break;
        __builtin_amdgcn_s_sleep(1);
        if ((++sp & 255u) == 0u) { if (xb_ld(&bar[XB_TMO])) break; if (sp > XB_SPIN_CAP) { atomicAdd(&bar[XB_TMO], 1u); break; } }
    }
    nloc = mine > 0u ? mine : 1u; nx = cnt > 0u ? cnt : 1u;
}

__device__ __forceinline__ void xcd_barrier(const XcdBarrier& b) {
    asm volatile("s_waitcnt vmcnt(0)" ::: "memory");
    __syncthreads();
    if (threadIdx.x == 0) {
        unsigned* bar = b.bar;
        __builtin_amdgcn_s_waitcnt(0);
        unsigned nloc = b.st[0], nx = b.st[1];
        if (nloc == 0u) { xcd_barrier_complete(bar, b.x, nloc, nx); b.st[0] = nloc; b.st[1] = nx; }
        const unsigned old = xb_add(&bar[XB_XSUB(b.x)], 1u);
        const unsigned gen = old / nloc;
        if (old + 1u == (gen + 1u) * nloc) {
            __builtin_amdgcn_fence(__ATOMIC_RELEASE, "agent");
            asm volatile("s_waitcnt vmcnt(0)" ::: "memory");
            const unsigned og = xb_add(&bar[XB_TOP], 1u);
            const unsigned tg = og / nx;
            if (og + 1u == (tg + 1u) * nx) xb_add(&bar[XB_TOPGEN], 1u);
            else XB_SPIN(xb_ld(&bar[XB_TOPGEN]) == tg, bar);
            __builtin_amdgcn_fence(__ATOMIC_ACQUIRE, "agent");
            xb_add(&bar[XB_XGEN(b.x)], 1u);
            asm volatile("s_waitcnt vmcnt(0)" ::: "memory");
        } else {
            XB_SPIN(xb_ld(&bar[XB_XGEN(b.x)]) == gen, bar);
            __builtin_amdgcn_fence(__ATOMIC_ACQUIRE, "agent");
            asm volatile("s_waitcnt vmcnt(0)" ::: "memory");
        }
    }
    __syncthreads();
}
constexpr int NWAVES = 8;
constexpr int NB = 8, SEQ = 8192, DM = 1024, CTXL = 256;
constexpr int NTOK = NB * SEQ, NCTX = NB * CTXL, MROWS = NTOK + NCTX;
constexpr int ZLD = 4352, INCOLS = 4320, DFF = 2816;
constexpr int ZQ = 0, ZF = 512, ZI = 1536, ZOG = 2048, ZR = 2560;
constexpr float ALPHA = 1.189207115f;
constexpr size_t MiB = 1u << 20;
constexpr size_t WS_CTL = 0, CTL_ZERO_BYTES = 64 * 1024;
constexpr size_t WS_MOD = 1 * MiB, WS_LB = 1 * MiB + 256 * 1024, WS_W2T = 1 * MiB + 512 * 1024, WS_A2T = WS_W2T + 64 * 1024, WS_G2T = WS_A2T + 64 * 1024;
constexpr size_t WS_WIN = 2 * MiB, WS_WOUT = 11 * MiB, WS_WGU = 13 * MiB, WS_WD = 24 * MiB, WS_SB = 30 * MiB;
constexpr size_t WS_U = 34 * MiB, WS_Z = 166 * MiB, WS_YY = 727 * MiB, WS_VL = 855 * MiB, WS_G = 919 * MiB, WS_END = 983 * MiB;
constexpr int CW_HG = 8448;
constexpr int CW_BAR = 1024;
constexpr int LDS_BYTES = 159744, MISC_OFF = 157696, EPI_OFF = 131072;
static_assert(CW_BAR * 4 + 3456 * 4 <= (int)CTL_ZERO_BYTES, "ctl");

typedef unsigned short u16;
typedef float f32x16 __attribute__((ext_vector_type(16)));
typedef float f32x2 __attribute__((ext_vector_type(2)));
typedef short s16x4 __attribute__((ext_vector_type(4)));
typedef unsigned u32x2 __attribute__((ext_vector_type(2)));
#define MFMA32(a, b, c) __builtin_amdgcn_mfma_f32_32x32x16_bf16(a, b, c, 0, 0, 0)
#define BAR() __syncthreads()
#define LBAR() do { asm volatile("s_waitcnt lgkmcnt(0)" ::: "memory"); __builtin_amdgcn_s_barrier(); asm volatile("" ::: "memory"); } while (0)
__device__ __forceinline__ int launder(int v) { asm volatile("" : "+v"(v)); return v; }
__device__ __forceinline__ int fresh_tid(int wave) { int l; asm volatile("v_mbcnt_lo_u32_b32 %0, -1, 0\n\tv_mbcnt_hi_u32_b32 %0, -1, %0" : "=v"(l)); return wave * 64 + l; }
__device__ __forceinline__ unsigned char* launder_sp(unsigned char* q) { asm volatile("" : "+s"(q)); return q; }
__device__ __forceinline__ float sigm(float x) { return __builtin_amdgcn_rcpf(1.0f + __expf(-x)); }
__device__ __forceinline__ float dppf(float x, const int ctrl) { return x; }
#define DPP_ADD(x, ctrl) x += __builtin_bit_cast(float, __builtin_amdgcn_update_dpp(0, __builtin_bit_cast(int, x), ctrl, 0xF, 0xF, true))
__device__ __forceinline__ float sum8(float x) { DPP_ADD(x, 0xB1); DPP_ADD(x, 0x4E); DPP_ADD(x, 0x141); return x; }
__device__ __forceinline__ float sum16(float x) { DPP_ADD(x, 0xB1); DPP_ADD(x, 0x4E); DPP_ADD(x, 0x141); DPP_ADD(x, 0x140); return x; }
__device__ __forceinline__ float sum32(float x) { x = sum16(x); x += __builtin_bit_cast(float, __builtin_amdgcn_ds_swizzle(__builtin_bit_cast(int, x), 0x401F)); return x; }
__device__ __forceinline__ float bflo(unsigned u) { return __builtin_bit_cast(float, u << 16); }
__device__ __forceinline__ float bfhi(unsigned u) { return __builtin_bit_cast(float, u & 0xffff0000u); }
__device__ __forceinline__ unsigned pkbf(float lo, float hi) { return pg8::cvt_pk_bf16(lo, hi); }
__device__ __forceinline__ float h2f(unsigned short h) { return (float)__builtin_bit_cast(_Float16, h); }
__device__ __forceinline__ void unpack8(const v4u u, float (&f)[8]) { f[0] = bflo(u.x); f[1] = bfhi(u.x); f[2] = bflo(u.y); f[3] = bfhi(u.y); f[4] = bflo(u.z); f[5] = bfhi(u.z); f[6] = bflo(u.w); f[7] = bfhi(u.w); }
__device__ __forceinline__ int arow(int i, int h5) { return (i & 3) + 8 * (i >> 2) + 4 * h5; }
__device__ __forceinline__ bf16x8 frag_kc(const LAS u16* X, int ld, int idx0, int k0, int lane) {
    return *(const LAS bf16x8*)(X + (idx0 + (lane & 31)) * ld + k0 + 8 * (lane >> 5));
}
__device__ __forceinline__ bf16x8 frag_tr(const LAS u16* X, int ld, int idx0, int k0, int lane) {
    const int g = lane >> 4, q = (lane >> 2) & 3, p = lane & 3;
    const LAS u16* a = X + (k0 + 8 * (g >> 1) + q) * ld + idx0 + 16 * (g & 1) + 4 * p;
    const s16x4 lo = __builtin_bit_cast(s16x4, __builtin_amdgcn_ds_read_tr16_b64_v4i16((LAS s16x4*)a));
    const s16x4 hi = __builtin_bit_cast(s16x4, __builtin_amdgcn_ds_read_tr16_b64_v4i16((LAS s16x4*)(a + 4 * ld)));
    return (bf16x8){lo[0], lo[1], lo[2], lo[3], hi[0], hi[1], hi[2], hi[3]};
}
__device__ __forceinline__ void st_tile_T(LAS u16* D, int ld, int row0, int col0, const f32x16& a, int lane) {
    LAS u16* p = D + (col0 + (lane & 31)) * ld + row0 + 4 * (lane >> 5);
#pragma unroll
    for (int g = 0; g < 4; ++g) { u32x2 w; w.x = pkbf(a[4 * g], a[4 * g + 1]); w.y = pkbf(a[4 * g + 2], a[4 * g + 3]); *(LAS u32x2*)(p + 8 * g) = w; }
}
__device__ __forceinline__ f32x16 zero16() { f32x16 z;
#pragma unroll
    for (int i = 0; i < 16; ++i) z[i] = 0.f; return z; }

__device__ __forceinline__ void transpose_item(const float* W, int N, u16* WT, int ldw, int k0, int n0, int drow0, LAS float* scr, int lane) {
    float t[32];
#pragma unroll
    for (int i = 0; i < 32; ++i) { const int kk = 2 * i + (lane >> 5); t[i] = __builtin_nontemporal_load(W + (size_t)(k0 + kk) * N + n0 + (lane & 31)); }
#pragma unroll
    for (int i = 0; i < 32; ++i) { const int kk = 2 * i + (lane >> 5); scr[kk * 33 + (lane & 31)] = t[i]; }
    LDS_WAIT(); asm volatile("" ::: "memory");
    const int c = lane & 7;
#pragma unroll
    for (int j = 0; j < 4; ++j) { const int n = (lane >> 3) + 8 * j; const LAS float* s = scr + (8 * c) * 33 + n;
        v4u o; o.x = pkbf(s[0 * 33], s[1 * 33]); o.y = pkbf(s[2 * 33], s[3 * 33]); o.z = pkbf(s[4 * 33], s[5 * 33]); o.w = pkbf(s[6 * 33], s[7 * 33]);
        *(v4u*)(WT + (size_t)(drow0 + n) * ldw + k0 + 8 * c) = o; }
    LDS_WAIT(); asm volatile("" ::: "memory");
}
struct Params {
    const float *x, *c, *ctx, *c_ctx, *w_ada, *b_ada, *w_in, *lb_logits, *hg_norm_w, *mu, *w0, *w2, *a0, *a2, *g2, *kkw, *kaw, *rkw, *lnxw, *lnxb, *w_out, *ln1g, *ln1b, *wg, *wu, *wd, *ln2g, *ln2b;
    float* out; unsigned char* ws;
};
constexpr int WI_IN = 16 * 135, WI_OUT = 16 * 32, WI_G = 16 * 88, WI_D = 44 * 32, WI_ALL = WI_IN + WI_OUT + 2 * WI_G + WI_D;
__device__ __forceinline__ void weight_items(const Params& p, LAS unsigned char* lds, int lane, int wave, int gw, int NGW, int first, int last) {
    LAS float* scr = (LAS float*)(lds + 65536 + wave * 8704);
    u16* wint = (u16*)(p.ws + WS_WIN); u16* woutt = (u16*)(p.ws + WS_WOUT); u16* wgut = (u16*)(p.ws + WS_WGU); u16* wdt = (u16*)(p.ws + WS_WD);
    for (int it = first + gw; it < last; it += NGW) {
        int r = it;
        if (r < WI_IN) { const int kb = r / 135, nb = r % 135; transpose_item(p.w_in, INCOLS, wint, 1024, 64 * kb, 32 * nb, 32 * nb, scr, lane); continue; } r -= WI_IN;
        if (r < WI_OUT) { const int kb = r / 32, nb = r % 32; transpose_item(p.w_out, 1024, woutt, 1024, 64 * kb, 32 * nb, 32 * nb, scr, lane); continue; } r -= WI_OUT;
        if (r < WI_G) { const int kb = r / 88, nb = r % 88, n0 = 32 * nb; transpose_item(p.wg, DFF, wgut, 1024, 64 * kb, n0, 256 * (n0 >> 7) + (n0 & 127), scr, lane); continue; } r -= WI_G;
        if (r < WI_G) { const int kb = r / 88, nb = r % 88, n0 = 32 * nb; transpose_item(p.wu, DFF, wgut, 1024, 64 * kb, n0, 256 * (n0 >> 7) + 128 + (n0 & 127), scr, lane); continue; } r -= WI_G;
        { const int kb = r / 32, nb = r % 32; transpose_item(p.wd, 1024, wdt, DFF, 64 * kb, 32 * nb, 32 * nb, scr, lane); }
    }
}
__device__ __forceinline__ void phase0a(const Params& p, LAS unsigned char* lds, int tid, int lane, int wave, int bid, int G) {
    float* mod = (float*)(p.ws + WS_MOD);
    for (int cb = bid; cb < 192; cb += G) {
        LAS float* sc = (LAS float*)lds; LAS float* red = sc + 9 * 1024;
        for (int i = tid; i < 9 * 1024; i += 512) { const int b = i >> 10, d = i & 1023; const float xv = b < 8 ? p.c[b * 1024 + d] : p.c_ctx[d]; sc[i] = xv * sigm(xv); }
        BAR();
        const int cl = tid & 31, dq = tid >> 5, col = cb * 32 + cl;
        float acc[9];
#pragma unroll
        for (int b = 0; b < 9; ++b) acc[b] = 0.f;
#pragma unroll
        for (int hb = 0; hb < 2; ++hb) { float w[32];
#pragma unroll
            for (int j = 0; j < 32; ++j) w[j] = p.w_ada[(size_t)(dq * 64 + hb * 32 + j) * 6144 + col];
#pragma unroll
            for (int j = 0; j < 32; ++j) {
#pragma unroll
                for (int b = 0; b < 9; ++b) acc[b] += sc[b * 1024 + dq * 64 + hb * 32 + j] * w[j]; } }
#pragma unroll
        for (int b = 0; b < 9; ++b) red[(dq * 9 + b) * 32 + cl] = acc[b];
        BAR();
        if (tid < 288) { const int b = tid >> 5; float s = 0.f;
#pragma unroll
            for (int q = 0; q < 16; ++q) s += red[(q * 9 + b) * 32 + cl];
            mod[b * 6144 + col] = s + p.b_ada[col]; }
        BAR();
    }
    {
        float* lb = (float*)(p.ws + WS_LB); u16* w2t = (u16*)(p.ws + WS_W2T); u16* a2t = (u16*)(p.ws + WS_A2T); u16* g2t = (u16*)(p.ws + WS_G2T); u16* wint = (u16*)(p.ws + WS_WIN);
        const int gt = bid * 512 + tid, GT = G * 512;
        for (int i = gt; i < 1024; i += GT) lb[i] = sigm(p.lb_logits[i] - p.lb_logits[1024 + i]);
        for (int i = gt; i < 2 * 512 * 32; i += GT) { const int l = i & 31, c = (i >> 5) & 511, d = i >> 14; const float a = p.w2[(d * 32 + l) * 512 + c], b = p.a2[(d * 32 + l) * 512 + c];
            w2t[i] = (u16)(pkbf(a, 0.f) & 0xffffu); a2t[i] = (u16)(pkbf(b, 0.f) & 0xffffu); }
        for (int i = gt; i < 512 * 96; i += GT) { const int l = i % 96, c = i / 96; g2t[i] = (u16)(pkbf(p.g2[l * 512 + c], 0.f) & 0xffffu); }
        for (int i = gt; i < 32 * 1024 / 2; i += GT) ((unsigned*)(wint + (size_t)INCOLS * 1024))[i] = 0u;
    }
    {   const int NGW = G * NWAVES, gw = G == 256 ? (bid >= 192 ? (bid - 192) * NWAVES + wave : 512 + bid * NWAVES + wave) : bid * NWAVES + wave;
        weight_items(p, lds, lane, wave, gw, NGW, 0, WI_ALL); }
}
__device__ __forceinline__ float wave_sum(float v) { v = sum32(v); v += __shfl_xor(v, 32); return v; }
__device__ __forceinline__ void phase0b(const Params& p, int lane, int wave, int bid, int G) {
    const float* mod = (const float*)(p.ws + WS_MOD); u16* U = (u16*)(p.ws + WS_U);
    const int gw = bid * NWAVES + wave, NGW = G * NWAVES;
    constexpr int RB = 4;
    for (int mg = gw; mg < MROWS / RB; mg += NGW) {
        const int m0 = mg * RB;
        const float* xrow = m0 < NTOK ? p.x + (size_t)m0 * DM : p.ctx + (size_t)(m0 - NTOK) * DM;
        const int mb = m0 < NTOK ? (m0 >> 13) : 8;
        f32x4 v[RB][4]; float s[RB], mean[RB], rstd[RB];
#pragma unroll
        for (int q = 0; q < RB; ++q)
#pragma unroll
            for (int j = 0; j < 4; ++j) v[q][j] = __builtin_nontemporal_load((const f32x4*)(xrow + (size_t)q * DM) + lane + 64 * j);
#pragma unroll
        for (int q = 0; q < RB; ++q) { s[q] = 0.f;
#pragma unroll
            for (int j = 0; j < 4; ++j) s[q] += (v[q][j].x + v[q][j].y) + (v[q][j].z + v[q][j].w); }
#pragma unroll
        for (int q = 0; q < RB; ++q) mean[q] = wave_sum(s[q]) * (1.f / DM);
#pragma unroll
        for (int q = 0; q < RB; ++q) { s[q] = 0.f;
#pragma unroll
            for (int j = 0; j < 4; ++j) { v[q][j] = v[q][j] - mean[q]; s[q] += (v[q][j].x * v[q][j].x + v[q][j].y * v[q][j].y) + (v[q][j].z * v[q][j].z + v[q][j].w * v[q][j].w); } }
#pragma unroll
        for (int q = 0; q < RB; ++q) rstd[q] = 1.f / sqrtf(wave_sum(s[q]) * (1.f / DM) + 1e-6f);
#pragma unroll
        for (int j = 0; j < 4; ++j) { const f32x4 a = ((const f32x4*)(mod + mb * 6144))[lane + 64 * j], b = ((const f32x4*)(mod + mb * 6144 + 1024))[lane + 64 * j];
#pragma unroll
            for (int q = 0; q < RB; ++q) { const f32x4 r = v[q][j] * rstd[q] * (b + 1.0f) + a; u32x2 w; w.x = pkbf(r.x, r.y); w.y = pkbf(r.z, r.w); ((u32x2*)(U + (size_t)(m0 + q) * DM))[lane + 64 * j] = w; } }
    }
}
__device__ __forceinline__ void chain_chunk(int n, int dir, int b, bool& isctx, int& tbase, long& rowbase) {
    isctx = n < 4;
    if (isctx) { const int cc = dir ? 3 - n : n; tbase = cc * 64; rowbase = (long)NTOK + b * CTXL + tbase; }
    else { const int xc = dir ? 127 - (n - 4) : n - 4; tbase = xc * 64; rowbase = (long)b * SEQ + tbase; }
}
constexpr int HG_LD = 136;
constexpr int HG_QT = 0, HG_KT = 17408, HG_VV = 34816, HG_ST = 52224, HG_PT = 87040, HG_TOT = 96256, HG_EM = 100352, HG_EE = 100864, HG_DD = 101376;
__device__ __forceinline__ void hgrn_chain(const Params& p, LAS unsigned char* lds, int tid, int lane_in, int wave, int b, int h, int dir) {
    LAS u16* QT = (LAS u16*)(lds + HG_QT); LAS u16* KT = (LAS u16*)(lds + HG_KT); LAS u16* VV = (LAS u16*)(lds + HG_VV); LAS u16* ST = (LAS u16*)(lds + HG_ST); LAS u16* PT = (LAS u16*)(lds + HG_PT);
    LAS float* TOT = (LAS float*)(lds + HG_TOT); LAS float* EM = (LAS float*)(lds + HG_EM); LAS float* EE = (LAS float*)(lds + HG_EE); LAS float* DD = (LAS float*)(lds + HG_DD);
    const int kb = wave >> 1, vb0 = 2 * (wave & 1);
    const int oti = wave >> 2, ovi = wave & 3;
    f32x16 S0 = zero16(), S1 = zero16();
    unsigned pq_[8], pf_[8], pv_[8];
#define HG_LOAD(nn) do { bool ic_; int tb_; long rb_; chain_chunk((nn), dir, b, ic_, tb_, rb_); const int ln_ = fresh_tid(wave) & 63; \
        const char* zb_ = (const char*)(Z + rb_ * ZLD); \
        _Pragma("unroll") for (int i = 0; i < 8; ++i) { const int j = 8 * wave + i; const int off = (dir ? 63 - j : j) * (ZLD * 2) + (h * 128 + 2 * ln_) * 2; \
            pq_[i] = *(const unsigned*)(zb_ + (long)(off + ZQ * 2)); pf_[i] = *(const unsigned*)(zb_ + (long)(off + (ZF + 512 * dir) * 2)); pv_[i] = *(const unsigned*)(zb_ + (long)(off + ZI * 2)); } } while (0)
    { const u16* Z = (const u16*)(p.ws + WS_Z); HG_LOAD(0); }
    for (int n = 0; n < 132; ++n) {
        bool isctx; int tbase; long rowbase; chain_chunk(n, dir, b, isctx, tbase, rowbase);
        unsigned char* wsl = launder_sp(p.ws); const u16* Z = (const u16*)(wsl + WS_Z); u16* O = (u16*)launder_sp((unsigned char*)p.out);
        const int lane = fresh_tid(wave) & 63, h5 = lane >> 5, r = lane & 31;
        float bb[8][2], om[8][2]; float cum0 = 0.f, cum1 = 0.f;
        const f32x2 lbv = *(const f32x2*)((const float*)(wsl + WS_LB) + 512 * dir + h * 128 + 2 * lane);
#pragma unroll
        for (int i = 0; i < 8; ++i) {
            const int j = 8 * wave + i;
            *(LAS unsigned*)(VV + j * HG_LD + 2 * lane) = pv_[i];
            const float f0 = lbv.x + (1.0f - lbv.x) * pg8::sigm(h2f((unsigned short)(pf_[i] & 0xffffu))), f1 = lbv.y + (1.0f - lbv.y) * pg8::sigm(h2f((unsigned short)(pf_[i] >> 16)));
            om[i][0] = 1.0f - f0; om[i][1] = 1.0f - f1;
            cum0 += __logf(f0); cum1 += __logf(f1); bb[i][0] = cum0; bb[i][1] = cum1;
        }
        *(LAS f32x2*)(TOT + wave * 128 + 2 * lane) = (f32x2){cum0, cum1};
        LBAR();
        float base0 = 0.f, base1 = 0.f, m0 = 0.f, m1 = 0.f, t0 = 0.f, t1 = 0.f;
#pragma unroll
        for (int w = 0; w < 8; ++w) { const f32x2 t = *(const LAS f32x2*)(TOT + w * 128 + 2 * lane);
            if (w < wave) { base0 += t.x; base1 += t.y; } if (w < 4) { m0 += t.x; m1 += t.y; } t0 += t.x; t1 += t.y; }
#pragma unroll
        for (int i = 0; i < 8; ++i) {
            const int j = 8 * wave + i;
            const float e0 = __expf(base0 + bb[i][0] - m0), e1 = __expf(base1 + bb[i][1] - m1);
            *(LAS unsigned*)(QT + j * HG_LD + 2 * lane) = pkbf(bflo(pq_[i]) * e0, bfhi(pq_[i]) * e1);
            *(LAS unsigned*)(KT + j * HG_LD + 2 * lane) = pkbf(om[i][0] * __builtin_amdgcn_rcpf(e0), om[i][1] * __builtin_amdgcn_rcpf(e1));
        }
        if (wave == 0) { *(LAS f32x2*)(EM + 2 * lane) = (f32x2){__expf(m0), __expf(m1)}; *(LAS f32x2*)(EE + 2 * lane) = (f32x2){__expf(t0 - m0), __expf(t1 - m1)}; *(LAS f32x2*)(DD + 2 * lane) = (f32x2){__expf(t0), __expf(t1)}; }
        if (n + 1 < 132) { HG_LOAD(n + 1); }
        LBAR();
#pragma unroll
        for (int tt = 0; tt < 2; ++tt) {
            f32x16 sc = tt ? S1 : S0;
#pragma unroll
            for (int g = 0; g < 4; ++g) { const f32x4 em = *(const LAS f32x4*)(EM + 32 * kb + 8 * g + 4 * h5);
#pragma unroll
                for (int e = 0; e < 4; ++e) sc[4 * g + e] *= em[e]; }
            st_tile_T(ST, HG_LD, 32 * kb, 32 * (vb0 + tt), sc, lane);
        }
        if (wave < 3) {
            const int ti = wave >= 1 ? 1 : 0, si = wave == 2 ? 1 : 0;
            f32x16 a = zero16();
#pragma unroll
            for (int ks = 0; ks < 8; ++ks) a = MFMA32(frag_kc(QT, HG_LD, 32 * ti, 16 * ks, lane), frag_kc(KT, HG_LD, 32 * si, 16 * ks, lane), a);
#pragma unroll
            for (int i = 0; i < 16; ++i) { const int t = 32 * ti + arow(i, h5), s = 32 * si + r; if (s > t) a[i] = 0.f; }
            st_tile_T(PT, 72, 32 * ti, 32 * si, a, lane);
        }
        LBAR();
        f32x16 o = zero16();
#pragma unroll
        for (int ks = 0; ks < 8; ++ks) o = MFMA32(frag_kc(QT, HG_LD, 32 * oti, 16 * ks, lane), frag_kc(ST, HG_LD, 32 * ovi, 16 * ks, lane), o);
#pragma unroll
        for (int ks = 0; ks < 4; ++ks) if (ks < 2 * (oti + 1)) o = MFMA32(frag_tr(PT, 72, 32 * oti, 16 * ks, lane), frag_tr(VV, HG_LD, 32 * ovi, 16 * ks, lane), o);
        if (!isctx) {
#pragma unroll
            for (int i = 0; i < 16; ++i) { const int j = 32 * oti + arow(i, h5); const long row = rowbase + (dir ? 63 - j : j);
                O[row * 1024 + dir * 512 + h * 128 + 32 * ovi + r] = (u16)(pkbf(o[i], 0.f) & 0xffffu); }
        }
#pragma unroll
        for (int tt = 0; tt < 2; ++tt) {
            f32x16 g = zero16();
#pragma unroll
            for (int ks = 0; ks < 4; ++ks) g = MFMA32(frag_tr(KT, HG_LD, 32 * kb, 16 * ks, lane), frag_tr(VV, HG_LD, 32 * (vb0 + tt), 16 * ks, lane), g);
#pragma unroll
            for (int gq = 0; gq < 4; ++gq) { const f32x4 dd = *(const LAS f32x4*)(DD + 32 * kb + 8 * gq + 4 * h5), ee = *(const LAS f32x4*)(EE + 32 * kb + 8 * gq + 4 * h5);
#pragma unroll
                for (int e = 0; e < 4; ++e) { if (tt) S1[4 * gq + e] = dd[e] * S1[4 * gq + e] + ee[e] * g[4 * gq + e]; else S0[4 * gq + e] = dd[e] * S0[4 * gq + e] + ee[e] * g[4 * gq + e]; } }
        }
        LBAR();
    }
}
#ifndef RQ_E1
#define RQ_E1 1
#endif
#ifndef RQ_INV
#define RQ_INV 1
#endif
#ifndef RQ_M1
#define RQ_M1 1
#endif
#ifndef RQ_E2A
#define RQ_E2A 1
#endif
#ifndef RQ_E2B
#define RQ_E2B 1
#endif
#ifndef RQ_M2
#define RQ_M2 1
#endif
constexpr int RW_WD = 0, RW_AD = 5120, RW_W2 = 10240, RW_A2 = 15360, RW_TOT = 0;
constexpr int RW_LW = 23552, RW_AG = 32768;
constexpr int RW_AT = 41984, RW_BT = 51200, RW_KT = 60416, RW_RT = 69632, RW_VV = 78848;
constexpr int RW_LF = 88064, RW_TB = 93184, RW_LB = 102400, RW_AAK = 111616, RW_ARB = 120832, RW_ARK = 130048;
constexpr int RW_TMP = 139264, RW_SBT = 144384, RW_PC = 153600;
static_assert(RW_PC + 256 <= MISC_OFF, "rwkv lds map");
__device__ __forceinline__ bf16x8 frag_trp(const LAS u16* X, int ld, int idx0, int k0, int lane) {
    const int g = lane >> 4, q = (lane >> 2) & 3, p = lane & 3;
    const LAS u16* a = X + (k0 + 4 * (g >> 1) + q) * ld + idx0 + 16 * (g & 1) + 4 * p;
    const s16x4 lo = __builtin_bit_cast(s16x4, __builtin_amdgcn_ds_read_tr16_b64_v4i16((LAS s16x4*)a));
    const s16x4 hi = __builtin_bit_cast(s16x4, __builtin_amdgcn_ds_read_tr16_b64_v4i16((LAS s16x4*)(a + 8 * ld)));
    return (bf16x8){lo[0], lo[1], lo[2], lo[3], hi[0], hi[1], hi[2], hi[3]};
}
__device__ __forceinline__ bf16x8 acc_frag(const f32x16& x, const int s) {
    const v4u w = (v4u){pkbf(x[8 * s], x[8 * s + 1]), pkbf(x[8 * s + 2], x[8 * s + 3]), pkbf(x[8 * s + 4], x[8 * s + 5]), pkbf(x[8 * s + 6], x[8 * s + 7])};
    return __builtin_bit_cast(bf16x8, w);
}
#define WAVE_LDS_SYNC() asm volatile("s_waitcnt lgkmcnt(0)" ::: "memory")
__device__ __forceinline__ void rwkv_chain(const Params& p, LAS unsigned char* lds, int tid, int lane_in, int wave, int b, int h, int dir) {
    LAS u16* WDs = (LAS u16*)(lds + RW_WD); LAS u16* ADs = (LAS u16*)(lds + RW_AD); LAS u16* W2s = (LAS u16*)(lds + RW_W2); LAS u16* A2s = (LAS u16*)(lds + RW_A2); LAS float* TOT = (LAS float*)(lds + RW_TOT);
    LAS u16* LWh = (LAS u16*)(lds + RW_LW); LAS u16* AGb = (LAS u16*)(lds + RW_AG); LAS float* PC = (LAS float*)(lds + RW_PC);
    LAS float* LF = (LAS float*)(lds + RW_LF); LAS u16* TB = (LAS u16*)(lds + RW_TB); LAS u16* LB = (LAS u16*)(lds + RW_LB);
    LAS u16* AAK = (LAS u16*)(lds + RW_AAK); LAS u16* ARB = (LAS u16*)(lds + RW_ARB); LAS u16* ARK = (LAS u16*)(lds + RW_ARK);
    LAS u16* ATs = (LAS u16*)(lds + RW_AT); LAS u16* BTs = (LAS u16*)(lds + RW_BT); LAS u16* KTs = (LAS u16*)(lds + RW_KT); LAS u16* RTs = (LAS u16*)(lds + RW_RT);
    LAS u16* VVs = (LAS u16*)(lds + RW_VV); LAS u16* TMP = (LAS u16*)(lds + RW_TMP); LAS u16* SBT = (LAS u16*)(lds + RW_SBT);
    const int t2 = (wave & 3) >> 1, c2 = wave & 1;
    unsigned pc_[4][3], pn_[4][3]; u32x2 pw_[4];
#define RW_LOAD(nn) do { bool ic_; int tb_; long rb_; chain_chunk((nn), dir, b, ic_, tb_, rb_); \
        const int lt_ = fresh_tid(wave), tg_ = lt_ >> 5, hc_ = h * 64 + 2 * (lt_ & 31), tok_ = lt_ >> 3, cg_ = lt_ & 7; \
        const int qr = hc_ / 440, qk = (512 + hc_) / 440, qv = (1024 + hc_) / 440; \
        const char* zb_ = (const char*)(Z + rb_ * ZLD + ZR);                         \
        const bool e0_ = ic_ ? (tb_ == 0) : true, e1_ = ic_ ? (tb_ == CTXL - 64) : true, vu_ = tb_ >= 64, vdn_ = tb_ < SEQ - 64; \
          \
        const int kr_ = ic_ ? (qr < 2 ? 0 : 1) : qr, kk_ = ic_ ? (qk < 2 ? 0 : 1) : qk, kv_ = ic_ ? (qv < 2 ? 0 : 1) : qv, kd_ = ic_ ? 1 : 3; \
        const int RB_ = ZLD * 2; \
        const int dr_ = kr_ == 0 ? -RB_ : kr_ == 1 ? RB_ : kr_ == 2 ? -64 * RB_ : 64 * RB_, dk_ = kk_ == 0 ? -RB_ : kk_ == 1 ? RB_ : kk_ == 2 ? -64 * RB_ : 64 * RB_, dv_ = kv_ == 0 ? -RB_ : kv_ == 1 ? RB_ : kv_ == 2 ? -64 * RB_ : 64 * RB_, dd_ = kd_ == 1 ? RB_ : 64 * RB_; \
        _Pragma("unroll") for (int i = 0; i < 4; ++i) { const int j = 4 * tg_ + i, tl = dir ? 63 - j : j; \
            const bool a0 = !(e0_ && tl == 0), a1 = !(e1_ && tl == 63); \
            const bool v0 = kr_ == 0 ? a0 : kr_ == 1 ? a1 : kr_ == 2 ? vu_ : vdn_, v1 = kk_ == 0 ? a0 : kk_ == 1 ? a1 : kk_ == 2 ? vu_ : vdn_, v2 = kv_ == 0 ? a0 : kv_ == 1 ? a1 : kv_ == 2 ? vu_ : vdn_; \
            const int off = tl * RB_ + hc_ * 2; \
            pc_[i][0] = *(const unsigned*)(zb_ + (long)off); pc_[i][1] = *(const unsigned*)(zb_ + (long)(off + 1024)); pc_[i][2] = *(const unsigned*)(zb_ + (long)(off + 2048)); \
            const unsigned x0 = *(const unsigned*)(zb_ + (long)(off + (v0 ? dr_ : 0))), x1 = *(const unsigned*)(zb_ + (long)(off + 1024 + (v1 ? dk_ : 0))), x2 = *(const unsigned*)(zb_ + (long)(off + 2048 + (v2 ? dv_ : 0))); \
            pn_[i][0] = v0 ? x0 : 0u; pn_[i][1] = v1 ? x1 : 0u; pn_[i][2] = v2 ? x2 : 0u; } \
        { const int j = tok_, tl = dir ? 63 - j : j; const bool vd = kd_ == 1 ? !(e1_ && tl == 63) : vdn_; \
            const int offw = tl * RB_ + (1536 + dir * 32 + 4 * cg_) * 2, offn = offw + (vd ? dd_ : 0); \
            pw_[0] = *(const u32x2*)(zb_ + (long)offw); pw_[1] = *(const u32x2*)(zb_ + (long)(offw + 128)); \
            const u32x2 yw = *(const u32x2*)(zb_ + (long)offn), ya = *(const u32x2*)(zb_ + (long)(offn + 128)); \
            pw_[2] = vd ? yw : (u32x2){0u, 0u}; pw_[3] = vd ? ya : (u32x2){0u, 0u}; \
 } \
    } while (0)
    { const u16* Z = (const u16*)(p.ws + WS_Z); RW_LOAD(0); }
#define LOAD_CA() do { const int l_ = fresh_tid(wave), hc_ = h * 64 + 2 * (l_ & 31), cg_ = l_ & 7; cA_mur = *(const f32x2*)(p.mu + hc_); cA_muk = *(const f32x2*)(p.mu + 512 + hc_); cA_muv = *(const f32x2*)(p.mu + 1024 + hc_); \
        cA_muw = *(const f32x4*)(p.mu + 1536 + dir * 32 + 4 * cg_); cA_mua = *(const f32x4*)(p.mu + 1600 + dir * 32 + 4 * cg_); } while (0)
#define LOAD_CC() do { const int hc_ = h * 64 + 2 * (fresh_tid(wave) & 31); cC_kk = *(const f32x2*)(p.kkw + hc_); cC_ka = *(const f32x2*)(p.kaw + hc_); cC_rk = *(const f32x2*)(p.rkw + hc_); } while (0)
    f32x16 Sa = zero16();
    f32x2 cA_mur, cA_muk, cA_muv, cC_kk, cC_ka, cC_rk; f32x4 cA_muw, cA_mua;
    {   const u16* w2t = (const u16*)(p.ws + WS_W2T) + (size_t)(dir * 512 + h * 64) * 32; const u16* a2t = (const u16*)(p.ws + WS_A2T) + (size_t)(dir * 512 + h * 64) * 32;
        for (int i = tid; i < 64 * 32; i += 512) { const int c = i >> 5, l = i & 31; W2s[c * 40 + l] = w2t[i]; A2s[c * 40 + l] = a2t[i]; } }
    float rv[4][2], kv[4][2], vv[4][2];
    float lw[4][2], av[4][2], bv[4][2], kd[4][2], cl[4][2];
    if (wave < 4) st_tile_T(SBT, 72, 32 * (wave >> 1), 32 * (wave & 1), Sa, lane_in);
    LOAD_CA();
    LBAR();
#ifdef DBG_TSTAGE
    unsigned tacc = 0, tprev = 0;
#define TNOW(v) do { unsigned long long t64_; asm volatile("s_memtime %0\n\ts_waitcnt lgkmcnt(0)" : "=s"(t64_)); v = (unsigned)t64_; } while (0)
#define TSTB(k) do { if ((k) == DBG_TSTAGE && DBG_BUSY) { unsigned tn_; TNOW(tn_); tacc += tn_ - tprev; } } while (0)
#define TST(k) do { unsigned tn_; TNOW(tn_); if ((k) == DBG_TSTAGE && !DBG_BUSY) tacc += tn_ - tprev; tprev = tn_; } while (0)
#else
#define TSTB(k) do { } while (0)
#define TST(k) do { } while (0)
#endif
    for (int n = -1; n < 132; ++n) {
        const bool e_on = n + 1 < 132, s_on = n >= 0;
        unsigned char* wsl = launder_sp(p.ws);
        const u16* Z = (const u16*)(wsl + WS_Z); u16* YY = (u16*)(wsl + WS_YY); u16* VL = (u16*)(wsl + WS_VL); u16* GG = (u16*)(wsl + WS_G); float* SBv = (float*)(wsl + WS_SB);
        bool isctxE = false, isctxS = false; int tbaseE = 0, tbaseS = 0; long rowbaseE = 0, rowbaseS = 0;
        if (e_on) chain_chunk(n + 1, dir, b, isctxE, tbaseE, rowbaseE);
        if (s_on) chain_chunk(n, dir, b, isctxS, tbaseS, rowbaseS);
        const bool do_g = e_on && (!isctxE) && (dir == 0), wr_sb = e_on && !isctxE, wr_y = s_on && !isctxS;
        const int ltid = fresh_tid(wave), lane = ltid & 63, h5 = lane >> 5, r = lane & 31;
        const int tg = ltid >> 5, c0 = 2 * r, hc = h * 64 + c0, tok8 = ltid >> 3, cg = ltid & 7;
        for (int rq = 0; rq < RQ_E1; ++rq) if (e_on) {
            const f32x2 mur = cA_mur, muk = cA_muk, muv = cA_muv;
            const float mur0 = mur.x, mur1 = mur.y, muk0 = muk.x, muk1 = muk.y, muv0 = muv.x, muv1 = muv.y;
            const f32x4 muw = cA_muw, mua = cA_mua;
#pragma unroll
            for (int i = 0; i < 4; ++i) {
                const unsigned ur = pc_[i][0], uk = pc_[i][1], uv = pc_[i][2], nr = pn_[i][0], nk = pn_[i][1], nv = pn_[i][2];
                rv[i][0] = bflo(ur) + mur0 * (bflo(nr) - bflo(ur)); rv[i][1] = bfhi(ur) + mur1 * (bfhi(nr) - bfhi(ur));
                kv[i][0] = bflo(uk) + muk0 * (bflo(nk) - bflo(uk)); kv[i][1] = bfhi(uk) + muk1 * (bfhi(nk) - bfhi(uk));
                vv[i][0] = bflo(uv) + muv0 * (bflo(nv) - bflo(uv)); vv[i][1] = bfhi(uv) + muv1 * (bfhi(nv) - bfhi(uv));
            }
            if (do_g) {
#pragma unroll
                for (int i = 0; i < 4; ++i) { const int j = 4 * tg + i, tl = dir ? 63 - j : j; *(unsigned*)(VL + (rowbaseE + tl) * 512 + hc) = pkbf(vv[i][0], vv[i][1]); }
            }
            {
                const int j = tok8;
                const u32x2 cw = pw_[0], ca = pw_[1], nw = pw_[2], na = pw_[3];
                float wl[4], al[4];
                wl[0] = bflo(cw.x) + muw[0] * (bflo(nw.x) - bflo(cw.x)); wl[1] = bfhi(cw.x) + muw[1] * (bfhi(nw.x) - bfhi(cw.x)); wl[2] = bflo(cw.y) + muw[2] * (bflo(nw.y) - bflo(cw.y)); wl[3] = bfhi(cw.y) + muw[3] * (bfhi(nw.y) - bfhi(cw.y));
                al[0] = bflo(ca.x) + mua[0] * (bflo(na.x) - bflo(ca.x)); al[1] = bfhi(ca.x) + mua[1] * (bfhi(na.x) - bfhi(ca.x)); al[2] = bflo(ca.y) + mua[2] * (bflo(na.y) - bflo(ca.y)); al[3] = bfhi(ca.y) + mua[3] * (bfhi(na.y) - bfhi(ca.y));
#pragma unroll
                for (int e = 0; e < 4; ++e) wl[e] = 1.0f - 2.0f * __builtin_amdgcn_rcpf(1.0f + __expf(2.0f * wl[e]));
                *(LAS u32x2*)(WDs + j * 40 + 4 * cg) = (u32x2){pkbf(wl[0], wl[1]), pkbf(wl[2], wl[3])};
                *(LAS u32x2*)(ADs + j * 40 + 4 * cg) = (u32x2){pkbf(al[0], al[1]), pkbf(al[2], al[3])};
            }
        }
        for (int rq = 0; rq < RQ_INV; ++rq) if (s_on && wave < 2) {
            const int bi = 2 * wave + ((lane >> 4) & 1), jj = lane & 15; float Td[16];
            int lfo = bi * 320;
#pragma unroll
            for (int i = 0; i < 16; ++i) {
                float s = (i == jj) ? 1.0f : 0.0f;
                const LAS float* Lr = LF + lfo + i * 20;
#pragma unroll
                for (int k4 = 0; k4 < 4; ++k4) if (4 * k4 < i) { const f32x4 lv = *(const LAS f32x4*)(Lr + 4 * k4);
#pragma unroll
                    for (int e = 0; e < 4; ++e) if (4 * k4 + e < i) s += lv[e] * Td[4 * k4 + e]; }
                Td[i] = s;
                if (i == 5 || i == 9 || i == 12) asm volatile("" : "+v"(lfo) : "v"(Td[i - 2]));
            }
            LAS u16* tp = TB + (16 * bi + jj) * 72 + 16 * bi;
            *(LAS v4u*)tp = (v4u){pkbf(Td[0], Td[1]), pkbf(Td[2], Td[3]), pkbf(Td[4], Td[5]), pkbf(Td[6], Td[7])};
            *(LAS v4u*)(tp + 8) = (v4u){pkbf(Td[8], Td[9]), pkbf(Td[10], Td[11]), pkbf(Td[12], Td[13]), pkbf(Td[14], Td[15])};
            LAS u16* zp = TB + (16 * bi + jj) * 72 + 16 * (bi ^ 1);
            *(LAS v4u*)zp = (v4u){0u, 0u, 0u, 0u}; *(LAS v4u*)(zp + 8) = (v4u){0u, 0u, 0u, 0u};
            WAVE_LDS_SYNC();
            const int o = 32 * wave; f32x16 a = zero16();
#pragma unroll
            for (int ks = 0; ks < 2; ++ks) a = MFMA32(frag_tr(LB, 72, o, o + 16 * ks, lane), frag_kc(TB, 72, o, o + 16 * ks, lane), a);
            st_tile_T(TMP + wave * 1280, 40, 0, 0, a, lane);
            WAVE_LDS_SYNC();
            a = zero16();
#pragma unroll
            for (int ks = 0; ks < 2; ++ks) a = MFMA32(frag_tr(TB, 72, o, o + 16 * ks, lane), frag_kc(TMP + wave * 1280, 40, 0, 16 * ks, lane), a);
            if (r < 16) { LAS u16* q = TB + (o + r) * 72 + o + 4 * h5;
#pragma unroll
                for (int g = 2; g < 4; ++g) *(LAS u32x2*)(q + 8 * g) = (u32x2){pkbf(a[4 * g], a[4 * g + 1]), pkbf(a[4 * g + 2], a[4 * g + 3])}; }
        }
        TSTB(0);
        LBAR();
        TST(0);
        for (int rq = 0; rq < RQ_M1; ++rq) if (e_on && wave >= 4) {
#pragma unroll
            for (int q = 0; q < 2; ++q) {
                const int tile = 2 * (wave - 4) + q;
                const int isa = tile >> 2, tt2 = (tile >> 1) & 1, cc2 = tile & 1;
                const LAS u16* Xs = isa ? ADs : WDs; const LAS u16* Ws = isa ? A2s : W2s;
                const float mbias = isa ? p.a0[dir * 512 + h * 64 + 32 * cc2 + r] : p.w0[dir * 512 + h * 64 + 32 * cc2 + r];
                f32x16 a = zero16();
#pragma unroll
                for (int ks = 0; ks < 2; ++ks) a = MFMA32(frag_kc(Xs, 40, 32 * tt2, 16 * ks, lane), frag_kc(Ws, 40, 32 * cc2, 16 * ks, lane), a);
                if (!isa) {
#pragma unroll
                    for (int i = 0; i < 16; ++i) { const _Float16 hv = (_Float16)(-0.6065306597f * sigm(a[i] + mbias)); LWh[(32 * tt2 + arow(i, h5)) * 72 + 32 * cc2 + r] = __builtin_bit_cast(unsigned short, hv); }
                } else {
#pragma unroll
                    for (int i = 0; i < 16; ++i) AGb[(32 * tt2 + arow(i, h5)) * 72 + 32 * cc2 + r] = (u16)(pkbf(sigm(a[i] + mbias), 0.f) & 0xffffu);
                }
            }
        }
        if (s_on && wave < 4) {
            const int v0 = 32 * (wave >> 1), ci = wave & 1, cs = 32 * ci;
            bf16x8 vf[4], sf[4];
#pragma unroll
            for (int ks = 0; ks < 4; ++ks) { vf[ks] = frag_tr(VVs, 72, v0, 16 * ks, lane); sf[ks] = frag_tr(SBT, 72, v0, 16 * ks, lane); }
            f32x16 A0 = zero16();
            { bf16x8 fa[6];
#pragma unroll
              for (int ks = 0; ks < 2; ++ks) fa[ks] = frag_tr(AAK, 72, 0, 16 * ks, lane);
#pragma unroll
              for (int ks = 0; ks < 4; ++ks) fa[2 + ks] = frag_kc(ATs, 72, 0, 16 * ks, lane);
#pragma unroll
              for (int ks = 0; ks < 2; ++ks) A0 = MFMA32(fa[ks], vf[ks], A0);
#pragma unroll
              for (int ks = 0; ks < 4; ++ks) A0 = MFMA32(fa[2 + ks], sf[ks], A0); }
            bf16x8 ut0, ut1;
            { const bf16x8 t0 = frag_trp(TB, 72, 0, 0, lane), t1 = frag_trp(TB, 72, 0, 16, lane); f32x16 Ut = zero16();
              Ut = MFMA32(t0, acc_frag(A0, 0), Ut); Ut = MFMA32(t1, acc_frag(A0, 1), Ut);
              ut0 = acc_frag(Ut, 0); ut1 = acc_frag(Ut, 1); }
            if (ci == 0) {
                A0 = zero16();
                bf16x8 fa[8];
#pragma unroll
                for (int ks = 0; ks < 2; ++ks) { fa[ks] = frag_tr(ARK, 72, 0, 16 * ks, lane); fa[6 + ks] = frag_trp(ARB, 72, 0, 16 * ks, lane); }
#pragma unroll
                for (int ks = 0; ks < 4; ++ks) fa[2 + ks] = frag_kc(RTs, 72, 0, 16 * ks, lane);
#pragma unroll
                for (int ks = 0; ks < 2; ++ks) A0 = MFMA32(fa[ks], vf[ks], A0);
#pragma unroll
                for (int ks = 0; ks < 4; ++ks) A0 = MFMA32(fa[2 + ks], sf[ks], A0);
                A0 = MFMA32(fa[6], ut0, A0); A0 = MFMA32(fa[7], ut1, A0);
                if (wr_y) {
#pragma unroll
                    for (int i = 0; i < 16; ++i) { const int j0 = arow(i, h5); const long r0 = rowbaseS + (dir ? 63 - j0 : j0); YY[r0 * 1024 + dir * 512 + h * 64 + v0 + r] = (u16)(pkbf(A0[i], 0.f) & 0xffffu); }
                }
            }
            { const bf16x8 b0 = frag_trp(BTs, 72, cs, 0, lane), b1 = frag_trp(BTs, 72, cs, 16, lane);
              Sa = MFMA32(ut0, b0, Sa); Sa = MFMA32(ut1, b1, Sa); }
            A0 = zero16();
            { bf16x8 fa[10];
#pragma unroll
              for (int ks = 0; ks < 4; ++ks) { fa[ks] = frag_tr(AAK, 72, 32, 16 * ks, lane); fa[4 + ks] = frag_kc(ATs, 72, 32, 16 * ks, lane); }
              fa[8] = frag_trp(LB, 72, 32, 0, lane); fa[9] = frag_trp(LB, 72, 32, 16, lane);
#pragma unroll
              for (int ks = 0; ks < 4; ++ks) A0 = MFMA32(fa[ks], vf[ks], A0);
#pragma unroll
              for (int ks = 0; ks < 4; ++ks) A0 = MFMA32(fa[4 + ks], sf[ks], A0);
              A0 = MFMA32(fa[8], ut0, A0); A0 = MFMA32(fa[9], ut1, A0); }
            bf16x8 ub0, ub1;
            { const bf16x8 t0 = frag_trp(TB, 72, 32, 32, lane), t1 = frag_trp(TB, 72, 32, 48, lane); f32x16 Ub = zero16();
              Ub = MFMA32(t0, acc_frag(A0, 0), Ub); Ub = MFMA32(t1, acc_frag(A0, 1), Ub);
              ub0 = acc_frag(Ub, 0); ub1 = acc_frag(Ub, 1); }
            if (ci == 1) {
                A0 = zero16();
                bf16x8 fa[12];
#pragma unroll
                for (int ks = 0; ks < 4; ++ks) { fa[ks] = frag_tr(ARK, 72, 32, 16 * ks, lane); fa[4 + ks] = frag_kc(RTs, 72, 32, 16 * ks, lane); fa[8 + ks] = frag_trp(ARB, 72, 32, 16 * ks, lane); }
#pragma unroll
                for (int ks = 0; ks < 4; ++ks) A0 = MFMA32(fa[ks], vf[ks], A0);
#pragma unroll
                for (int ks = 0; ks < 4; ++ks) A0 = MFMA32(fa[4 + ks], sf[ks], A0);
                A0 = MFMA32(fa[8], ut0, A0); A0 = MFMA32(fa[9], ut1, A0); A0 = MFMA32(fa[10], ub0, A0); A0 = MFMA32(fa[11], ub1, A0);
                if (wr_y) {
#pragma unroll
                    for (int i = 0; i < 16; ++i) { const int j1 = 32 + arow(i, h5); const long r1 = rowbaseS + (dir ? 63 - j1 : j1); YY[r1 * 1024 + dir * 512 + h * 64 + v0 + r] = (u16)(pkbf(A0[i], 0.f) & 0xffffu); }
                }
            }
            { bf16x8 fb[6];
              fb[0] = frag_trp(BTs, 72, cs, 32, lane); fb[1] = frag_trp(BTs, 72, cs, 48, lane);
#pragma unroll
              for (int ks = 0; ks < 4; ++ks) fb[2 + ks] = frag_tr(KTs, 72, cs, 16 * ks, lane);
              Sa = MFMA32(ub0, fb[0], Sa); Sa = MFMA32(ub1, fb[1], Sa);
#pragma unroll
              for (int ks = 0; ks < 4; ++ks) Sa = MFMA32(vf[ks], fb[2 + ks], Sa); }
            { const float pca = PC[cs + r];
#pragma unroll
              for (int i = 0; i < 16; ++i) Sa[i] *= pca; }
        }
        if (e_on) { LOAD_CC(); }
        TSTB(1);
        LBAR();
        TST(1);
        if (s_on && wave < 4) st_tile_T(SBT, 72, 32 * (wave >> 1), 32 * (wave & 1), Sa, lane);
        float cum0 = 0.f, cum1 = 0.f; float sbv[4];
        for (int rq = 0; rq < RQ_E2A; ++rq) if (e_on) {
            cum0 = 0.f; cum1 = 0.f;
            const f32x2 kkp = cC_kk, kap = cC_ka, rkp = cC_rk;
            const float kk0 = kkp.x, kk1 = kkp.y, ka0 = kap.x, ka1 = kap.y, rk0 = rkp.x, rk1 = rkp.y;
            unsigned lwu[4], agu[4];
#pragma unroll
            for (int i = 0; i < 4; ++i) { const int j = 4 * tg + i; lwu[i] = *(const LAS unsigned*)(LWh + j * 72 + c0); agu[i] = *(const LAS unsigned*)(AGb + j * 72 + c0); }
#pragma unroll
            for (int i = 0; i < 4; ++i) {
                lw[i][0] = h2f((unsigned short)(lwu[i] & 0xffffu)); lw[i][1] = h2f((unsigned short)(lwu[i] >> 16));
                const float ag0 = bflo(agu[i]), ag1 = bfhi(agu[i]);
                float k0 = kv[i][0] * kk0, k1 = kv[i][1] * kk1; float ss = k0 * k0 + k1 * k1;
                kd[i][0] = kv[i][0] * (1.0f + (ag0 - 1.0f) * ka0); kd[i][1] = kv[i][1] * (1.0f + (ag1 - 1.0f) * ka1);
                float sb = rv[i][0] * kd[i][0] * rk0 + rv[i][1] * kd[i][1] * rk1;
                ss = sum32(ss); sb = sum32(sb); sbv[i] = sb;
                const float inv = 1.0f / fmaxf(sqrtf(ss), 1e-12f); k0 *= inv; k1 *= inv;
                av[i][0] = -k0; av[i][1] = -k1; bv[i][0] = k0 * ag0; bv[i][1] = k1 * ag1;
                cum0 += lw[i][0]; cum1 += lw[i][1]; cl[i][0] = cum0; cl[i][1] = cum1;
            }
            if (wr_sb && r == 0) {
#pragma unroll
                for (int i = 0; i < 4; ++i) { const int j = 4 * tg + i, tl = dir ? 63 - j : j; SBv[((size_t)dir * NTOK + rowbaseE + tl) * 8 + h] = sbv[i]; }
            }
            *(LAS f32x2*)(TOT + tg * 64 + c0) = (f32x2){cum0, cum1};
#pragma unroll
            for (int i = 0; i < 4; ++i) *(LAS unsigned*)(VVs + (4 * tg + i) * 72 + c0) = pkbf(vv[i][0], vv[i][1]);
            if (n + 2 < 132) { RW_LOAD(n + 2); }
        }
        TSTB(2);
        LBAR();
        TST(2);
        for (int rq = 0; rq < RQ_E2B; ++rq) if (e_on) {
            float base0 = 0.f, base1 = 0.f, tt0 = 0.f, tt1 = 0.f;
#pragma unroll
            for (int g = 0; g < 16; ++g) { const f32x2 t = *(const LAS f32x2*)(TOT + g * 64 + c0); if (g < tg) { base0 += t.x; base1 += t.y; } tt0 += t.x; tt1 += t.y; }
            float Xp0 = __expf(base0), Xp1 = __expf(base1);
#pragma unroll
            for (int i = 0; i < 4; ++i) {
                const int j = 4 * tg + i;
                const float E0 = __expf(base0 + cl[i][0]), E1 = __expf(base1 + cl[i][1]), I0 = __builtin_amdgcn_rcpf(E0), I1 = __builtin_amdgcn_rcpf(E1);
                *(LAS unsigned*)(ATs + j * 72 + c0) = pkbf(av[i][0] * Xp0, av[i][1] * Xp1);
                *(LAS unsigned*)(BTs + j * 72 + c0) = pkbf(bv[i][0] * I0, bv[i][1] * I1);
                *(LAS unsigned*)(KTs + j * 72 + c0) = pkbf(kd[i][0] * I0, kd[i][1] * I1);
                *(LAS unsigned*)(RTs + j * 72 + c0) = pkbf(rv[i][0] * E0, rv[i][1] * E1);
                Xp0 = E0; Xp1 = E1;
            }
            if (tg == 0) *(LAS f32x2*)(PC + c0) = (f32x2){__expf(tt0), __expf(tt1)};
        }
        TSTB(3);
        LBAR();
        TST(3);
        for (int rq = 0; rq < RQ_M2; ++rq) if (e_on) {
            const int mtx = wave & 3; const LAS u16* Am = mtx < 2 ? ATs : RTs; const LAS u16* Bm = (mtx & 1) ? KTs : BTs; LAS u16* Dm = (LAS u16*)(lds + RW_LB + 9216 * mtx);
            const int ntile = wave < 4 ? 2 : 1;
#pragma unroll
            for (int q = 0; q < 2; ++q) if (q < ntile) {
                const int ti = wave < 4 ? 1 - q : 1, ii = wave < 4 ? 0 : 1;
                f32x16 a = zero16();
#pragma unroll
                for (int ks = 0; ks < 4; ++ks) a = MFMA32(frag_kc(Am, 72, 32 * ti, 16 * ks, lane), frag_kc(Bm, 72, 32 * ii, 16 * ks, lane), a);
#pragma unroll
                for (int i = 0; i < 16; ++i) { const int lim = (ti != ii) ? 64 : (arow(i, h5) + (mtx < 2 ? 0 : 1)); a[i] = (r < lim) ? a[i] : 0.f; }
                st_tile_T(Dm, 72, 32 * ti, 32 * ii, a, lane);
                if (mtx == 0 && ti == ii) {
#pragma unroll
                    for (int i = 0; i < 16; ++i) { const int t = arow(i, h5); if ((t >> 4) == (r >> 4)) LF[(2 * ti + (t >> 4)) * 320 + (t & 15) * 20 + (r & 15)] = a[i]; }
                }
            }
        }
        if (n + 2 < 132) { LOAD_CA(); }
        TSTB(4);
        LBAR();
        TST(4);
    }
#ifdef DBG_TSTAGE
    if (b == 0 && h == 0 && dir == 0 && wave == DBG_TWAVE && (lane_in == 0)) ((float*)(p.ws + WS_CTL))[8192] = __expf(floorf(__logf((float)tacc / 133.0f) * 20.0f + 0.5f) * 0.05f);
#endif
#undef RW_LOAD
}

__device__ __forceinline__ void gate_panel(const Params& p, LAS unsigned char* lds, int lane, int wave, int pm) {
    const u16* Z = (const u16*)(p.ws + WS_Z); u16* GG = (u16*)(p.ws + WS_G); const u16* G2T = (const u16*)(p.ws + WS_G2T);
    LAS u16* Gs = (LAS u16*)(lds + wave * 6656);
    const int r = lane & 31, h5 = lane >> 5;
    {   const int rr = lane >> 1, half = lane & 1; const long row = (long)pm * 256 + wave * 32 + rr; const bool vd = (row & (SEQ - 1)) < SEQ - 64;
        const u16* zc = Z + row * ZLD + ZR + 1664 + 48 * half; const u16* zn = zc + (vd ? 64 * ZLD : 0);
#pragma unroll
        for (int q = 0; q < 6; ++q) { const v4u c = *(const v4u*)(zc + 8 * q); v4u nb = *(const v4u*)(zn + 8 * q); if (!vd) nb = (v4u){0u, 0u, 0u, 0u};
            const f32x4 m0 = *(const f32x4*)(p.mu + 1664 + 48 * half + 8 * q), m1 = *(const f32x4*)(p.mu + 1664 + 48 * half + 8 * q + 4);
            float cv[8], nv[8]; unpack8(c, cv); unpack8(nb, nv);
            float g[8];
#pragma unroll
            for (int e = 0; e < 8; ++e) { const float mu = e < 4 ? m0[e] : m1[e - 4]; g[e] = sigm(cv[e] + mu * (nv[e] - cv[e])); }
            *(LAS v4u*)(Gs + rr * 104 + 48 * half + 8 * q) = (v4u){pkbf(g[0], g[1]), pkbf(g[2], g[3]), pkbf(g[4], g[5]), pkbf(g[6], g[7])}; } }
    asm volatile("s_waitcnt lgkmcnt(0)" ::: "memory");
    bf16x8 af[6];
#pragma unroll
    for (int ks = 0; ks < 6; ++ks) af[ks] = frag_kc(Gs, 104, 0, 16 * ks, lane);
    for (int ct = 0; ct < 16; ++ct) {
        f32x16 a = zero16();
        const u16* bp = G2T + (size_t)(32 * ct + r) * 96 + 8 * h5;
#pragma unroll
        for (int ks = 0; ks < 6; ++ks) a = MFMA32(af[ks], *(const bf16x8*)(bp + 16 * ks), a);
#pragma unroll
        for (int i = 0; i < 16; ++i) { const long row = (long)pm * 256 + wave * 32 + arow(i, h5); GG[row * 512 + 32 * ct + r] = (u16)(pkbf(a[i], 0.f) & 0xffffu); }
    }
    asm volatile("s_waitcnt lgkmcnt(0)" ::: "memory");
}
#define CU_SYNC() do { asm volatile("s_waitcnt vmcnt(0)" ::: "memory"); __syncthreads(); __builtin_amdgcn_fence(__ATOMIC_ACQUIRE, "agent"); asm volatile("s_waitcnt vmcnt(0)" ::: "memory"); __syncthreads(); } while (0)
__device__ __forceinline__ void hgrn_combine_panel(const Params& p, int pm, int lane, int wave) {
    const u16* Z = (const u16*)(p.ws + WS_Z); u16* O = (u16*)p.out;
    float nw[8];
#pragma unroll
    for (int e = 0; e < 8; ++e) nw[e] = p.hg_norm_w[((8 * lane) & 127) + e];
    constexpr int RB = 4;
    for (int i = 0; i < 32; i += RB) {
        v4u uof[RB], uob[RB], uog[RB];
#pragma unroll
        for (int q = 0; q < RB; ++q) { const long row = (long)pm * 256 + wave * 32 + i + q;
            uof[q] = __builtin_nontemporal_load((const v4u*)(O + row * 1024 + 8 * lane)); uob[q] = __builtin_nontemporal_load((const v4u*)(O + row * 1024 + 512 + 8 * lane)); uog[q] = __builtin_nontemporal_load((const v4u*)(Z + row * ZLD + ZOG + 8 * lane)); }
#pragma unroll
        for (int q = 0; q < RB; ++q) { const long row = (long)pm * 256 + wave * 32 + i + q;
            float a[8], b[8], c[8], o[8];
            unpack8(uof[q], a); unpack8(uob[q], b); unpack8(uog[q], c);
            float ss = 0.f;
#pragma unroll
            for (int e = 0; e < 8; ++e) { o[e] = a[e] + b[e]; ss += o[e] * o[e]; }
            ss = sum16(ss);
            const float rs = 1.0f / sqrtf(ss * (1.0f / 128.0f) + 1e-5f);
            v4u wh;
            wh.x = pkbf(o[0] * rs * nw[0] * c[0], o[1] * rs * nw[1] * c[1]); wh.y = pkbf(o[2] * rs * nw[2] * c[2], o[3] * rs * nw[3] * c[3]);
            wh.z = pkbf(o[4] * rs * nw[4] * c[4], o[5] * rs * nw[5] * c[5]); wh.w = pkbf(o[6] * rs * nw[6] * c[6], o[7] * rs * nw[7] * c[7]);
            *(v4u*)(O + row * 1024 + 8 * lane) = wh; }
    }
}
__device__ __forceinline__ void combine_panel(const Params& p, int pm, int lane, int wave) {
    u16* YY = (u16*)(p.ws + WS_YY); const u16* VL = (const u16*)(p.ws + WS_VL); const u16* GG = (const u16*)(p.ws + WS_G);
    const float* SBv = (const float*)(p.ws + WS_SB);
    float lw_[8], lb_[8];
#pragma unroll
    for (int e = 0; e < 8; ++e) { lw_[e] = p.lnxw[8 * lane + e]; lb_[e] = p.lnxb[8 * lane + e]; }
    const int hh = lane >> 3;
    constexpr int RB = 4;
    for (int i = 0; i < 32; i += RB) {
        v4u uyf[RB], uyb[RB], uv[RB], ug[RB]; float sfb[RB];
#pragma unroll
        for (int q = 0; q < RB; ++q) { const long row = (long)pm * 256 + wave * 32 + i + q;
            uyf[q] = __builtin_nontemporal_load((const v4u*)(YY + row * 1024 + 8 * lane)); uyb[q] = __builtin_nontemporal_load((const v4u*)(YY + row * 1024 + 512 + 8 * lane)); uv[q] = __builtin_nontemporal_load((const v4u*)(VL + row * 512 + 8 * lane)); ug[q] = __builtin_nontemporal_load((const v4u*)(GG + row * 512 + 8 * lane));
            sfb[q] = SBv[(size_t)row * 8 + hh] + SBv[((size_t)NTOK + row) * 8 + hh]; }
#pragma unroll
        for (int q = 0; q < RB; ++q) { const long row = (long)pm * 256 + wave * 32 + i + q;
            float yf[8], yb[8], vv[8], gg[8], y[8];
            unpack8(uyf[q], yf); unpack8(uyb[q], yb); unpack8(uv[q], vv); unpack8(ug[q], gg);
            float sm = 0.f;
#pragma unroll
            for (int e = 0; e < 8; ++e) { y[e] = yf[e] + yb[e]; sm += y[e]; }
            sm = sum8(sm);
            const float mean = sm * (1.0f / 64.0f); float sq = 0.f;
#pragma unroll
            for (int e = 0; e < 8; ++e) { y[e] -= mean; sq += y[e] * y[e]; }
            sq = sum8(sq);
            const float rstd = 1.0f / sqrtf(sq * (1.0f / 64.0f) + 64e-5f);
#pragma unroll
            for (int e = 0; e < 8; ++e) y[e] = (y[e] * rstd * lw_[e] + lb_[e] + sfb[q] * vv[e]) * gg[e];
            v4u wr; wr.x = pkbf(y[0], y[1]); wr.y = pkbf(y[2], y[3]); wr.z = pkbf(y[4], y[5]); wr.w = pkbf(y[6], y[7]);
            *(v4u*)(YY + row * 1024 + 512 + 8 * lane) = wr; }
    }
}
template <int RB> __device__ __forceinline__ void row_stats(f32x4 (&v)[RB][4], float (&mean)[RB], float (&rstd)[RB], float eps) {
    float s[RB];
#pragma unroll
    for (int q = 0; q < RB; ++q) { s[q] = 0.f;
#pragma unroll
        for (int j = 0; j < 4; ++j) s[q] += (v[q][j].x + v[q][j].y) + (v[q][j].z + v[q][j].w); }
#pragma unroll
    for (int q = 0; q < RB; ++q) mean[q] = wave_sum(s[q]) * (1.f / DM);
#pragma unroll
    for (int q = 0; q < RB; ++q) { s[q] = 0.f;
#pragma unroll
        for (int j = 0; j < 4; ++j) { v[q][j] = v[q][j] - mean[q]; s[q] += (v[q][j].x * v[q][j].x + v[q][j].y * v[q][j].y) + (v[q][j].z * v[q][j].z + v[q][j].w * v[q][j].w); } }
#pragma unroll
    for (int q = 0; q < RB; ++q) rstd[q] = 1.f / sqrtf(wave_sum(s[q]) * (1.f / DM) + eps);
}
__device__ __forceinline__ void ln1_panel(const Params& p, int pm, int lane, int wave) {
    const float* mod = (const float*)(p.ws + WS_MOD) + (size_t)((pm * 256) >> 13) * 6144; u16* U = (u16*)(p.ws + WS_U); const u16* F = (const u16*)(p.ws + WS_VL); u16* X1 = (u16*)(p.ws + WS_YY);
    constexpr int RB = 4;
    for (int i = 0; i < 32; i += RB) {
        const long row0 = (long)pm * 256 + wave * 32 + i;
        f32x4 v[RB][4]; float mean[RB], rstd[RB];
#pragma unroll
        for (int q = 0; q < RB; ++q)
#pragma unroll
            for (int j = 0; j < 4; ++j) { const f32x4 xv = __builtin_nontemporal_load((const f32x4*)(p.x + (row0 + q) * DM) + lane + 64 * j); const u32x2 fv = __builtin_nontemporal_load((const u32x2*)(F + (row0 + q) * DM) + lane + 64 * j);
                v[q][j] = xv * ALPHA + (f32x4){bflo(fv.x), bfhi(fv.x), bflo(fv.y), bfhi(fv.y)}; }
        row_stats<RB>(v, mean, rstd, 1e-5f);
#pragma unroll
        for (int j = 0; j < 4; ++j) { const f32x4 g = ((const f32x4*)p.ln1g)[lane + 64 * j], bb = ((const f32x4*)p.ln1b)[lane + 64 * j];
#pragma unroll
            for (int q = 0; q < RB; ++q) { v[q][j] = v[q][j] * rstd[q] * g + bb; u32x2 w; w.x = pkbf(v[q][j].x, v[q][j].y); w.y = pkbf(v[q][j].z, v[q][j].w); ((u32x2*)(X1 + (row0 + q) * DM))[lane + 64 * j] = w; } }
        row_stats<RB>(v, mean, rstd, 1e-6f);
#pragma unroll
        for (int j = 0; j < 4; ++j) { const f32x4 sh = ((const f32x4*)(mod + 3072))[lane + 64 * j], sc = ((const f32x4*)(mod + 4096))[lane + 64 * j];
#pragma unroll
            for (int q = 0; q < RB; ++q) { const f32x4 r = v[q][j] * rstd[q] * (sc + 1.0f) + sh; u32x2 w; w.x = pkbf(r.x, r.y); w.y = pkbf(r.z, r.w); ((u32x2*)(U + (row0 + q) * DM))[lane + 64 * j] = w; } }
    }
}
__device__ __forceinline__ void ln2_panel(const Params& p, int pm, int lane, int wave) {
    const u16* F = (const u16*)(p.ws + WS_VL); const u16* X1 = (const u16*)(p.ws + WS_YY);
    constexpr int RB = 4;
    for (int i = 0; i < 32; i += RB) {
        const long row0 = (long)pm * 256 + wave * 32 + i;
        f32x4 v[RB][4]; float mean[RB], rstd[RB];
#pragma unroll
        for (int q = 0; q < RB; ++q)
#pragma unroll
            for (int j = 0; j < 4; ++j) { const u32x2 xb = __builtin_nontemporal_load((const u32x2*)(X1 + (row0 + q) * DM) + lane + 64 * j); const u32x2 fv = __builtin_nontemporal_load((const u32x2*)(F + (row0 + q) * DM) + lane + 64 * j);
                v[q][j] = (f32x4){bflo(xb.x), bfhi(xb.x), bflo(xb.y), bfhi(xb.y)} * ALPHA + (f32x4){bflo(fv.x), bfhi(fv.x), bflo(fv.y), bfhi(fv.y)}; }
        row_stats<RB>(v, mean, rstd, 1e-5f);
#pragma unroll
        for (int j = 0; j < 4; ++j) { const f32x4 g = ((const f32x4*)p.ln2g)[lane + 64 * j], bb = ((const f32x4*)p.ln2b)[lane + 64 * j];
#pragma unroll
            for (int q = 0; q < RB; ++q) { f32x4 o = v[q][j] * rstd[q] * g + bb;
#ifdef DBG_SANITIZE
                for (int e2 = 0; e2 < 4; ++e2) if (!(fabsf(o[e2]) < 1e30f)) o[e2] = 0.f;
#endif
                ((f32x4*)(p.out + (row0 + q) * DM))[lane + 64 * j] = o; } }
    }
}

#ifndef P1_ALIGN
#define P1_ALIGN true
#endif
#ifndef P1_WGM
#define P1_WGM 8
#endif
#ifndef REP_LN1
#define REP_LN1 1
#endif
#ifndef REP0
#define REP0 1
#endif
#ifndef REP_DOWN
#define REP_DOWN 1
#endif
#ifndef REP_OUT
#define REP_OUT 1
#endif
#ifndef REP_GU
#define REP_GU 1
#endif
#ifndef REP1
#define REP1 1
#endif
#ifndef REP2
#define REP2 1
#endif
#ifndef REP_RW
#define REP_RW 1
#endif
#ifndef REP_HG
#define REP_HG 1
#endif
#ifndef N_LAUNCHES
#define N_LAUNCHES 1
#endif
typedef const unsigned long long __attribute__((address_space(4))) KWord;
__device__ __forceinline__ Params load_params(KWord* k) { asm volatile("" : "+s"(k)); Params q; unsigned long long* d = (unsigned long long*)&q;
#pragma unroll
    for (int i = 0; i < (int)(sizeof(Params) / 8); ++i) d[i] = k[i];
    return q; }
#define PARAMS() const Params p = load_params(kp)
__global__ void __launch_bounds__(NWAVES * 64, 2) mega_fwd(Params p_arg, int ph_lo, int ph_hi) {
    KWord* kp = (KWord*)__builtin_amdgcn_kernarg_segment_ptr();
    extern __shared__ __attribute__((aligned(16))) unsigned char lds_raw[];
    LAS unsigned char* lds = (LAS unsigned char*)lds_raw;
    const int wave = __builtin_amdgcn_readfirstlane((int)threadIdx.x >> 6), bid = blockIdx.x, G = gridDim.x;
#define TID_LANE() int lane; asm volatile("v_mbcnt_lo_u32_b32 %0, -1, 0\n\tv_mbcnt_hi_u32_b32 %0, -1, %0" : "=v"(lane)); const int tid = wave * 64 + lane
    volatile LAS unsigned* MISC = (volatile LAS unsigned*)(lds + MISC_OFF);
    { TID_LANE(); if (tid < 32) MISC[tid] = 0u; }
    __syncthreads();
    XcdBarrier bar; { PARAMS(); bar.bar = (unsigned*)(p.ws + WS_CTL) + CW_BAR; bar.x = 0; bar.st = nullptr;
    if (N_LAUNCHES == 1) bar = xcd_barrier_post((unsigned*)(p.ws + WS_CTL) + CW_BAR, MISC + 8); }
#ifndef PHASE_MASK
#define PHASE_MASK 1023
#endif
#define IN(k) (((PHASE_MASK >> (k)) & 1) && ph_lo <= (k) && (k) < ph_hi)
#define SEAM(k) do { if (N_LAUNCHES == 1 && IN(k) && IN((k) + 1)) xcd_barrier(bar); } while (0)
    if (IN(0)) { PARAMS(); TID_LANE(); for (int rp = 0; rp < REP0; ++rp) phase0a(p, lds, tid, lane, wave, bid, G); } SEAM(0);
    if (IN(1)) { PARAMS(); TID_LANE(); for (int rp = 0; rp < REP1; ++rp) phase0b(p, lane, wave, bid, G); } SEAM(1);
    if (IN(2)) { PARAMS(); TID_LANE();
        pg8::Gemm g{(const u16*)(p.ws + WS_U), (const u16*)(p.ws + WS_WIN), MROWS, ZLD, DM, DM, DM}; pg8::StaticOrder S; S.init(MROWS, ZLD - 512, G, bid, P1_WGM); S.gap_at = 8; S.gap = 2;
        const LAS float* epl = (const LAS float*)(lds + EPI_OFF);
        { LAS float* w = (LAS float*)(lds + EPI_OFF); const float* lbg = (const float*)(p.ws + WS_LB); for (int i = tid; i < 1024; i += NWAVES * 64) w[i] = lbg[i]; __syncthreads(); }
        pg8::EpiZ E{(u16*)(p.ws + WS_Z), ZLD, (const float*)(p.ws + WS_LB), 0};
#ifdef P1_STAGGER
        { const int grp = (bid >> 3) & (P1_STAGGER - 1); if (grp) { const unsigned long long t0 = __builtin_amdgcn_s_memrealtime(); while (__builtin_amdgcn_s_memrealtime() - t0 < (unsigned long long)(2900 / P1_STAGGER) * grp) __builtin_amdgcn_s_sleep(8); } }
#endif
#ifdef PROBE_P1NULL_FIRST
        { pg8::EpiNull E0; pg8::gemm_phase<pg8::EpiNull, pg8::StaticOrder, true, true>(lds, g, S, E0, launder(tid)); }
#endif
#ifdef PROBE_P1RAW
        for (int rp = 0; rp < 2; ++rp) { pg8::EpiZ Er{(u16*)(p.ws + (rp == 0 ? WS_YY : WS_Z)), ZLD, (const float*)(p.ws + WS_LB), rp == 0 ? PROBE_P1RAW : 0}; pg8::gemm_phase<pg8::EpiZ, pg8::StaticOrder, P1_ALIGN, true>(lds, g, S, Er, launder(tid)); }
#else
        for (int rp = 0; rp < REP2; ++rp) pg8::gemm_phase<pg8::EpiZ, pg8::StaticOrder, P1_ALIGN, true>(lds, g, S, E, launder(tid));
#endif
#ifdef PROBE_P1NULL
        { pg8::EpiNull E0; pg8::StaticOrder S0; S0.init(PROBE_P1NULL == 2 ? NTOK : MROWS, ZLD, G, bid, P1_WGM); pg8::gemm_phase<pg8::EpiNull, pg8::StaticOrder, true, true>(lds, g, S0, E0, launder(tid)); }
#endif
    } SEAM(2);
    if (IN(3)) { PARAMS();
        constexpr int NGATE = 64;
        for (int task = bid; task < 192 + NGATE; task += G) {
            int lane2; asm volatile("v_mbcnt_lo_u32_b32 %0, -1, 0\n\tv_mbcnt_hi_u32_b32 %0, -1, %0" : "=v"(lane2)); const int tid2 = wave * 64 + lane2;
            if (task < 128) { for (int rp = 0; rp < REP_RW; ++rp) rwkv_chain(p, lds, tid2, lane2, wave, task >> 4, (task >> 1) & 7, task & 1); }
            else if (task < 192) { const int t = task - 128; for (int rp = 0; rp < REP_HG; ++rp) hgrn_chain(p, lds, tid2, lane2, wave, t >> 3, (t >> 1) & 3, t & 1);
                asm volatile("s_waitcnt vmcnt(0)" ::: "memory"); __syncthreads();
                if (threadIdx.x == 0) { __builtin_amdgcn_fence(__ATOMIC_RELEASE, "agent"); asm volatile("s_waitcnt vmcnt(0)" ::: "memory");
                    (void)xb_add((unsigned*)(p.ws + WS_CTL) + CW_HG + 16 * (t >> 3), 1u); } }
            else { const int oc = task - 192;
                for (int pm = oc; pm < NTOK / 256; pm += NGATE) gate_panel(p, lds, lane2, wave, pm);
                __syncthreads();
                { int lane3; asm volatile("v_mbcnt_lo_u32_b32 %0, -1, 0\n\tv_mbcnt_hi_u32_b32 %0, -1, %0" : "=v"(lane3)); const int tid3 = wave * 64 + lane3;
                  pg8::Gemm g{(const u16*)(p.ws + WS_U), (const u16*)(p.ws + WS_WIN), MROWS, ZLD, DM, DM, DM}; pg8::OgOrder S{oc, NGATE, NTOK / 256};
                  pg8::EpiZ E{(u16*)(p.ws + WS_Z), ZLD, (const float*)(p.ws + WS_LB), 0};
                  pg8::gemm_phase<pg8::EpiZ, pg8::OgOrder, true, true>(lds, g, S, E, tid3); }
                asm volatile("s_waitcnt vmcnt(0)" ::: "memory"); __syncthreads();
                for (int pm = oc; pm < NTOK / 256; pm += NGATE) {
                    if (threadIdx.x == 0) { unsigned* cnt = (unsigned*)(p.ws + WS_CTL) + CW_HG + 16 * (pm >> 5); unsigned* bar = (unsigned*)(p.ws + WS_CTL) + CW_BAR;
                        XB_SPIN(xb_ld(cnt) < 8u, bar);
                        __builtin_amdgcn_fence(__ATOMIC_ACQUIRE, "agent"); asm volatile("s_waitcnt vmcnt(0)" ::: "memory"); }
                    __syncthreads();
                    int lane3; asm volatile("v_mbcnt_lo_u32_b32 %0, -1, 0\n\tv_mbcnt_hi_u32_b32 %0, -1, %0" : "=v"(lane3));
                    hgrn_combine_panel(p, pm, lane3, wave);
                } }
            __syncthreads();
        }
    } SEAM(3);
    if (IN(4)) { PARAMS(); TID_LANE(); for (int pm = bid; pm < NTOK / 256; pm += G) combine_panel(p, pm, launder(lane), wave); } SEAM(4);
    if (IN(5)) { PARAMS(); TID_LANE();
        pg8::Gemm g{(const u16*)p.out, (const u16*)(p.ws + WS_WOUT), NTOK, DM, DM, DM, DM, (long)((const char*)(p.ws + WS_YY) - (const char*)p.out), 8};   pg8::StaticOrder S; S.init(NTOK, DM, G, bid);
        int bl = -1; bool same = true; { pg8::Unit u0; if (S.next(0, u0)) bl = u0.pm >> 5; for (int i = 1; S.next(i, u0); ++i) same = same && ((u0.pm >> 5) == bl); }
        { LAS float* w = (LAS float*)(lds + EPI_OFF); const float* gg = (const float*)(p.ws + WS_MOD) + 2048 + (size_t)(bl < 0 ? 0 : bl) * 6144; for (int i = tid; i < 1024; i += NWAVES * 64) w[i] = gg[i]; __syncthreads(); }
        if (same) { pg8::EpiGate<true> E{(u16*)(p.ws + WS_VL), DM, (const float*)(p.ws + WS_MOD) + 2048, (const LAS float*)(lds + EPI_OFF)};
            for (int rp = 0; rp < REP_OUT; ++rp) pg8::gemm_phase<pg8::EpiGate<true>, pg8::StaticOrder, true, true>(lds, g, S, E, launder(tid)); }
        else { pg8::EpiGate<false> E{(u16*)(p.ws + WS_VL), DM, (const float*)(p.ws + WS_MOD) + 2048, (const LAS float*)(lds + EPI_OFF)};
            pg8::gemm_phase<pg8::EpiGate<false>, pg8::StaticOrder, true, true>(lds, g, S, E, launder(tid)); }
    } SEAM(5);
    if (IN(6)) { PARAMS(); TID_LANE(); for (int rp = 0; rp < REP_LN1; ++rp) for (int pm = bid; pm < NTOK / 256; pm += G) ln1_panel(p, pm, launder(lane), wave); } SEAM(6);
    if (IN(7)) { PARAMS(); TID_LANE();
        pg8::Gemm g{(const u16*)(p.ws + WS_U), (const u16*)(p.ws + WS_WGU), NTOK, 2 * DFF, DM, DM, DM}; pg8::StaticOrder S; S.init(NTOK, 2 * DFF, G, bid);
        pg8::EpiGU E{(u16*)(p.ws + WS_Z), ZLD};
        for (int rp = 0; rp < REP_GU; ++rp) pg8::gemm_phase<pg8::EpiGU, pg8::StaticOrder, true, true>(lds, g, S, E, launder(tid));
#ifdef PROBE_GUNULL
        { pg8::EpiNull E0; pg8::gemm_phase<pg8::EpiNull, pg8::StaticOrder, true, true>(lds, g, S, E0, launder(tid)); }
#endif
#ifdef PROBE_XN
        { pg8::EpiNull E0; pg8::Gemm gx{(const u16*)(p.ws + WS_U), (const u16*)(p.ws + PROBE_XB), PROBE_XM, PROBE_XN, DM, DM, DM}; pg8::StaticOrder Sx; Sx.init(PROBE_XM, PROBE_XN, G, bid, PROBE_XW); pg8::gemm_phase<pg8::EpiNull, pg8::StaticOrder, true, true>(lds, gx, Sx, E0, launder(tid)); }
#endif
    } SEAM(7);
    if (IN(8)) { PARAMS(); TID_LANE();
        pg8::Gemm g{(const u16*)(p.ws + WS_Z), (const u16*)(p.ws + WS_WD), NTOK, DM, DFF, ZLD, DFF}; pg8::StaticOrder S; S.init(NTOK, DM, G, bid);
        int bl = -1; bool same = true; { pg8::Unit u0; if (S.next(0, u0)) bl = u0.pm >> 5; for (int i = 1; S.next(i, u0); ++i) same = same && ((u0.pm >> 5) == bl); }
        { LAS float* w = (LAS float*)(lds + EPI_OFF); const float* gg = (const float*)(p.ws + WS_MOD) + 5120 + (size_t)(bl < 0 ? 0 : bl) * 6144; for (int i = tid; i < 1024; i += NWAVES * 64) w[i] = gg[i]; __syncthreads(); }
        if (same) { pg8::EpiGate<true> E{(u16*)(p.ws + WS_VL), DM, (const float*)(p.ws + WS_MOD) + 5120, (const LAS float*)(lds + EPI_OFF)};
            for (int rp = 0; rp < REP_DOWN; ++rp) pg8::gemm_phase<pg8::EpiGate<true>, pg8::StaticOrder, true, true>(lds, g, S, E, launder(tid)); }
        else { pg8::EpiGate<false> E{(u16*)(p.ws + WS_VL), DM, (const float*)(p.ws + WS_MOD) + 5120, (const LAS float*)(lds + EPI_OFF)};
            pg8::gemm_phase<pg8::EpiGate<false>, pg8::StaticOrder, true, true>(lds, g, S, E, launder(tid)); }
    } SEAM(8);
    if (IN(9)) { PARAMS(); TID_LANE(); for (int pm = bid; pm < NTOK / 256; pm += G) ln2_panel(p, pm, launder(lane), wave);
#ifdef DBG_TSTAGE
        if (bid == 0 && tid == 0) { asm volatile("s_waitcnt vmcnt(0)" ::: "memory"); p.out[0] += ((const float*)(p.ws + WS_CTL))[8192]; }
#endif
    }
#undef IN
#undef SEAM
}

extern "C" void kernel_launch(void* const* d_in, const int* in_sizes, int n_in, void* d_out, int out_size, void* d_ws, size_t ws_size, hipStream_t stream) {
    static int grid = 0;
    if (grid == 0) {
        if (n_in != 28 || in_sizes[0] != NTOK * DM || out_size != NTOK * DM || ws_size < WS_END) { fprintf(stderr, "kernel_launch: unexpected shapes: n_in %d in0 %d out %d ws %zu (need %zu)\n", n_in, n_in > 0 ? in_sizes[0] : -1, out_size, ws_size, (size_t)WS_END); grid = -1; return; }
        int dev = 0, cus = 0, per_cu = 0;
        if (hipGetDevice(&dev) != hipSuccess || hipDeviceGetAttribute(&cus, hipDeviceAttributeMultiprocessorCount, dev) != hipSuccess) { grid = -1; return; }
        if (hipFuncSetAttribute((const void*)mega_fwd, hipFuncAttributeMaxDynamicSharedMemorySize, LDS_BYTES) != hipSuccess) { fprintf(stderr, "kernel_launch: hipFuncSetAttribute failed\n"); grid = -1; return; }
        if (hipOccupancyMaxActiveBlocksPerMultiprocessor(&per_cu, (const void*)mega_fwd, NWAVES * 64, LDS_BYTES) != hipSuccess || per_cu < 1) { fprintf(stderr, "kernel_launch: occupancy query says %d blocks per CU\n", per_cu); (void)hipGetLastError(); grid = -1; return; }
        grid = cus;
    }
    if (grid < 0) return;
    Params p{};
    const float** pp = (const float**)&p;
    for (int i = 0; i < 28; ++i) pp[i] = (const float*)d_in[i];
    p.out = (float*)d_out; p.ws = (unsigned char*)d_ws;
#if N_LAUNCHES == 1
    if (hipMemsetAsync((char*)d_ws + WS_CTL, 0, CTL_ZERO_BYTES, stream) != hipSuccess) { fprintf(stderr, "kernel_launch: memset failed\n"); return; }
    hipLaunchKernelGGL(mega_fwd, dim3(grid), dim3(NWAVES * 64), LDS_BYTES, stream, p, 0, 10);
#else
    for (int ph = 0; ph < 10; ++ph) hipLaunchKernelGGL(mega_fwd, dim3(grid), dim3(NWAVES * 64), LDS_BYTES, stream, p, ph, ph + 1);
#endif
}
```
